# Optimizing an MI355X kernel written in HIP

```python
import math
import jax, jax.numpy as jnp
from jax import lax
import numpy as np

D_MODEL = 1024
BATCH = 8
SEQ = 2048
DEPTH = 1

HEAD_DIM = 64
N_HEADS_SB = 8
N_HEADS_MOBA = 8
D_SB = N_HEADS_SB * HEAD_DIM
D_MOBA = N_HEADS_MOBA * HEAD_DIM
SB_Q_BLOCK = 128
MOBA_BLOCK = 256
MOBA_TOPK = 3
MOBA_Q_CHUNK = 16
REL_BUCKETS = 32
REL_MAX_DIST = 128
N_EXPERTS = 32
TOP_K = 4
D_EXPERT = D_MODEL
SWIGLU_LIMIT = 7.0
SWIGLU_ALPHA = 1.702
RMS_EPS = 1e-6
IN_SPLIT_POINTS = (D_SB, 2 * D_SB, 3 * D_SB, 3 * D_SB + D_MOBA, 3 * D_SB + 2 * D_MOBA, 3 * D_SB + 3 * D_MOBA, 3 * D_SB + 3 * D_MOBA + D_MODEL)
D_IN_PROJ = 3 * D_SB + 3 * D_MOBA + 2 * D_MODEL

kernel_name = "hybrid_stickbreak_moba_moe_block"


def rmsnorm(x, g):
    xf = x.astype(jnp.float32)
    var = jnp.mean(xf * xf, axis=-1, keepdims=True)
    return (xf * lax.rsqrt(var + RMS_EPS)).astype(x.dtype) * g


def split_heads(t, n_heads):
    B, S, _ = t.shape
    return t.reshape(B, S, n_heads, HEAD_DIM).transpose(0, 2, 1, 3)


def merge_heads(t):
    B, H, S, dh = t.shape
    return t.transpose(0, 2, 1, 3).reshape(B, S, H * dh)


def rel_bucket(dist):
    n = jnp.maximum(dist, 0)
    max_exact = REL_BUCKETS // 2
    nf = jnp.maximum(n, 1).astype(jnp.float32)
    large = max_exact + (jnp.log(nf / max_exact) / math.log(REL_MAX_DIST / max_exact)
                         * (REL_BUCKETS - max_exact)).astype(jnp.int32)
    large = jnp.minimum(large, REL_BUCKETS - 1)
    return jnp.where(n < max_exact, n, large)


def stick_breaking_attention(q, k, v):
    B, H, S, dh = q.shape
    nq = S // SB_Q_BLOCK
    qb = q.reshape(B, H, nq, SB_Q_BLOCK, dh).transpose(2, 0, 1, 3, 4)
    key_pos = jnp.arange(S)
    scale = 1.0 / math.sqrt(dh)

    def block(args):
        i, qi = args
        q_pos = i * SB_Q_BLOCK + jnp.arange(SB_Q_BLOCK)
        z = jnp.einsum('bhqd,bhkd->bhqk', qi, k).astype(jnp.float32) * scale
        causal = key_pos[None, :] < q_pos[:, None]
        log_keep = jnp.where(causal, -jax.nn.softplus(z), 0.0)
        tail = lax.cumsum(log_keep, axis=3, reverse=True) - log_keep
        a = jnp.where(causal, jnp.exp(jax.nn.log_sigmoid(z) + tail), 0.0)
        return jnp.einsum('bhqk,bhkd->bhqd', a.astype(v.dtype), v)

    out = lax.map(block, (jnp.arange(nq), qb))
    return out.transpose(1, 2, 0, 3, 4).reshape(B, H, S, dh)


_gather_blocks = jax.vmap(jax.vmap(lambda blk, idx: blk[idx]))


def moba_attention(q, k, v, rel_bias):
    B, H, S, dh = q.shape
    L = MOBA_BLOCK
    n_blk = -(-S // L)
    pad = n_blk * L - S
    kp = jnp.pad(k, ((0, 0), (0, 0), (0, pad), (0, 0)))
    vp = jnp.pad(v, ((0, 0), (0, 0), (0, pad), (0, 0)))
    k_blocks = kp.reshape(B, H, n_blk, L, dh)
    v_blocks = vp.reshape(B, H, n_blk, L, dh)
    k_mean = jnp.mean(k_blocks.astype(jnp.float32), axis=3)
    k_sel = min(MOBA_TOPK, n_blk)
    scale = 1.0 / math.sqrt(dh)
    C = MOBA_Q_CHUNK
    nq = S // C
    qc = q.reshape(B, H, nq, C, dh).transpose(2, 0, 1, 3, 4)
    offs = jnp.arange(L)
    rel_t = rel_bias.T
    head_idx = jnp.arange(H)[:, None, None, None]

    def chunk(args):
        i, qi = args
        q_pos = i * C + jnp.arange(C)
        own_blk = (i * C) // L
        gs = jnp.einsum('bhqd,bhnd->bhqn', qi.astype(jnp.float32), k_mean)
        past = jnp.arange(n_blk) < own_blk
        gs = jnp.where(past[None, None, None, :], gs, -jnp.inf)
        _, top = lax.top_k(gs, k_sel)
        sel_valid = top < own_blk
        kg = _gather_blocks(k_blocks, top)
        vg = _gather_blocks(v_blocks, top)
        s_past = jnp.einsum('bhqd,bhqmld->bhqml', qi, kg).astype(jnp.float32) * scale
        dist_past = q_pos[None, None, :, None, None] - (top[..., None] * L + offs)
        bias_past = rel_t[head_idx, rel_bucket(dist_past)]
        s_past = jnp.where(sel_valid[..., None], s_past + bias_past, -jnp.inf)
        k_own = lax.dynamic_slice_in_dim(k_blocks, own_blk, 1, axis=2)[:, :, 0]
        v_own = lax.dynamic_slice_in_dim(v_blocks, own_blk, 1, axis=2)[:, :, 0]
        s_own = jnp.einsum('bhqd,bhld->bhql', qi, k_own).astype(jnp.float32) * scale
        dist_own = q_pos[:, None] - (own_blk * L + offs)[None, :]
        bias_own = rel_t[:, rel_bucket(dist_own)]
        s_own = jnp.where((dist_own >= 0)[None, None], s_own + bias_own[None], -jnp.inf)
        scores = jnp.concatenate([s_past.reshape(B, H, C, k_sel * L), s_own], axis=-1)
        p = jax.nn.softmax(scores, axis=-1).astype(v.dtype)
        p_past = p[..., :k_sel * L].reshape(B, H, C, k_sel, L)
        p_own = p[..., k_sel * L:]
        return (jnp.einsum('bhqml,bhqmld->bhqd', p_past, vg)
                + jnp.einsum('bhql,bhld->bhqd', p_own, v_own))

    out = lax.map(chunk, (jnp.arange(nq), qc))
    return out.transpose(1, 2, 0, 3, 4).reshape(B, H, S, dh)


def moe_ffn(x, w_router, b_router, w_gate_up, b_gate_up, w_down, b_down):
    B, S, D = x.shape
    xt = x.reshape(B * S, D)
    logits = (xt @ w_router + b_router).astype(jnp.float32)
    top_val, top_idx = lax.top_k(logits, TOP_K)
    top_w = jax.nn.softmax(top_val, axis=-1)
    gates = jnp.sum(jax.nn.one_hot(top_idx, N_EXPERTS, dtype=jnp.float32) * top_w[..., None], axis=1)

    def expert_step(acc, params):
        wgu, bgu, wd, bd, g = params
        hgu = xt @ wgu + bgu
        gate = jnp.minimum(hgu[:, :D_EXPERT], SWIGLU_LIMIT)
        up = jnp.clip(hgu[:, D_EXPERT:], -SWIGLU_LIMIT, SWIGLU_LIMIT)
        y = ((up + 1.0) * (gate * jax.nn.sigmoid(SWIGLU_ALPHA * gate))) @ wd + bd
        return acc + g[:, None].astype(y.dtype) * y, None

    acc, _ = lax.scan(expert_step, jnp.zeros_like(xt), (w_gate_up, b_gate_up, w_down, b_down, gates.T))
    return acc.reshape(B, S, D)


def setup_inputs(seed: int = 0) -> dict:
    key = jax.random.key(seed)
    ks = jax.random.split(key, 15)
    f32 = jnp.float32
    nrm = lambda k, shape, s: jax.random.normal(k, shape, f32) * s
    return {
        "x": nrm(ks[0], (BATCH, SEQ, D_MODEL), 1.0),
        "norm_mix_g": 1.0 + nrm(ks[1], (DEPTH, D_MODEL), 0.02),
        "w_in": nrm(ks[2], (DEPTH, D_MODEL, D_IN_PROJ), D_MODEL ** -0.5),
        "w_proj_sb": nrm(ks[3], (DEPTH, D_SB, D_MODEL), D_SB ** -0.5),
        "w_proj_moba": nrm(ks[4], (DEPTH, D_MOBA, D_MODEL), D_MOBA ** -0.5),
        "w_out": nrm(ks[5], (DEPTH, D_MODEL, D_MODEL), D_MODEL ** -0.5),
        "rel_bias": nrm(ks[6], (REL_BUCKETS, N_HEADS_MOBA), 0.5),
        "norm_ffn_g": 1.0 + nrm(ks[7], (DEPTH, D_MODEL), 0.02),
        "w_router": nrm(ks[8], (DEPTH, D_MODEL, N_EXPERTS), D_MODEL ** -0.5),
        "b_router": nrm(ks[9], (DEPTH, N_EXPERTS), 0.01),
        "w_gate_up": nrm(ks[10], (DEPTH, N_EXPERTS, D_MODEL, 2 * D_EXPERT), D_MODEL ** -0.5),
        "b_gate_up": nrm(ks[11], (DEPTH, N_EXPERTS, 2 * D_EXPERT), 0.02),
        "w_down": nrm(ks[12], (DEPTH, N_EXPERTS, D_EXPERT, D_MODEL), D_EXPERT ** -0.5),
        "b_down": nrm(ks[13], (DEPTH, N_EXPERTS, D_MODEL), 0.02),
        "norm_final_g": 1.0 + nrm(ks[14], (D_MODEL,), 0.02),
    }


def reference(x, norm_mix_g, w_in, w_proj_sb, w_proj_moba, w_out, rel_bias, norm_ffn_g,
              w_router, b_router, w_gate_up, b_gate_up, w_down, b_down, norm_final_g):
    h = x
    for l in range(DEPTH):
        xn = rmsnorm(h, norm_mix_g[l])
        proj = xn @ w_in[l]
        q_sb, k_sb, v_sb, q_mb, k_mb, v_mb, g_sb, g_mb = jnp.split(proj, IN_SPLIT_POINTS, axis=-1)
        y_sb = stick_breaking_attention(split_heads(q_sb, N_HEADS_SB), split_heads(k_sb, N_HEADS_SB),
                                        split_heads(v_sb, N_HEADS_SB))
        y_mb = moba_attention(split_heads(q_mb, N_HEADS_MOBA), split_heads(k_mb, N_HEADS_MOBA),
                              split_heads(v_mb, N_HEADS_MOBA), rel_bias)
        merged = (jax.nn.sigmoid(g_sb) * (merge_heads(y_sb) @ w_proj_sb[l])
                  + jax.nn.sigmoid(g_mb) * (merge_heads(y_mb) @ w_proj_moba[l]))
        h = h + merged @ w_out[l]
        hn = rmsnorm(h, norm_ffn_g[l])
        h = h + moe_ffn(hn, w_router[l], b_router[l], w_gate_up[l], b_gate_up[l], w_down[l], b_down[l])
    return rmsnorm(h, norm_final_g)
```

```cpp
#include <hip/hip_runtime.h>
#include <cstdio>
#include <cstdint>
#include <cmath>

#ifndef PROBE_DUMP
#define PROBE_DUMP 0
#define PROBE_DUMP_OFF WS_GATES
#define PROBE_DUMP_LD 2048
#define PROBE_DUMP_C0 0
#endif
#ifndef PROBE_NSLOT
#define PROBE_NSLOT 4
#endif
#ifndef MK_N_LAUNCHES
#define MK_N_LAUNCHES 1
#endif

constexpr int T_TOK = 16384, DM = 1024, DIN = 5120, NEXP = 32, TOPK = 4, SEQ = 2048, NBATCH = 8, NHEAD = 8;
constexpr int QKV_LD = 3072, GATE_LD = 2048;
constexpr float C2F = 0.125f * 1.4426950408889634f;
constexpr float LOG2E = 1.4426950408889634f;
constexpr float RMS_EPS = 1e-6f;
constexpr int LIST_CAP = 16384;
constexpr int MAX_TILES = 288;

namespace pg8 {
#define PG8_LAS __attribute__((address_space(3)))
typedef unsigned short bf16_t;
typedef short bf16x8 __attribute__((ext_vector_type(8)));
typedef float f32x4 __attribute__((ext_vector_type(4)));
typedef float f32x2 __attribute__((ext_vector_type(2)));
typedef unsigned u32x4 __attribute__((ext_vector_type(4)));
constexpr int BM = 256, BK = 64, HALF = 128, HTB = HALF * BK * 2, STAGE_BYTES = 8 * HTB, NXCD = 8, WGM = 8;

__host__ __device__ __forceinline__ int lds_byte(int r, int c) { const int st = (r >> 4) * 2 + (c >> 5), rr = r & 15, cc = c & 31, ob = rr * 64 + cc * 2; return st * 1024 + (ob ^ (((ob >> 9) & 1) << 5)); }
__host__ __device__ __forceinline__ void stage_rc(int b, int& R, int& C) { const int st = b / 1024, sb = b % 1024, swz = sb ^ (((sb >> 9) & 1) << 5); R = (st >> 1) * 16 + swz / 64; C = (st & 1) * 32 + (swz % 64) / 2; }
__host__ __device__ __forceinline__ int perm32(int rho) { const int n = rho >> 4, i = rho & 15; return 8 * (i >> 2) + 4 * n + (i & 3); }

struct Unit { int pm, pn, e, aux; };

__device__ __forceinline__ bool static_tile(int i, int G, int c, int nM, int nN, int& pm, int& pn) {
    const int nwg = nM * nN; const long L = (long)i * G + c; if (L >= nwg) return false;
    int wgid = (int)L; { const int q = nwg / NXCD, r = nwg % NXCD, xcd = wgid % NXCD, off = wgid / NXCD; wgid = (xcd < r ? xcd * (q + 1) : r * (q + 1) + (xcd - r) * q) + off; }
    const int nig = WGM * nN, gid = wgid / nig, fm = gid * WGM, gsz = (nM - fm) < WGM ? (nM - fm) : WGM;
    pm = fm + ((wgid % nig) % gsz); pn = (wgid % nig) / gsz; return true;
}

typedef __bf16 bf16x2_t __attribute__((ext_vector_type(2)));
__device__ __forceinline__ unsigned cvt_pk_bf16(float lo, float hi) { f32x2 v = {lo, hi}; bf16x2_t b = __builtin_convertvector(v, bf16x2_t); return __builtin_bit_cast(unsigned, b); }
__device__ __forceinline__ float bf_lo(unsigned w) { return __uint_as_float(w << 16); }
__device__ __forceinline__ float bf_hi(unsigned w) { return __uint_as_float(w & 0xffff0000u); }

template <class Epi, class Sched, bool ALIGN_EPI, bool GATHER>
__device__ __forceinline__ void gemm_phase(PG8_LAS unsigned char* lds, const Sched& S, const Epi& E, const int K, const int lda, const int ldb) {
    const int tid = threadIdx.x, wid = __builtin_amdgcn_readfirstlane(tid >> 6), lane = tid & 63, wr = wid >> 2, wc = wid & 3, fr = lane & 15, fq = lane >> 4;
    const int nt = K / BK;
    unsigned voA[2][2], voN[2][2], voffB[2]; int RA[2], CA[2];
#pragma unroll
    for (int i = 0; i < 2; ++i) { int R, C; stage_rc(tid * 16 + i * 8192, R, C); const int Rb = Epi::PERM ? ((R & ~31) + perm32(R & 31)) : R;
        RA[i] = R; CA[i] = C; voffB[i] = (unsigned)(Rb * ldb + C) * 2u;
#pragma unroll
        for (int h = 0; h < 2; ++h) voA[h][i] = (unsigned)((h * HALF + R) * lda + C) * 2u; }
    const size_t kstep = (size_t)(BK * 2);
    const size_t hstepB = (size_t)HALF * ldb * 2;
    const unsigned ldsw = (unsigned)wid * 1024u;
    const int aoff = lds_byte(wr * 64 + fr, fq * 8), boff = lds_byte(wc * 32 + fr, fq * 8);
#define PG8_SA(b, h) (((b) * 2 + (h)) * HTB)
#define PG8_SB(b, h) ((4 + (b) * 2 + (h)) * HTB)
#define PG8_STAGE(bufoff, gbase, voff) do { _Pragma("unroll") for (int _i = 0; _i < 2; ++_i) \
        __builtin_amdgcn_global_load_lds((const unsigned*)((const char*)(gbase) + (voff)[_i]), (PG8_LAS unsigned*)(lds + (bufoff) + ldsw + _i * 8192), 16, 0, 0); } while (0)
#define PG8_LDA(dst, b, h) do { _Pragma("unroll") for (int m = 0; m < 4; ++m) _Pragma("unroll") for (int k = 0; k < 2; ++k) dst[m][k] = *(const PG8_LAS bf16x8*)(lds + PG8_SA(b, h) + aoff + m * 2048 + k * 1024); } while (0)
#define PG8_LDB(dst, b, h) do { _Pragma("unroll") for (int n = 0; n < 2; ++n) _Pragma("unroll") for (int k = 0; k < 2; ++k) dst[n][k] = *(const PG8_LAS bf16x8*)(lds + PG8_SB(b, h) + boff + n * 2048 + k * 1024); } while (0)
#define PG8_MMA(ai, bj, At, Bt) do { __builtin_amdgcn_s_setprio(1); _Pragma("unroll") for (int m = 0; m < 4; ++m) _Pragma("unroll") for (int n = 0; n < 2; ++n) _Pragma("unroll") for (int k = 0; k < 2; ++k) \
        acc[ai][bj][m][n] = __builtin_amdgcn_mfma_f32_16x16x32_bf16(Bt[n][k], At[m][k], acc[ai][bj][m][n], 0, 0, 0); __builtin_amdgcn_s_setprio(0); } while (0)
#define PG8_WAIT_V(n) asm volatile("s_waitcnt vmcnt(" #n ")" ::: "memory")
#define PG8_WAIT_L(n) asm volatile("s_waitcnt lgkmcnt(" #n ")" ::: "memory")
#define PG8_BAR __builtin_amdgcn_s_barrier()
#define PG8_SCHED __builtin_amdgcn_sched_barrier(0)
    Unit cur, nxt; int ui = 0;
    if (!S.next(0, cur)) return;
    if constexpr (GATHER) S.a_rows(cur, RA, CA, voA);
#pragma unroll
    for (int h = 0; h < 2; ++h)
#pragma unroll
        for (int i = 0; i < 2; ++i) voN[h][i] = voA[h][i];
    f32x4 acc[2][2][4][2];
#pragma unroll
    for (int a = 0; a < 2; ++a)
#pragma unroll
        for (int b = 0; b < 2; ++b)
#pragma unroll
            for (int m = 0; m < 4; ++m)
#pragma unroll
                for (int n = 0; n < 2; ++n) acc[a][b][m][n] = (f32x4){0.f, 0.f, 0.f, 0.f};
    bf16x8 At[4][2], B0[2][2], B1[2][2];
    const char* cA = S.a_base(cur); const char* cB = S.b_base(cur);
    PG8_STAGE(PG8_SB(0, 0), cB, voffB); PG8_STAGE(PG8_SB(0, 1), cB + hstepB, voffB); PG8_STAGE(PG8_SA(0, 0), cA, voA[0]); PG8_STAGE(PG8_SA(0, 1), cA, voA[1]);
    if (wr == 1) PG8_BAR;
    PG8_WAIT_V(2); PG8_BAR;
    PG8_STAGE(PG8_SB(1, 0), cB + kstep, voffB); PG8_STAGE(PG8_SA(1, 0), cA + kstep, voA[0]); PG8_STAGE(PG8_SB(1, 1), cB + hstepB + kstep, voffB);
    PG8_WAIT_V(6); PG8_BAR;
    for (;;) {
        const bool has_next = S.next(ui + 1, nxt);
        const char* nA = has_next ? S.a_base(nxt) : cA; const char* nB = has_next ? S.b_base(nxt) : cB;
        if constexpr (GATHER) { if (has_next) S.a_rows(nxt, RA, CA, voN); }
        for (int t = 0; t < nt; t += 2) {
            const bool last = (t == nt - 2);
            const char* a1 = cA + (size_t)(t + 1) * kstep;
            const char* a2 = last ? nA : cA + (size_t)(t + 2) * kstep; const char* b2 = last ? nB : cB + (size_t)(t + 2) * kstep;
            const char* a3 = a2 + kstep; const char* b3 = b2 + kstep;
            unsigned v2[2][2];
#pragma unroll
            for (int h = 0; h < 2; ++h)
#pragma unroll
                for (int i = 0; i < 2; ++i) v2[h][i] = voA[h][i];
            if constexpr (GATHER) { if (last) { asm volatile("" : "+v"(voN[0][0]), "+v"(voN[0][1]), "+v"(voN[1][0]), "+v"(voN[1][1]));
#pragma unroll
                for (int h = 0; h < 2; ++h)
#pragma unroll
                    for (int i = 0; i < 2; ++i) v2[h][i] = voN[h][i]; } }
            PG8_LDB(B0, 0, 0); PG8_LDB(B1, 0, 1); PG8_SCHED; PG8_LDA(At, 0, 0); PG8_STAGE(PG8_SA(1, 1), a1, voA[1]);
            PG8_WAIT_V(8); PG8_WAIT_L(0); PG8_BAR; PG8_MMA(0, 0, At, B0); PG8_MMA(0, 1, At, B1); PG8_BAR; PG8_SCHED;
            PG8_LDA(At, 0, 1); PG8_STAGE(PG8_SB(0, 0), b2, voffB); PG8_STAGE(PG8_SB(0, 1), b2 + hstepB, voffB); PG8_STAGE(PG8_SA(0, 0), a2, v2[0]);
            PG8_WAIT_V(8); PG8_WAIT_L(0); PG8_BAR; PG8_MMA(1, 0, At, B0); PG8_MMA(1, 1, At, B1); PG8_BAR; PG8_SCHED;
            PG8_LDB(B0, 1, 0); PG8_LDB(B1, 1, 1); PG8_SCHED; PG8_LDA(At, 1, 0); PG8_STAGE(PG8_SA(0, 1), a2, v2[1]);
            PG8_WAIT_V(8); PG8_WAIT_L(0); PG8_BAR; PG8_MMA(0, 0, At, B0); PG8_MMA(0, 1, At, B1); PG8_BAR; PG8_SCHED;
            PG8_LDA(At, 1, 1); PG8_STAGE(PG8_SB(1, 0), b3, voffB); PG8_STAGE(PG8_SB(1, 1), b3 + hstepB, voffB); PG8_STAGE(PG8_SA(1, 0), a3, v2[0]);
            PG8_WAIT_V(8); PG8_WAIT_L(0); PG8_BAR; PG8_MMA(1, 0, At, B0); PG8_MMA(1, 1, At, B1); PG8_BAR; PG8_SCHED;
        }
        if constexpr (ALIGN_EPI) { if (wr == 0) PG8_BAR; }
        E(acc, cur, wr, wc, fr, fq);
        if (!has_next) break;
#pragma unroll
        for (int a = 0; a < 2; ++a)
#pragma unroll
            for (int b = 0; b < 2; ++b)
#pragma unroll
                for (int m = 0; m < 4; ++m)
#pragma unroll
                    for (int n = 0; n < 2; ++n) acc[a][b][m][n] = (f32x4){0.f, 0.f, 0.f, 0.f};
        cur = nxt; cA = nA; cB = nB; ++ui;
#pragma unroll
        for (int h = 0; h < 2; ++h)
#pragma unroll
            for (int i = 0; i < 2; ++i) voA[h][i] = voN[h][i];
        if constexpr (ALIGN_EPI) { if (wr == 1) PG8_BAR; }
    }
    PG8_WAIT_V(0);
    if constexpr (!ALIGN_EPI) { if (wr == 0) PG8_BAR; }
    PG8_BAR;
#undef PG8_SA
#undef PG8_SB
#undef PG8_STAGE
#undef PG8_LDA
#undef PG8_LDB
#undef PG8_MMA
#undef PG8_WAIT_V
#undef PG8_WAIT_L
#undef PG8_BAR
#undef PG8_SCHED
}

__device__ __forceinline__ float sigmoidf_fast(float x) { return __builtin_amdgcn_rcpf(1.0f + __builtin_amdgcn_exp2f(-LOG2E * x)); }

struct EpiInProj {
    static constexpr bool PERM = true;
    bf16_t* qkv; bf16_t* gates; float* kpart;
    __device__ __forceinline__ void operator()(const f32x4 (&acc)[2][2][4][2], const Unit& u, int wr, int wc, int fr, int fq) const {
        const int row0 = u.pm * BM + wr * 64 + fr; const int pn = u.pn;
        const int cw = wc * 32 + 8 * fq;
        if (pn < 12) {
            const float sc = (pn < 2 || pn == 6 || pn == 7) ? C2F : 1.0f;
            bf16_t* base = qkv + pn * BM + cw;
#pragma unroll
            for (int ai = 0; ai < 2; ++ai)
#pragma unroll
                for (int m = 0; m < 4; ++m) { bf16_t* rowp = base + (size_t)(row0 + ai * HALF + m * 16) * QKV_LD;
#pragma unroll
                    for (int bj = 0; bj < 2; ++bj) { const f32x4 v0 = acc[ai][bj][m][0] * sc, v1 = acc[ai][bj][m][1] * sc;
                        u32x4 w; w.x = cvt_pk_bf16(v0[0], v0[1]); w.y = cvt_pk_bf16(v0[2], v0[3]); w.z = cvt_pk_bf16(v1[0], v1[1]); w.w = cvt_pk_bf16(v1[2], v1[3]);
                        *(u32x4*)(rowp + bj * HALF) = w; } }
            if (pn == 8 || pn == 9) {
#pragma unroll
                for (int bj = 0; bj < 2; ++bj)
#pragma unroll
                    for (int n = 0; n < 2; ++n) { f32x4 s = (f32x4){0.f, 0.f, 0.f, 0.f};
#pragma unroll
                        for (int ai = 0; ai < 2; ++ai)
#pragma unroll
                            for (int m = 0; m < 4; ++m) s += acc[ai][bj][m][n];
#pragma unroll
                        for (int o = 1; o < 16; o <<= 1) { s[0] += __shfl_xor(s[0], o); s[1] += __shfl_xor(s[1], o); s[2] += __shfl_xor(s[2], o); s[3] += __shfl_xor(s[3], o); }
                        if (fr == 0) *(f32x4*)(kpart + (size_t)(u.pm * 2 + wr) * 512 + (pn - 8) * BM + bj * HALF + cw + 4 * n) = s; }
            }
        } else {
            bf16_t* base = gates + (pn - 12) * BM + cw;
#pragma unroll
            for (int ai = 0; ai < 2; ++ai)
#pragma unroll
                for (int m = 0; m < 4; ++m) { bf16_t* rowp = base + (size_t)(row0 + ai * HALF + m * 16) * GATE_LD;
#pragma unroll
                    for (int bj = 0; bj < 2; ++bj) { const f32x4 a0 = acc[ai][bj][m][0], a1 = acc[ai][bj][m][1];
                        u32x4 w; w.x = cvt_pk_bf16(sigmoidf_fast(a0[0]), sigmoidf_fast(a0[1])); w.y = cvt_pk_bf16(sigmoidf_fast(a0[2]), sigmoidf_fast(a0[3]));
                        w.z = cvt_pk_bf16(sigmoidf_fast(a1[0]), sigmoidf_fast(a1[1])); w.w = cvt_pk_bf16(sigmoidf_fast(a1[2]), sigmoidf_fast(a1[3]));
                        *(u32x4*)(rowp + bj * HALF) = w; } }
        }
    }
};

struct EpiProjGate {
    static constexpr bool PERM = true;
    const bf16_t* gates; bf16_t* merged;
    __device__ __forceinline__ void operator()(const f32x4 (&acc)[2][2][4][2], const Unit& u, int wr, int wc, int fr, int fq) const {
        const int row0 = u.pm * BM + wr * 64 + fr; const int col0 = u.pn * BM + wc * 32 + 8 * fq; const int br = u.e;
#pragma unroll
        for (int ai = 0; ai < 2; ++ai)
#pragma unroll
            for (int m = 0; m < 4; ++m) { const size_t row = (size_t)(row0 + ai * HALF + m * 16);
#pragma unroll
                for (int bj = 0; bj < 2; ++bj) {
                    const u32x4 g = *(const u32x4*)(gates + row * GATE_LD + br * DM + col0 + bj * HALF);
                    f32x4 v0 = acc[ai][bj][m][0], v1 = acc[ai][bj][m][1];
                    v0[0] *= bf_lo(g.x); v0[1] *= bf_hi(g.x); v0[2] *= bf_lo(g.y); v0[3] *= bf_hi(g.y);
                    v1[0] *= bf_lo(g.z); v1[1] *= bf_hi(g.z); v1[2] *= bf_lo(g.w); v1[3] *= bf_hi(g.w);
                    bf16_t* op = merged + row * DM + col0 + bj * HALF;
                    if (br == 1) { const u32x4 p = *(const u32x4*)op;
                        v0[0] += bf_lo(p.x); v0[1] += bf_hi(p.x); v0[2] += bf_lo(p.y); v0[3] += bf_hi(p.y);
                        v1[0] += bf_lo(p.z); v1[1] += bf_hi(p.z); v1[2] += bf_lo(p.w); v1[3] += bf_hi(p.w); }
                    u32x4 w; w.x = cvt_pk_bf16(v0[0], v0[1]); w.y = cvt_pk_bf16(v0[2], v0[3]); w.z = cvt_pk_bf16(v1[0], v1[1]); w.w = cvt_pk_bf16(v1[2], v1[3]);
                    *(u32x4*)op = w; } }
    }
};

struct EpiResF32 {
    static constexpr bool PERM = false;
    const float* x; float* h1;
    __device__ __forceinline__ void operator()(const f32x4 (&acc)[2][2][4][2], const Unit& u, int wr, int wc, int fr, int fq) const {
        const int row0 = u.pm * BM + wr * 64 + fr; const int col0 = u.pn * BM + wc * 32 + 4 * fq;
#pragma unroll
        for (int ai = 0; ai < 2; ++ai)
#pragma unroll
            for (int m = 0; m < 4; ++m) { const size_t off = (size_t)(row0 + ai * HALF + m * 16) * DM + col0;
#pragma unroll
                for (int bj = 0; bj < 2; ++bj)
#pragma unroll
                    for (int n = 0; n < 2; ++n) { const f32x4 b = *(const f32x4*)(x + off + bj * HALF + n * 16); *(f32x4*)(h1 + off + bj * HALF + n * 16) = b + acc[ai][bj][m][n]; } }
    }
};

struct EpiSwiglu {
    static constexpr bool PERM = true;
    const float* bgu; bf16_t* act;
    __device__ __forceinline__ void operator()(const f32x4 (&acc)[2][2][4][2], const Unit& u, int wr, int wc, int fr, int fq) const {
        const int row0 = u.pm * BM + wr * 64 + fr; const int f0 = u.pn * HALF + wc * 32 + 8 * fq;
        const float* bp = bgu + (size_t)u.e * 2048 + f0;
        const f32x4 bg0 = *(const f32x4*)(bp), bg1 = *(const f32x4*)(bp + 4), bu0 = *(const f32x4*)(bp + 1024), bu1 = *(const f32x4*)(bp + 1028);
#pragma unroll
        for (int ai = 0; ai < 2; ++ai)
#pragma unroll
            for (int m = 0; m < 4; ++m) { float y[8];
#pragma unroll
                for (int n = 0; n < 2; ++n)
#pragma unroll
                    for (int j = 0; j < 4; ++j) { const float g = fminf(acc[ai][0][m][n][j] + (n ? bg1[j] : bg0[j]), 7.0f);
                        const float up = fminf(fmaxf(acc[ai][1][m][n][j] + (n ? bu1[j] : bu0[j]), -7.0f), 7.0f);
                        y[n * 4 + j] = (up + 1.0f) * (g * __builtin_amdgcn_rcpf(1.0f + __builtin_amdgcn_exp2f(-1.702f * LOG2E * g))); }
                u32x4 w; w.x = cvt_pk_bf16(y[0], y[1]); w.y = cvt_pk_bf16(y[2], y[3]); w.z = cvt_pk_bf16(y[4], y[5]); w.w = cvt_pk_bf16(y[6], y[7]);
                *(u32x4*)(act + (size_t)(row0 + ai * HALF + m * 16) * DM + f0) = w; }
    }
};

struct EpiDown {
    static constexpr bool PERM = true;
    const float* bd; const int* list; const PG8_LAS int* cnt; const float* topw; bf16_t* yslot;
    __device__ __forceinline__ void operator()(const f32x4 (&acc)[2][2][4][2], const Unit& u, int wr, int wc, int fr, int fq) const {
        const int e = u.e, lt = u.aux; const int nvalid = cnt[e] - lt * BM; const int col0 = u.pn * BM + wc * 32 + 8 * fq;
        const float* bp = bd + (size_t)e * DM + col0;
        f32x4 bv[2][2];
#pragma unroll
        for (int bj = 0; bj < 2; ++bj)
#pragma unroll
            for (int n = 0; n < 2; ++n) bv[bj][n] = *(const f32x4*)(bp + bj * HALF + 4 * n);
#pragma unroll
        for (int ai = 0; ai < 2; ++ai)
#pragma unroll
            for (int m = 0; m < 4; ++m) { const int r = ai * HALF + wr * 64 + m * 16 + fr;
                if (r < nvalid) { const int id = list[(size_t)e * LIST_CAP + lt * BM + r]; const float w = topw[id]; bf16_t* rowp = yslot + (size_t)id * DM + col0;
#pragma unroll
                    for (int bj = 0; bj < 2; ++bj) { const f32x4 v0 = (acc[ai][bj][m][0] + bv[bj][0]) * w, v1 = (acc[ai][bj][m][1] + bv[bj][1]) * w;
                        u32x4 o; o.x = cvt_pk_bf16(v0[0], v0[1]); o.y = cvt_pk_bf16(v0[2], v0[3]); o.z = cvt_pk_bf16(v1[0], v1[1]); o.w = cvt_pk_bf16(v1[2], v1[3]);
                        *(u32x4*)(rowp + bj * HALF) = o; } } }
    }
};

struct DenseOrder {
    int nM, nN, G, c; const char* A; const char* Bt; size_t astep, bstep;
    __device__ __forceinline__ bool next(int i, Unit& u) const { u.e = 0; u.aux = 0; return static_tile(i, G, c, nM, nN, u.pm, u.pn); }
    __device__ __forceinline__ const char* a_base(const Unit& u) const { return A + (size_t)u.pm * astep; }
    __device__ __forceinline__ const char* b_base(const Unit& u) const { return Bt + (size_t)u.pn * bstep; }
    __device__ __forceinline__ void a_rows(const Unit&, const int (&)[2], const int (&)[2], unsigned (&)[2][2]) const {}
};
struct ProjOrder {
    int G, c; const char* Y; const char* Wp;
    __device__ __forceinline__ bool next(int i, Unit& u) const { u.e = i & 1; u.aux = 0; return static_tile(i >> 1, G, c, T_TOK / BM, DM / BM, u.pm, u.pn); }
    __device__ __forceinline__ const char* a_base(const Unit& u) const { return Y + ((size_t)u.pm * BM * DM + u.e * 512) * 2; }
    __device__ __forceinline__ const char* b_base(const Unit& u) const { return Wp + ((size_t)u.pn * BM * DM + u.e * 512) * 2; }
    __device__ __forceinline__ void a_rows(const Unit&, const int (&)[2], const int (&)[2], unsigned (&)[2][2]) const {}
};
struct MoeOrder {
    int NT, nN, G, c; const PG8_LAS int* tile_e; const PG8_LAS int* tileoff; const PG8_LAS int* cnt;
    const char* A; const char* Bt; size_t astep, bstep, bexp; const int* list; int lda; bool gather;
    __device__ __forceinline__ bool next(int i, Unit& u) const { if (!static_tile(i, G, c, NT, nN, u.pm, u.pn)) return false; u.e = tile_e[u.pm]; u.aux = u.pm - tileoff[u.e]; return true; }
    __device__ __forceinline__ const char* a_base(const Unit& u) const { return gather ? A : A + (size_t)u.pm * astep; }
    __device__ __forceinline__ const char* b_base(const Unit& u) const { return Bt + (size_t)u.e * bexp + (size_t)u.pn * bstep; }
    __device__ __forceinline__ void a_rows(const Unit& u, const int (&RA)[2], const int (&CA)[2], unsigned (&vo)[2][2]) const {
        const int n = cnt[u.e] - u.aux * BM; const int* lp = list + (size_t)u.e * LIST_CAP + u.aux * BM;
#pragma unroll
        for (int h = 0; h < 2; ++h)
#pragma unroll
            for (int i = 0; i < 2; ++i) { const int r = h * HALF + RA[i]; const int id = (r < n) ? lp[r] : 0; vo[h][i] = (unsigned)((id >> 2) * lda + CA[i]) * 2u; }
    }
};
}

namespace att {
typedef unsigned short bf16;
using bf16x8 = __attribute__((ext_vector_type(8))) short;
using s16x4 = __attribute__((ext_vector_type(4))) short;
using f32x16 = __attribute__((ext_vector_type(16))) float;
using u32x4 = __attribute__((ext_vector_type(4))) unsigned;
using f32x4 = __attribute__((ext_vector_type(4))) float;
constexpr int NW = 8, KVBLK = 64, NSLOT = 3, SLOTB = 8192, PITCH = QKV_LD;
constexpr int LDS_K = 0, LDS_V = NSLOT * SLOTB, LDS_WS = 2 * NSLOT * SLOTB, LDS_OST = LDS_WS + NW * 64 * 4, LDS_KM = LDS_OST + NW * 4096, LDS_LUT = LDS_KM + 2048, LDS_FLG = LDS_LUT + 512, LDS_BYTES = LDS_FLG + 64;
__device__ __forceinline__ int crow(int r, int hi) { return (r & 3) + 8 * (r >> 2) + 4 * hi; }
#define SBAR() __builtin_amdgcn_sched_barrier(0)
__device__ __forceinline__ void glds16(const void* gsrc, unsigned lds_dst) { unsigned keep;
    asm volatile("s_mov_b32 %0, m0\n\ts_mov_b32 m0, %2\n\ts_nop 0\n\tglobal_load_lds_dwordx4 %1, off\n\ts_mov_b32 m0, %0" : "=&s"(keep) : "v"(gsrc), "s"(lds_dst) : "memory"); }
typedef float f32x2_t __attribute__((ext_vector_type(2))); typedef __bf16 bf16x2_t __attribute__((ext_vector_type(2)));
__device__ __forceinline__ unsigned cvtpk_s(float lo, float hi) { f32x2_t v = {lo, hi}; bf16x2_t b = __builtin_convertvector(v, bf16x2_t); return __builtin_bit_cast(unsigned, b); }
#define WAIT_BAR(N) asm volatile("s_waitcnt vmcnt(" #N ") lgkmcnt(0)\n\ts_barrier" ::: "memory")
typedef __attribute__((address_space(3))) const char* lds_cptr;

__device__ __forceinline__ void qkt(f32x16& p0, f32x16& p1, lds_cptr Kslot, const bf16x8* qr, const f32x16& c0, int r32, int hi) {
    lds_cptr kb = Kslot + hi * 1024 + r32 * 16;
#pragma unroll
    for (int d0 = 0; d0 < 4; ++d0) {
        const bf16x8 b0 = *(const __attribute__((address_space(3))) bf16x8*)(kb + d0 * 2048);
        const bf16x8 b1 = *(const __attribute__((address_space(3))) bf16x8*)(kb + d0 * 2048 + 512);
        if (d0 == 0) { p0 = __builtin_amdgcn_mfma_f32_32x32x16_bf16(b0, qr[0], c0, 0, 0, 0); p1 = __builtin_amdgcn_mfma_f32_32x32x16_bf16(b1, qr[0], c0, 0, 0, 0); }
        else { p0 = __builtin_amdgcn_mfma_f32_32x32x16_bf16(b0, qr[d0], p0, 0, 0, 0); p1 = __builtin_amdgcn_mfma_f32_32x32x16_bf16(b1, qr[d0], p1, 0, 0, 0); } }
}
__device__ __forceinline__ void pv(f32x16* o, int vb, bf16x8 pa0, bf16x8 pa1, bf16x8 pa2, bf16x8 pa3) {
#pragma unroll
    for (int d0 = 0; d0 < 2; ++d0) { s16x4 lo[4], hi[4];
#pragma unroll
        for (int ks = 0; ks < 4; ++ks) {
            asm volatile("ds_read_b64_tr_b16 %0,%1 offset:%c2" : "=&v"(lo[ks]) : "v"(vb), "i"(d0 * 4096 + ks * 1024) : "memory");
            asm volatile("ds_read_b64_tr_b16 %0,%1 offset:%c2" : "=&v"(hi[ks]) : "v"(vb), "i"(d0 * 4096 + ks * 1024 + 512) : "memory"); }
        asm volatile("s_waitcnt lgkmcnt(0)" ::: "memory"); SBAR();
#define PK(k) (bf16x8){lo[k][0], lo[k][1], lo[k][2], lo[k][3], hi[k][0], hi[k][1], hi[k][2], hi[k][3]}
        o[d0] = __builtin_amdgcn_mfma_f32_32x32x16_bf16(pa0, PK(0), o[d0], 0, 0, 0);
        o[d0] = __builtin_amdgcn_mfma_f32_32x32x16_bf16(pa1, PK(1), o[d0], 0, 0, 0);
        o[d0] = __builtin_amdgcn_mfma_f32_32x32x16_bf16(pa2, PK(2), o[d0], 0, 0, 0);
        o[d0] = __builtin_amdgcn_mfma_f32_32x32x16_bf16(pa3, PK(3), o[d0], 0, 0, 0);
#undef PK
    }
}
__device__ __forceinline__ float swap32(float v, int hi) {
    auto rr = __builtin_amdgcn_permlane32_swap(__float_as_uint(v), __float_as_uint(v), false, false);
    return __uint_as_float(hi ? rr[0] : rr[1]);
}
__device__ __forceinline__ void store_o(const f32x16* o, const float* rs, bf16* Ow, int ldo, char* shm, int wid, int lane, int r32, int hi) {
    bf16* stg = (bf16*)(shm + LDS_OST) + wid * 2048;
#pragma unroll
    for (int r = 0; r < 16; ++r) { const int orow = crow(r, hi);
#pragma unroll
        for (int d0 = 0; d0 < 2; ++d0) { const float v = o[d0][r] * rs[r]; const unsigned u = __float_as_uint(v); stg[orow * 64 + d0 * 32 + r32] = (bf16)((u + 0x7fffu + ((u >> 16) & 1u)) >> 16); } }
    asm volatile("s_waitcnt lgkmcnt(0)" ::: "memory");
#pragma unroll
    for (int i = 0; i < 4; ++i) { const int row = i * 8 + (lane >> 3), ch = lane & 7; const u32x4 v = *(const u32x4*)(stg + row * 64 + ch * 8); *(u32x4*)(Ow + (long)row * ldo + ch * 8) = v; }
}
#define PKW(P, B) cvtpk_s(P[B], P[B + 1])

__device__ __forceinline__ void sb_unit(int b, int h, int qb, const bf16* QKV, bf16* Y, char* shm) {
    const int tid = threadIdx.x, lane = tid & 63, r32 = lane & 31, hi = lane >> 5; const int wid = __builtin_amdgcn_readfirstlane(tid >> 6);
    const long rowbase = (long)b * SEQ; const int q0 = qb * 256;
    const bf16* Qw = QKV + (rowbase + q0 + wid * 32) * PITCH + h * 64;
    const bf16* Kh = QKV + rowbase * PITCH + 512 + h * 64; const bf16* Vh = QKV + rowbase * PITCH + 1024 + h * 64;
    const unsigned lds0 = (unsigned)(uintptr_t)shm;
    const lds_cptr shm3 = (lds_cptr)shm;
    volatile __attribute__((address_space(3))) unsigned* flg = (volatile __attribute__((address_space(3))) unsigned*)(shm3 + LDS_FLG);
    const bf16* ksrc = Kh + (long)lane * PITCH + wid * 8;
    const bf16* vsrc = Vh + (long)(16 * (wid & 3) + (lane >> 2)) * PITCH + (wid >> 2) * 32 + (lane & 3) * 8;
    const unsigned kdst = lds0 + LDS_K + wid * 1024, vdst = lds0 + LDS_V + wid * 1024;
#define DMA_KV(t, slot) do { glds16(ksrc + (long)(t) * KVBLK * PITCH, (unsigned)__builtin_amdgcn_readfirstlane(kdst + (slot))); glds16(vsrc + (long)(t) * KVBLK * PITCH, (unsigned)__builtin_amdgcn_readfirstlane(vdst + (slot))); } while (0)
    const int vb0 = (int)(lds0 + LDS_V) + ((lane >> 4) & 1) * 32 + (lane & 3) * 8 + (4 * hi + ((lane & 15) >> 2)) * 64;
    bf16x8 qr[4];
#pragma unroll
    for (int d0 = 0; d0 < 4; ++d0) qr[d0] = *reinterpret_cast<const bf16x8*>(&Qw[(long)r32 * PITCH + d0 * 16 + hi * 8]);
    if (lane == 0) flg[wid] = 0u;
    const int ktop = 4 * qb + 3;
    DMA_KV(ktop, 0); DMA_KV(ktop - 1, SLOTB);
    f32x16 o[2]; o[0] = f32x16{}; o[1] = f32x16{}; const f32x16 zero16 = f32x16{};
    float carry = 0.f;
    const int ktd = 4 * qb + (wid >> 1);
    const int qpos = q0 + wid * 32 + r32;
    bool wdone = false;
    int sl_cur = 0, sl_n1 = SLOTB, sl_n2 = 2 * SLOTB;
    for (int kt = ktop; ; --kt) {
        if (kt > 0) { WAIT_BAR(2); } else { WAIT_BAR(0); }
        { const u32x4 f0 = *(const __attribute__((address_space(3))) u32x4*)(shm3 + LDS_FLG), f1 = *(const __attribute__((address_space(3))) u32x4*)(shm3 + LDS_FLG + 16);
          const unsigned all = f0.x & f0.y & f0.z & f0.w & f1.x & f1.y & f1.z & f1.w;
          if (__builtin_amdgcn_readfirstlane(all) != 0u) break; }
        if (kt >= 2) DMA_KV(kt - 2, sl_n2);
        if (!wdone && kt <= ktd) {
            f32x16 p0, p1;
            qkt(p0, p1, shm3 + LDS_K + sl_cur, qr, zero16, r32, hi);
            const bool diag = (kt == ktd);
            int qk = qpos - 4 * hi - 64 * kt; asm volatile("" : "+v"(qk));
            float lk[32], ls[32];
#pragma unroll
            for (int i = 0; i < 32; ++i) { const float z = (i < 16) ? p0[i] : p1[i - 16];
                const float e = __builtin_amdgcn_exp2f(-__builtin_fabsf(z)); const float l2 = __builtin_amdgcn_logf(1.0f + e);
                const float sp = __builtin_fmaxf(z, 0.f) + l2;
                float nk = -sp, lsv = z - sp;
                if (diag) { const bool valid = (8 * (i >> 2) + (i & 3)) < qk; nk = valid ? nk : 0.f; lsv = valid ? lsv : -INFINITY; }
                lk[i] = nk; ls[i] = lsv; }
            float gs[8], pg[8], S[8];
#pragma unroll
            for (int g = 0; g < 8; ++g) { gs[g] = (lk[4 * g] + lk[4 * g + 1]) + (lk[4 * g + 2] + lk[4 * g + 3]); pg[g] = swap32(gs[g], hi); }
            S[7] = 0.f;
#pragma unroll
            for (int g = 6; g >= 0; --g) S[g] = S[g + 1] + (gs[g + 1] + pg[g + 1]);
            const float tot = S[0] + (gs[0] + pg[0]);
#pragma unroll
            for (int g = 0; g < 8; ++g) { float t = carry + S[g] + (hi ? 0.f : pg[g]);
#pragma unroll
                for (int j = 3; j >= 0; --j) { const int i = 4 * g + j; const float a = __builtin_amdgcn_exp2f(ls[i] + t); t += lk[i]; if (i < 16) p0[i] = a; else p1[i - 16] = a; } }
            carry += tot;
            u32x4 pw0, pw1, pw2, pw3;
            pw0 = (u32x4){PKW(p0, 0), PKW(p0, 2), PKW(p0, 4), PKW(p0, 6)}; pw1 = (u32x4){PKW(p0, 8), PKW(p0, 10), PKW(p0, 12), PKW(p0, 14)};
            pw2 = (u32x4){PKW(p1, 0), PKW(p1, 2), PKW(p1, 4), PKW(p1, 6)}; pw3 = (u32x4){PKW(p1, 8), PKW(p1, 10), PKW(p1, 12), PKW(p1, 14)};
            SBAR();
            pv(o, vb0 + sl_cur, __builtin_bit_cast(bf16x8, pw0), __builtin_bit_cast(bf16x8, pw1), __builtin_bit_cast(bf16x8, pw2), __builtin_bit_cast(bf16x8, pw3));
            wdone = __all(carry < -36.0f);
            if (wdone && lane == 0) flg[wid] = 1u;
        }
        if (kt == 0) break;
        { const int t_ = sl_cur; sl_cur = sl_n1; sl_n1 = sl_n2; sl_n2 = t_; }
    }
    float ones[16];
#pragma unroll
    for (int r = 0; r < 16; ++r) ones[r] = 1.0f;
    store_o(o, ones, Y + (rowbase + q0 + wid * 32) * DM + h * 64, DM, shm, wid, lane, r32, hi);
    WAIT_BAR(0);
#undef DMA_KV
}

__device__ __forceinline__ void moba_unit(int b, int h, int qb, const bf16* QKV, bf16* Y, const float* kpart, const float* rel_bias, char* shm) {
    const int tid = threadIdx.x, lane = tid & 63, r32 = lane & 31, hi = lane >> 5; const int wid = __builtin_amdgcn_readfirstlane(tid >> 6);
    const long rowbase = (long)b * SEQ; const int q0 = qb * 256;
    const bf16* Qw = QKV + (rowbase + q0 + wid * 32) * PITCH + 1536 + h * 64;
    const bf16* Kh = QKV + rowbase * PITCH + 2048 + h * 64; const bf16* Vh = QKV + rowbase * PITCH + 2560 + h * 64;
    const unsigned lds0 = (unsigned)(uintptr_t)shm;
    const lds_cptr shm3 = (lds_cptr)shm;
    __attribute__((address_space(3))) float* wsf = (__attribute__((address_space(3))) float*)(shm3 + LDS_WS) + wid * 64;
    __attribute__((address_space(3))) float* kmean = (__attribute__((address_space(3))) float*)(shm3 + LDS_KM);
    __attribute__((address_space(3))) float* lut = (__attribute__((address_space(3))) float*)(shm3 + LDS_LUT);
    const bf16* ksrc = Kh + (long)lane * PITCH + wid * 8;
    const bf16* vsrc = Vh + (long)(16 * (wid & 3) + (lane >> 2)) * PITCH + (wid >> 2) * 32 + (lane & 3) * 8;
    const unsigned kdst = lds0 + LDS_K + wid * 1024, vdst = lds0 + LDS_V + wid * 1024;
#define DMA_KV(t, slot) do { glds16(ksrc + (long)(t) * KVBLK * PITCH, (unsigned)__builtin_amdgcn_readfirstlane(kdst + (slot))); glds16(vsrc + (long)(t) * KVBLK * PITCH, (unsigned)__builtin_amdgcn_readfirstlane(vdst + (slot))); } while (0)
    const int vb0 = (int)(lds0 + LDS_V) + ((lane >> 4) & 1) * 32 + (lane & 3) * 8 + (4 * hi + ((lane & 15) >> 2)) * 64;
    { const int j = tid >> 6, d = tid & 63; const float* kp = kpart + (size_t)((b * 8 + j) * 2) * 512 + h * 64 + d; kmean[j * 64 + d] = (kp[0] + kp[512]) * (1.0f / 256.0f);
      if (tid < 128) { const int n = tid; int bk; if (n < 16) bk = n; else { bk = 16 + (int)(logf((float)n * (1.0f / 16.0f)) / 2.0794415416798357f * 16.0f); bk = bk > 31 ? 31 : bk; }
          lut[n] = rel_bias[bk * NHEAD + h] * LOG2E; } }
    bf16x8 qr[4];
#pragma unroll
    for (int d0 = 0; d0 < 4; ++d0) qr[d0] = *reinterpret_cast<const bf16x8*>(&Qw[(long)r32 * PITCH + d0 * 16 + hi * 8]);
    const int ns = 4 * qb + 4;
#define TILE_OF(s) ((s) < 4 ? 4 * qb + (s) : (s) - 4)
    DMA_KV(TILE_OF(0), 0); DMA_KV(TILE_OF(1), SLOTB);
    float mhat = 0.f, l_reg = 0.f; f32x16 o[2]; o[0] = f32x16{}; o[1] = f32x16{};
    const int qpos = q0 + wid * 32 + r32; bool first = true; unsigned selmask = 0u; float bias31 = 0.f;
    int sl_cur = 0, sl_n1 = SLOTB, sl_n2 = 2 * SLOTB;
    for (int s = 0; s < ns; ++s) {
        if (s + 1 < ns) { WAIT_BAR(2); } else { WAIT_BAR(0); }
        if (s + 2 < ns) DMA_KV(TILE_OF(s + 2), sl_n2);
        if (s == 0) {
            bias31 = lut[127];
            __attribute__((address_space(3))) float* gsh = (__attribute__((address_space(3))) float*)(shm3 + LDS_OST) + wid * 1024;
#pragma unroll 1
            for (int j = 0; j < qb; ++j) { float a = 0.f;
#pragma unroll
                for (int d0 = 0; d0 < 4; ++d0) { const f32x4 k0 = *(const __attribute__((address_space(3))) f32x4*)(kmean + j * 64 + d0 * 16 + hi * 8), k1 = *(const __attribute__((address_space(3))) f32x4*)(kmean + j * 64 + d0 * 16 + hi * 8 + 4);
                    const bf16x8 q = qr[d0];
                    a += __uint_as_float((unsigned)(unsigned short)q[0] << 16) * k0[0] + __uint_as_float((unsigned)(unsigned short)q[1] << 16) * k0[1] + __uint_as_float((unsigned)(unsigned short)q[2] << 16) * k0[2] + __uint_as_float((unsigned)(unsigned short)q[3] << 16) * k0[3]
                       + __uint_as_float((unsigned)(unsigned short)q[4] << 16) * k1[0] + __uint_as_float((unsigned)(unsigned short)q[5] << 16) * k1[1] + __uint_as_float((unsigned)(unsigned short)q[6] << 16) * k1[2] + __uint_as_float((unsigned)(unsigned short)q[7] << 16) * k1[3]; }
                gsh[j * 64 + lane] = a + swap32(a, hi); }
            asm volatile("s_waitcnt lgkmcnt(0)" ::: "memory");
            float g[8];
#pragma unroll
            for (int j = 0; j < 8; ++j) { g[j] = -INFINITY; if (j < qb) g[j] = gsh[j * 64 + lane]; }
#pragma unroll
            for (int j = 0; j < 8; ++j) if (j < qb) { int rank = 0;
#pragma unroll
                for (int i = 0; i < 8; ++i) if (i != j && i < qb) rank += (g[i] > g[j] || (g[i] == g[j] && i < j)) ? 1 : 0;
                if (rank < 3) selmask |= 1u << j; }
        }
        const int kt = TILE_OF(s);
        const bool own = s < 4;
        const bool active = !own || (s <= (wid >> 1));
        if (active) {
            const int dmin = (q0 + wid * 32) - (64 * kt + 63);
            const bool far = dmin >= 113;
            float nb = -mhat;
            if (!own) nb = ((selmask >> (kt >> 2)) & 1u) ? nb : -INFINITY;
            if (far) nb += bias31;
            f32x16 c0;
#pragma unroll
            for (int r = 0; r < 16; ++r) c0[r] = nb;
            f32x16 p0, p1;
            qkt(p0, p1, shm3 + LDS_K + sl_cur, qr, c0, r32, hi);
            if (!far) {
                int qk = qpos - 4 * hi - 64 * kt; asm volatile("" : "+v"(qk));
#pragma unroll
                for (int i = 0; i < 32; ++i) { const int dist = qk - (8 * (i >> 2) + (i & 3)); const int dc = dist < 0 ? 0 : (dist > 127 ? 127 : dist);
                    const float bb = lut[dc]; float x = (i < 16) ? p0[i] : p1[i - 16]; x = (dist < 0) ? -INFINITY : x + bb; if (i < 16) p0[i] = x; else p1[i - 16] = x;
                    if ((i & 7) == 7) asm volatile("" ::: "memory"); }
            }
            float rm = __builtin_fmaxf(p0[0], p1[0]);
#pragma unroll
            for (int r = 1; r < 16; ++r) rm = __builtin_fmaxf(rm, __builtin_fmaxf(p0[r], p1[r]));
            rm = __builtin_fmaxf(rm, swap32(rm, hi));
            if (first) {
                mhat = rm; first = false;
#pragma unroll
                for (int r = 0; r < 16; ++r) { p0[r] -= rm; p1[r] -= rm; }
            } else if (__any(rm > 8.0f)) {
                const float dl = __builtin_fmaxf(rm, 0.f); mhat += dl;
#pragma unroll
                for (int r = 0; r < 16; ++r) { p0[r] -= dl; p1[r] -= dl; }
                const float f = __builtin_amdgcn_exp2f(-dl); l_reg *= f; if (hi == 0) wsf[r32] = f;
                asm volatile("s_waitcnt lgkmcnt(0)" ::: "memory");
#pragma unroll
                for (int r = 0; r < 16; ++r) { const float fr_ = wsf[crow(r, hi)]; o[0][r] *= fr_; o[1][r] *= fr_; }
            }
            float sacc = 0.f;
#pragma unroll
            for (int r = 0; r < 16; ++r) { p0[r] = __builtin_amdgcn_exp2f(p0[r]); p1[r] = __builtin_amdgcn_exp2f(p1[r]); sacc += p0[r] + p1[r]; }
            l_reg += sacc;
            u32x4 pw0, pw1, pw2, pw3;
            pw0 = (u32x4){PKW(p0, 0), PKW(p0, 2), PKW(p0, 4), PKW(p0, 6)}; pw1 = (u32x4){PKW(p0, 8), PKW(p0, 10), PKW(p0, 12), PKW(p0, 14)};
            pw2 = (u32x4){PKW(p1, 0), PKW(p1, 2), PKW(p1, 4), PKW(p1, 6)}; pw3 = (u32x4){PKW(p1, 8), PKW(p1, 10), PKW(p1, 12), PKW(p1, 14)};
            SBAR();
            pv(o, vb0 + sl_cur, __builtin_bit_cast(bf16x8, pw0), __builtin_bit_cast(bf16x8, pw1), __builtin_bit_cast(bf16x8, pw2), __builtin_bit_cast(bf16x8, pw3));
        }
        { const int t_ = sl_cur; sl_cur = sl_n1; sl_n1 = sl_n2; sl_n2 = t_; }
    }
    l_reg += swap32(l_reg, hi);
    if (hi == 0) wsf[32 + r32] = l_reg; asm volatile("s_waitcnt lgkmcnt(0)" ::: "memory");
    float rli[16];
#pragma unroll
    for (int r = 0; r < 16; ++r) rli[r] = __builtin_amdgcn_rcpf(wsf[32 + crow(r, hi)]);
    store_o(o, rli, Y + (rowbase + q0 + wid * 32) * DM + 512 + h * 64, DM, shm, wid, lane, r32, hi);
    WAIT_BAR(0);
#undef DMA_KV
#undef TILE_OF
}
#undef PKW
#undef SBAR
#undef WAIT_BAR
}

constexpr size_t MiB = 1u << 20;
constexpr size_t WS_CTL = 0, CTL_ZERO_BYTES = 1 * MiB;
constexpr size_t WS_WIN = 2 * MiB;
constexpr size_t WS_WPROJ = 12 * MiB;
constexpr size_t WS_WOUT = 14 * MiB;
constexpr size_t WS_WGU = 16 * MiB;
constexpr size_t WS_WD = 144 * MiB;
constexpr size_t WS_XN = 208 * MiB;
constexpr size_t WS_QKV = 240 * MiB;
constexpr size_t WS_GATES = 336 * MiB;
constexpr size_t WS_Y = 400 * MiB;
constexpr size_t WS_MERGED = 432 * MiB;
constexpr size_t WS_H1 = 464 * MiB;
constexpr size_t WS_HN = 528 * MiB;
constexpr size_t WS_ACT = 560 * MiB;
constexpr size_t WS_YSLOT = 704 * MiB;
constexpr size_t WS_LIST = 832 * MiB;
constexpr size_t WS_TOPW = 834 * MiB;
constexpr size_t WS_KPART = 835 * MiB;
constexpr size_t WS_END = 836 * MiB;
constexpr int CW_TMO = 0, CW_CODE = 1;
constexpr int CW_CNT = 64;
constexpr int CW_BAR = 4096;

constexpr int RING_OFF = 0, RING_BYTES = 131072;
constexpr int LDSCTL_OFF = RING_BYTES;
constexpr int L_MISC = LDSCTL_OFF;
constexpr int L_CNT = LDSCTL_OFF + 128;
constexpr int L_TOFF = LDSCTL_OFF + 256;
constexpr int L_TILEE = LDSCTL_OFF + 512;
constexpr int L_HIST = LDSCTL_OFF + 2048;
constexpr int L_BASE = LDSCTL_OFF + 2176;
constexpr int L_TMP = LDSCTL_OFF + 2304;
constexpr int LDS_BYTES = LDSCTL_OFF + 8192;
constexpr int NWAVES = 8;

#define GAS __attribute__((address_space(1)))
#define LAS __attribute__((address_space(3)))
typedef unsigned short bf16;
typedef unsigned v4u __attribute__((ext_vector_type(4)));
typedef unsigned v2u __attribute__((ext_vector_type(2)));
typedef float f32x4 __attribute__((ext_vector_type(4)));
typedef GAS unsigned gu32;
#define RLX_AGENT __ATOMIC_RELAXED, __HIP_MEMORY_SCOPE_AGENT
#define LDS_WAIT() asm volatile("s_waitcnt lgkmcnt(0)" ::: "memory")
__device__ __forceinline__ unsigned f2bf(float f) { unsigned u = __builtin_bit_cast(unsigned, f); return (u + 0x7fffu + ((u >> 16) & 1u)) >> 16; }
__device__ __forceinline__ unsigned pk2(float lo, float hi) { return f2bf(lo) | (f2bf(hi) << 16); }

#define XB_TMO      128
#define XB_XCNT(j)  (256  + 64 * (j))
#define XB_XSUB(j)  (1280 + 64 * (j))
#define XB_XGEN(j)  (2304 + 64 * (j))
#define XB_TOP      3328
#define XB_TOPGEN   3392
#define XCD_BAR_WORDS 3456
#define XB_SPIN_CAP (1u << 18)
__device__ __forceinline__ unsigned xb_ld(unsigned* p)              { return __hip_atomic_load(p, __ATOMIC_RELAXED, __HIP_MEMORY_SCOPE_AGENT); }
__device__ __forceinline__ unsigned xb_add(unsigned* p, unsigned v) { return __hip_atomic_fetch_add(p, v, __ATOMIC_RELAXED, __HIP_MEMORY_SCOPE_AGENT); }
__device__ __forceinline__ unsigned xb_xcc_id() { return (unsigned)__builtin_amdgcn_s_getreg((3 << 11) | 20) & 0xFu; }
#define XB_SPIN(cond, bar) do { unsigned _sp = 0; while (cond) { __builtin_amdgcn_s_sleep(1); \
    if ((++_sp & 255u) == 0u) { if (xb_ld(&(bar)[XB_TMO])) break; if (_sp > XB_SPIN_CAP) { atomicAdd(&(bar)[XB_TMO], 1u); break; } } } } while (0)
struct XcdBarrier { unsigned* bar; unsigned x; volatile LAS unsigned* st; };
__device__ __forceinline__ XcdBarrier xcd_barrier_post(unsigned* bar, volatile LAS unsigned* st) {
    XcdBarrier b; b.bar = bar; b.x = xb_xcc_id(); b.st = st;
    if (threadIdx.x == 0) (void)xb_add(&bar[XB_XCNT(b.x)], 1u);
    return b;
}
__device__ __forceinline__ void xcd_barrier_complete(unsigned* bar, unsigned x, unsigned& nloc, unsigned& nx) {
    const unsigned G = gridDim.x * gridDim.y * gridDim.z;
    unsigned sum, cnt, mine, sp = 0u;
    for (;;) {
        sum = 0u; cnt = 0u; mine = 0u;
#pragma unroll
        for (unsigned j = 0; j < 16; ++j) { const unsigned c = xb_ld(&bar[XB_XCNT(j)]); sum += c; cnt += (c > 0u) ? 1u : 0u; mine = (j == x) ? c : mine; }
        if (sum == G) break;
        __builtin_amdgcn_s_sleep(1);
        if ((++sp & 255u) == 0u) { if (xb_ld(&bar[XB_TMO])) break; if (sp > XB_SPIN_CAP) { atomicAdd(&bar[XB_TMO], 1u); break; } }
    }
    nloc = mine > 0u ? mine : 1u; nx = cnt > 0u ? cnt : 1u;
}
__device__ __forceinline__ void xcd_barrier(const XcdBarrier& b) {
    asm volatile("s_waitcnt vmcnt(0)" ::: "memory");
    __syncthreads();
    if (threadIdx.x == 0) {
        unsigned* bar = b.bar;
        __builtin_amdgcn_s_waitcnt(0);
        unsigned nloc = b.st[0], nx = b.st[1];
        if (nloc == 0u) { xcd_barrier_complete(bar, b.x, nloc, nx); b.st[0] = nloc; b.st[1] = nx; }
        const unsigned old = xb_add(&bar[XB_XSUB(b.x)], 1u);
        const unsigned gen = old / nloc;
        if (old + 1u == (gen + 1u) * nloc) {
            __builtin_amdgcn_fence(__ATOMIC_RELEASE, "agent");
            asm volatile("s_waitcnt vmcnt(0)" ::: "memory");
            const unsigned og = xb_add(&bar[XB_TOP], 1u);
            const unsigned tg = og / nx;
            if (og + 1u == (tg + 1u) * nx) xb_add(&bar[XB_TOPGEN], 1u);
            else XB_SPIN(xb_ld(&bar[XB_TOPGEN]) == tg, bar);
            __builtin_amdgcn_fence(__ATOMIC_ACQUIRE, "agent");
            xb_add(&bar[XB_XGEN(b.x)], 1u);
            asm volatile("s_waitcnt vmcnt(0)" ::: "memory");
        } else {
            XB_SPIN(xb_ld(&bar[XB_XGEN(b.x)]) == gen, bar);
            __builtin_amdgcn_fence(__ATOMIC_ACQUIRE, "agent");
            asm volatile("s_waitcnt vmcnt(0)" ::: "memory");
        }
    }
    __syncthreads();
}

struct Frame {
    LAS unsigned char* lds; gu32* ctl; int tid, lane, wave, vcu, G;
    const float *x, *norm_mix_g, *w_in, *w_proj_sb, *w_proj_moba, *w_out, *rel_bias, *norm_ffn_g, *w_router, *b_router, *w_gate_up, *b_gate_up, *w_down, *b_down, *norm_final_g;
    float* out; unsigned char* ws;
};
__device__ __forceinline__ float wave_sum(float v) {
#pragma unroll
    for (int o = 1; o < 64; o <<= 1) v += __shfl_xor(v, o);
    return v;
}
__device__ __forceinline__ void p0_transpose_item(const float* W, int ldw, int k0, int n0, bf16* WT, int ldt, int dst_row0, int kdst0, LAS float* scr, int lane) {
#pragma unroll 8
    for (int i = 0; i < 32; ++i) { const int kk = 2 * i + (lane >> 5); scr[kk * 33 + (lane & 31)] = W[(size_t)(k0 + kk) * ldw + n0 + (lane & 31)]; }
    LDS_WAIT(); asm volatile("" ::: "memory");
    const int c = lane & 7;
#pragma unroll
    for (int j = 0; j < 4; ++j) { const int n = (lane >> 3) + 8 * j; const LAS float* s = scr + (8 * c) * 33 + n;
        v4u o; o.x = pk2(s[0 * 33], s[1 * 33]); o.y = pk2(s[2 * 33], s[3 * 33]); o.z = pk2(s[4 * 33], s[5 * 33]); o.w = pk2(s[6 * 33], s[7 * 33]);
        *(GAS v4u*)(WT + (size_t)(dst_row0 + n) * ldt + kdst0 + k0 + 8 * c) = o; }
    LDS_WAIT(); asm volatile("" ::: "memory");
}
__device__ __forceinline__ void rms_row_to_bf16(const float* xrow, const f32x4 (&g)[4], bf16* orow, int lane) {
    const GAS f32x4* xr = (const GAS f32x4*)xrow + lane;
    f32x4 v[4]; float s = 0.f;
#pragma unroll
    for (int j = 0; j < 4; ++j) { v[j] = xr[64 * j]; s += (v[j].x * v[j].x + v[j].y * v[j].y) + (v[j].z * v[j].z + v[j].w * v[j].w); }
    const float rstd = 1.0f / sqrtf(wave_sum(s) * (1.0f / DM) + RMS_EPS);
    GAS unsigned long long* o8 = (GAS unsigned long long*)orow + lane;
#pragma unroll
    for (int j = 0; j < 4; ++j) { const f32x4 y = v[j] * rstd * g[j]; o8[64 * j] = (unsigned long long)pk2(y.x, y.y) | ((unsigned long long)pk2(y.z, y.w) << 32); }
}
__device__ __forceinline__ void p0_prologue(Frame& F) {
    LAS float* scr = (LAS float*)(F.lds + RING_OFF + F.wave * 16384);
    const int gw = F.vcu * NWAVES + F.wave, NGW = F.G * NWAVES;
    bf16* WIN = (bf16*)(F.ws + WS_WIN); bf16* WPROJ = (bf16*)(F.ws + WS_WPROJ); bf16* WOUT = (bf16*)(F.ws + WS_WOUT); bf16* WGU = (bf16*)(F.ws + WS_WGU); bf16* WD = (bf16*)(F.ws + WS_WD);
    constexpr int I_IN = 16 * 160, I_PS = 8 * 32, I_PM = 8 * 32, I_OUT = 16 * 32, I_GU = 32 * 16 * 64, I_D = 32 * 16 * 32;
    constexpr int NITEMS = I_IN + I_PS + I_PM + I_OUT + I_GU + I_D;
    for (int it = gw; it < NITEMS; it += NGW) {
        int r = it;
        if (r < I_GU) { const int e = r >> 10, q = r & 1023, kb = q >> 6, nb = q & 63, n0 = 32 * nb;
            const int cc = n0 & 1023, drow = (cc >> 7) * 256 + (n0 >= 1024 ? 128 : 0) + (cc & 127);
            p0_transpose_item(F.w_gate_up + (size_t)e * 1024 * 2048, 2048, 64 * kb, n0, WGU + (size_t)e * 2048 * 1024, 1024, drow - 0, 0, scr, F.lane); continue; } r -= I_GU;
        if (r < I_D) { const int e = r >> 9, q = r & 511, kb = q >> 5, nb = q & 31;
            p0_transpose_item(F.w_down + (size_t)e * 1024 * 1024, 1024, 64 * kb, 32 * nb, WD + (size_t)e * 1024 * 1024, 1024, 32 * nb, 0, scr, F.lane); continue; } r -= I_D;
        if (r < I_IN) { const int kb = r / 160, nb = r % 160; p0_transpose_item(F.w_in, DIN, 64 * kb, 32 * nb, WIN, 1024, 32 * nb, 0, scr, F.lane); continue; } r -= I_IN;
        if (r < I_PS) { const int kb = r >> 5, nb = r & 31; p0_transpose_item(F.w_proj_sb, 1024, 64 * kb, 32 * nb, WPROJ, 1024, 32 * nb, 0, scr, F.lane); continue; } r -= I_PS;
        if (r < I_PM) { const int kb = r >> 5, nb = r & 31; p0_transpose_item(F.w_proj_moba, 1024, 64 * kb, 32 * nb, WPROJ, 1024, 32 * nb, 512, scr, F.lane); continue; } r -= I_PM;
        { const int kb = r >> 5, nb = r & 31; p0_transpose_item(F.w_out, 1024, 64 * kb, 32 * nb, WOUT, 1024, 32 * nb, 0, scr, F.lane); }
    }
    f32x4 g[4];
#pragma unroll
    for (int j = 0; j < 4; ++j) g[j] = ((const f32x4*)F.norm_mix_g)[F.lane + 64 * j];
    bf16* XN = (bf16*)(F.ws + WS_XN);
    for (int m = gw; m < T_TOK; m += NGW) rms_row_to_bf16(F.x + (size_t)m * DM, g, XN + (size_t)m * DM, F.lane);
}

__device__ __forceinline__ void p5_router(Frame& F) {
    LAS float* wT = (LAS float*)(F.lds + RING_OFF);
    LAS int* hist = (LAS int*)(F.lds + L_HIST); LAS int* basel = (LAS int*)(F.lds + L_BASE); LAS int* tmp = (LAS int*)(F.lds + L_TMP);
    const int tid = F.tid, lane = F.lane;
    for (int kk = tid; kk < DM; kk += NWAVES * 64) {
#pragma unroll
        for (int q = 0; q < 8; ++q) { const f32x4 v = *(const f32x4*)(F.w_router + (size_t)kk * 32 + 4 * q);
            wT[(4 * q + 0) * DM + kk] = v.x; wT[(4 * q + 1) * DM + kk] = v.y; wT[(4 * q + 2) * DM + kk] = v.z; wT[(4 * q + 3) * DM + kk] = v.w; } }
    if (tid < 32) hist[tid] = 0;
    __syncthreads();
    f32x4 g[4];
#pragma unroll
    for (int j = 0; j < 4; ++j) g[j] = ((const f32x4*)F.norm_ffn_g)[lane + 64 * j];
    const float* H1 = (const float*)(F.ws + WS_H1); bf16* HN = (bf16*)(F.ws + WS_HN); float* topw = (float*)(F.ws + WS_TOPW); int* list = (int*)(F.ws + WS_LIST);
    const float brt = F.b_router[lane >> 1];
    const int hi5 = lane & 32, b4 = lane & 16, b3 = lane & 8, b2 = lane & 4, b1 = lane & 2;
#pragma unroll 1
    for (int rb = F.vcu; rb < T_TOK / 64; rb += F.G) {
#pragma unroll 1
        for (int rp = 0; rp < 4; ++rp) {
            const int rl0 = F.wave * 8 + rp * 2; const int row0 = rb * 64 + rl0;
            f32x4 hn[2][4];
#pragma unroll
            for (int r = 0; r < 2; ++r) { const GAS f32x4* xr = (const GAS f32x4*)(H1 + (size_t)(row0 + r) * DM) + lane; float s = 0.f;
#pragma unroll
                for (int j = 0; j < 4; ++j) { hn[r][j] = xr[64 * j]; s += (hn[r][j].x * hn[r][j].x + hn[r][j].y * hn[r][j].y) + (hn[r][j].z * hn[r][j].z + hn[r][j].w * hn[r][j].w); }
                const float rstd = 1.0f / sqrtf(wave_sum(s) * (1.0f / DM) + RMS_EPS);
                GAS unsigned long long* o8 = (GAS unsigned long long*)(HN + (size_t)(row0 + r) * DM) + lane;
#pragma unroll
                for (int j = 0; j < 4; ++j) { hn[r][j] = hn[r][j] * rstd * g[j]; o8[64 * j] = (unsigned long long)pk2(hn[r][j].x, hn[r][j].y) | ((unsigned long long)pk2(hn[r][j].z, hn[r][j].w) << 32); } }
            float acc[2][32];
#pragma unroll
            for (int e = 0; e < 32; ++e) { acc[0][e] = 0.f; acc[1][e] = 0.f; }
#pragma unroll
            for (int j = 0; j < 4; ++j)
#pragma unroll
                for (int eb = 0; eb < 32; eb += 8) {
#pragma unroll
                    for (int e = eb; e < eb + 8; ++e) { const f32x4 w = *(const LAS f32x4*)(wT + e * DM + 4 * (lane + 64 * j));
                        acc[0][e] += hn[0][j].x * w.x + hn[0][j].y * w.y + hn[0][j].z * w.z + hn[0][j].w * w.w;
                        acc[1][e] += hn[1][j].x * w.x + hn[1][j].y * w.y + hn[1][j].z * w.z + hn[1][j].w * w.w;
                        asm volatile("" : "+v"(acc[0][e]), "+v"(acc[1][e])); }
                    asm volatile("" ::: "memory"); }
#pragma unroll
            for (int r = 0; r < 2; ++r) {
                float b16[16], b8[8], b4v[4], b2v[2];
#pragma unroll
                for (int i = 0; i < 16; ++i) { const float send = hi5 ? acc[r][i] : acc[r][i + 16], keep = hi5 ? acc[r][i + 16] : acc[r][i]; b16[i] = keep + __shfl_xor(send, 32); }
#pragma unroll
                for (int i = 0; i < 8; ++i) { const float send = b4 ? b16[i] : b16[i + 8], keep = b4 ? b16[i + 8] : b16[i]; b8[i] = keep + __shfl_xor(send, 16); }
#pragma unroll
                for (int i = 0; i < 4; ++i) { const float send = b3 ? b8[i] : b8[i + 4], keep = b3 ? b8[i + 4] : b8[i]; b4v[i] = keep + __shfl_xor(send, 8); }
#pragma unroll
                for (int i = 0; i < 2; ++i) { const float send = b2 ? b4v[i] : b4v[i + 2], keep = b2 ? b4v[i + 2] : b4v[i]; b2v[i] = keep + __shfl_xor(send, 4); }
                float val; { const float send = b1 ? b2v[0] : b2v[1], keep = b1 ? b2v[1] : b2v[0]; val = keep + __shfl_xor(send, 2); }
                val += __shfl_xor(val, 1);
                val += brt;
                const int myidx = lane >> 1; float v = val; float selv[4]; int seli[4];
#pragma unroll
                for (int k = 0; k < 4; ++k) { float m = v;
#pragma unroll
                    for (int o = 2; o < 64; o <<= 1) m = fmaxf(m, __shfl_xor(m, o));
                    int cand = (v == m) ? myidx : 99;
#pragma unroll
                    for (int o = 2; o < 64; o <<= 1) { const int oc = __shfl_xor(cand, o); cand = oc < cand ? oc : cand; }
                    selv[k] = m; seli[k] = cand; if (myidx == cand) v = -INFINITY; }
                const float e1 = __expf(selv[1] - selv[0]), e2 = __expf(selv[2] - selv[0]), e3 = __expf(selv[3] - selv[0]); const float inv = 1.0f / (1.0f + e1 + e2 + e3);
                if (lane < 4) { const int k = lane; const int ex = k == 0 ? seli[0] : k == 1 ? seli[1] : k == 2 ? seli[2] : seli[3]; const float wk = (k == 0 ? 1.0f : k == 1 ? e1 : k == 2 ? e2 : e3) * inv;
                    const int slot = __hip_atomic_fetch_add(hist + ex, 1, __ATOMIC_RELAXED, __HIP_MEMORY_SCOPE_WORKGROUP);
                    tmp[(rl0 + r) * 4 + k] = ex | (slot << 8);
                    topw[(size_t)(row0 + r) * 4 + k] = wk; }
            }
        }
        __syncthreads();
        if (tid < 32) basel[tid] = (int)__hip_atomic_fetch_add((unsigned*)(F.ctl + CW_CNT + tid), (unsigned)hist[tid], RLX_AGENT);
        __syncthreads();
        if (tid < 256) { const int t = tmp[tid]; const int ex = t & 255, slot = t >> 8; list[(size_t)ex * LIST_CAP + basel[ex] + slot] = (rb * 64 + (tid >> 2)) * 4 + (tid & 3); }
        __syncthreads();
        if (tid < 32) hist[tid] = 0;
        __syncthreads();
    }
}
__device__ __forceinline__ int moe_tables(Frame& F) {
    LAS int* cnt = (LAS int*)(F.lds + L_CNT); LAS int* toff = (LAS int*)(F.lds + L_TOFF); LAS int* tile_e = (LAS int*)(F.lds + L_TILEE);
    __syncthreads();
    if (F.tid < 32) { const int e = F.tid; int off = 0, mine = 0;
        for (int j = 0; j < 32; ++j) { const int c = (int)__hip_atomic_load((unsigned*)(F.ctl + CW_CNT + j), RLX_AGENT); const int c2 = c > LIST_CAP ? LIST_CAP : c; const int ntl = (c2 + 255) >> 8; if (j < e) off += ntl; if (j == e) mine = c2; }
        cnt[e] = mine; toff[e] = off; const int ntl = (mine + 255) >> 8; if (e == 31) toff[32] = off + ntl;
        for (int t = 0; t < ntl; ++t) if (off + t < MAX_TILES) tile_e[off + t] = e; }
    __syncthreads();
    int NT = toff[32]; return NT > MAX_TILES ? MAX_TILES : NT;
}
__device__ __forceinline__ void p8_final(Frame& F) {
    const int gw = F.vcu * NWAVES + F.wave, NGW = F.G * NWAVES, lane = F.lane;
    f32x4 g[4];
#pragma unroll
    for (int j = 0; j < 4; ++j) g[j] = ((const f32x4*)F.norm_final_g)[lane + 64 * j];
    const float* H1 = (const float*)(F.ws + WS_H1); const bf16* YS = (const bf16*)(F.ws + WS_YSLOT);
#if PROBE_DUMP
    {
        const bf16* src = (const bf16*)(F.ws + PROBE_DUMP_OFF);
        for (int m = gw; m < T_TOK; m += NGW) { GAS f32x4* o = (GAS f32x4*)(F.out + (size_t)m * DM) + lane;
#pragma unroll
            for (int j = 0; j < 4; ++j) { const v2u w = *((const GAS v2u*)(src + (size_t)m * PROBE_DUMP_LD + PROBE_DUMP_C0) + lane + 64 * j); o[64 * j] = (f32x4){__uint_as_float(w.x << 16), __uint_as_float(w.x & 0xffff0000u), __uint_as_float(w.y << 16), __uint_as_float(w.y & 0xffff0000u)}; } }
        return;
    }
#endif
    for (int m = gw; m < T_TOK; m += NGW) {
        const GAS f32x4* xr = (const GAS f32x4*)(H1 + (size_t)m * DM) + lane; f32x4 v[4];
#pragma unroll
        for (int j = 0; j < 4; ++j) v[j] = xr[64 * j];
#pragma unroll
        for (int k = 0; k < PROBE_NSLOT; ++k) { const GAS v2u* yr = (const GAS v2u*)(YS + (size_t)(m * 4 + k) * DM) + lane;
#pragma unroll
            for (int j = 0; j < 4; ++j) { const v2u w = yr[64 * j]; v[j].x += __uint_as_float(w.x << 16); v[j].y += __uint_as_float(w.x & 0xffff0000u); v[j].z += __uint_as_float(w.y << 16); v[j].w += __uint_as_float(w.y & 0xffff0000u); } }
        float s = 0.f;
#pragma unroll
        for (int j = 0; j < 4; ++j) s += (v[j].x * v[j].x + v[j].y * v[j].y) + (v[j].z * v[j].z + v[j].w * v[j].w);
        const float rstd = 1.0f / sqrtf(wave_sum(s) * (1.0f / DM) + RMS_EPS);
        GAS f32x4* o = (GAS f32x4*)(F.out + (size_t)m * DM) + lane;
#pragma unroll
        for (int j = 0; j < 4; ++j) o[64 * j] = v[j] * rstd * g[j];
    }
}

constexpr int N_PHASES = 9;
struct Args { const float* in[15]; float* out; unsigned char* ws; int ph_lo, ph_hi; };
__global__ void __launch_bounds__(NWAVES * 64, 2) fwd_kernel(Args args) {
    extern __shared__ __attribute__((aligned(16))) unsigned char lds[];
    Frame F;
    F.lds = (LAS unsigned char*)lds;
    F.tid = threadIdx.x; F.lane = F.tid & 63; F.wave = __builtin_amdgcn_readfirstlane(F.tid >> 6);
    F.G = gridDim.x; { const int bx = blockIdx.x; F.vcu = (F.G % 8 == 0) ? (bx % 8) * (F.G / 8) + bx / 8 : bx; }
    F.ws = args.ws; F.ctl = (gu32*)(args.ws + WS_CTL); F.out = args.out;
    F.x = args.in[0]; F.norm_mix_g = args.in[1]; F.w_in = args.in[2]; F.w_proj_sb = args.in[3]; F.w_proj_moba = args.in[4]; F.w_out = args.in[5]; F.rel_bias = args.in[6]; F.norm_ffn_g = args.in[7];
    F.w_router = args.in[8]; F.b_router = args.in[9]; F.w_gate_up = args.in[10]; F.b_gate_up = args.in[11]; F.w_down = args.in[12]; F.b_down = args.in[13]; F.norm_final_g = args.in[14];
    for (int u = F.tid; u < (LDS_BYTES - LDSCTL_OFF) / 4; u += NWAVES * 64) ((LAS unsigned*)(F.lds + LDSCTL_OFF))[u] = 0u;
    __syncthreads();
    XcdBarrier bar; bar.bar = (unsigned*)(F.ctl + CW_BAR); bar.x = 0; bar.st = nullptr;
    if (MK_N_LAUNCHES == 1) bar = xcd_barrier_post((unsigned*)(F.ctl + CW_BAR), (volatile LAS unsigned*)(F.lds + L_MISC) + 8);
#define GRID_BAR() do { if (MK_N_LAUNCHES == 1) xcd_barrier(bar); } while (0)
    const int lo = args.ph_lo, hi = args.ph_hi;
#ifndef PH_MASK
#define PH_MASK 0x1ff
#endif
#define IN(k) ((((PH_MASK) >> (k)) & 1) && lo <= (k) && (k) < hi)
#define BOTH(k) (IN(k) && IN((k) + 1))
    unsigned char* ws = args.ws;

    if (IN(0)) { p0_prologue(F); if (BOTH(0)) GRID_BAR(); }

    if (IN(1)) {
        pg8::DenseOrder S{T_TOK / 256, DIN / 256, F.G, (int)blockIdx.x, (const char*)(ws + WS_XN), (const char*)(ws + WS_WIN), (size_t)256 * DM * 2, (size_t)256 * DM * 2};
        pg8::EpiInProj E{(bf16*)(ws + WS_QKV), (bf16*)(ws + WS_GATES), (float*)(ws + WS_KPART)};
        pg8::gemm_phase<pg8::EpiInProj, pg8::DenseOrder, true, false>(F.lds + RING_OFF, S, E, DM, DM, DM);
        if (BOTH(1)) GRID_BAR();
    }

    if (IN(2)) {
        const att::bf16* QKV = (const att::bf16*)(ws + WS_QKV); att::bf16* Y = (att::bf16*)(ws + WS_Y);
        for (int v = F.vcu; v < 256; v += F.G) {
            const int bh = v >> 2, s = v & 3, b = bh >> 3, h = bh & 7;
#ifndef NO_MOBA
            att::moba_unit(b, h, 7 - s, QKV, Y, (const float*)(ws + WS_KPART), F.rel_bias, (char*)lds + RING_OFF);
            att::moba_unit(b, h, s, QKV, Y, (const float*)(ws + WS_KPART), F.rel_bias, (char*)lds + RING_OFF);
#endif
#ifndef NO_SB
            att::sb_unit(b, h, 7 - s, QKV, Y, (char*)lds + RING_OFF);
            att::sb_unit(b, h, s, QKV, Y, (char*)lds + RING_OFF);
#endif
        }
        if (BOTH(2)) GRID_BAR();
    }

    if (IN(3)) {
        pg8::ProjOrder S{F.G, (int)blockIdx.x, (const char*)(ws + WS_Y), (const char*)(ws + WS_WPROJ)};
        pg8::EpiProjGate E{(const bf16*)(ws + WS_GATES), (bf16*)(ws + WS_MERGED)};
        pg8::gemm_phase<pg8::EpiProjGate, pg8::ProjOrder, true, false>(F.lds + RING_OFF, S, E, 512, DM, DM);
        if (BOTH(3)) GRID_BAR();
    }

    if (IN(4)) {
        pg8::DenseOrder S{T_TOK / 256, DM / 256, F.G, (int)blockIdx.x, (const char*)(ws + WS_MERGED), (const char*)(ws + WS_WOUT), (size_t)256 * DM * 2, (size_t)256 * DM * 2};
        pg8::EpiResF32 E{F.x, (float*)(ws + WS_H1)};
        pg8::gemm_phase<pg8::EpiResF32, pg8::DenseOrder, true, false>(F.lds + RING_OFF, S, E, DM, DM, DM);
        if (BOTH(4)) GRID_BAR();
    }

    if (IN(5)) { p5_router(F); if (BOTH(5)) GRID_BAR(); }

    if (IN(6)) {
        const int NT = moe_tables(F);
        pg8::MoeOrder S{NT, 8, F.G, (int)blockIdx.x, (const LAS int*)(F.lds + L_TILEE), (const LAS int*)(F.lds + L_TOFF), (const LAS int*)(F.lds + L_CNT),
                        (const char*)(ws + WS_HN), (const char*)(ws + WS_WGU), (size_t)256 * DM * 2, (size_t)256 * DM * 2, (size_t)2048 * DM * 2, (const int*)(ws + WS_LIST), DM, true};
        pg8::EpiSwiglu E{F.b_gate_up, (bf16*)(ws + WS_ACT)};
        pg8::gemm_phase<pg8::EpiSwiglu, pg8::MoeOrder, true, true>(F.lds + RING_OFF, S, E, DM, DM, DM);
        if (BOTH(6)) GRID_BAR();
    }

    if (IN(7)) {
        const int NT = moe_tables(F);
        pg8::MoeOrder S{NT, 4, F.G, (int)blockIdx.x, (const LAS int*)(F.lds + L_TILEE), (const LAS int*)(F.lds + L_TOFF), (const LAS int*)(F.lds + L_CNT),
                        (const char*)(ws + WS_ACT), (const char*)(ws + WS_WD), (size_t)256 * DM * 2, (size_t)256 * DM * 2, (size_t)1024 * DM * 2, (const int*)(ws + WS_LIST), DM, false};
        pg8::EpiDown E{F.b_down, (const int*)(ws + WS_LIST), (const LAS int*)(F.lds + L_CNT), (const float*)(ws + WS_TOPW), (bf16*)(ws + WS_YSLOT)};
        pg8::gemm_phase<pg8::EpiDown, pg8::MoeOrder, true, false>(F.lds + RING_OFF, S, E, DM, DM, DM);
        if (BOTH(7)) GRID_BAR();
    }

    if (IN(8)) { p8_final(F); }
#undef IN
#undef BOTH
#undef GRID_BAR
}

extern "C" void kernel_launch(void* const* d_in, const int* in_sizes, int n_in, void* d_out, int out_size, void* d_ws, size_t ws_size, hipStream_t stream) {
    static int grid = 0;
    if (grid == 0) {
        if (n_in != 15 || in_sizes[0] != T_TOK * DM || out_size != T_TOK * DM || ws_size < WS_END) { fprintf(stderr, "kernel_launch: unexpected shapes (n_in %d, in0 %d, out %d, ws %zu); nothing launched\n", n_in, n_in > 0 ? in_sizes[0] : -1, out_size, ws_size); grid = -1; return; }
        int dev = 0, cus = 0, per_cu = 0;
        if (hipGetDevice(&dev) != hipSuccess || hipDeviceGetAttribute(&cus, hipDeviceAttributeMultiprocessorCount, dev) != hipSuccess) { grid = -1; return; }
        if (hipFuncSetAttribute((const void*)fwd_kernel, hipFuncAttributeMaxDynamicSharedMemorySize, LDS_BYTES) != hipSuccess) { fprintf(stderr, "kernel_launch: hipFuncSetAttribute failed\n"); grid = -1; return; }
        if (hipOccupancyMaxActiveBlocksPerMultiprocessor(&per_cu, (const void*)fwd_kernel, NWAVES * 64, LDS_BYTES) != hipSuccess || per_cu < 1) { fprintf(stderr, "kernel_launch: occupancy query reports %d workgroups per CU\n", per_cu); }
        (void)hipGetLastError();
        grid = cus;
    }
    if (grid < 0) return;
    if (hipMemsetAsync((char*)d_ws + WS_CTL, 0, CTL_ZERO_BYTES, stream) != hipSuccess) return;
    Args a{};
    for (int i = 0; i < 15; ++i) a.in[i] = (const float*)d_in[i];
    a.out = (float*)d_out; a.ws = (unsigned char*)d_ws;
    if (MK_N_LAUNCHES == 1) { a.ph_lo = 0; a.ph_hi = N_PHASES; hipLaunchKernelGGL(fwd_kernel, dim3(grid), dim3(NWAVES * 64), LDS_BYTES, stream, a); }
    else { for (int p = 0; p < N_PHASES; ++p) { a.ph_lo = p; a.ph_hi = p + 1; hipLaunchKernelGGL(fwd_kernel, dim3(grid), dim3(NWAVES * 64), LDS_BYTES, stream, a); } }
}
```

```cpp
#include <hip/hip_runtime.h>
#include <cstdio>
#include <cstdint>
#include <cmath>

#ifndef PROBE_DUMP
#define PROBE_DUMP 0
#define PROBE_DUMP_OFF WS_GATES
#define PROBE_DUMP_LD 2048
#define PROBE_DUMP_C0 0
#endif
#ifndef PROBE_REP
#define PROBE_REP 0
#endif
#ifndef PROBE_NSLOT
#define PROBE_NSLOT 4
#endif
#ifndef MK_N_LAUNCHES
#define MK_N_LAUNCHES 1
#endif

constexpr int T_TOK = 16384, DM = 1024, DIN = 5120, NEXP = 32, TOPK = 4, SEQ = 2048, NBATCH = 8, NHEAD = 8;
constexpr int QKV_LD = 3072, GATE_LD = 2048;
#ifndef MOE_FP8_SW
#define MOE_FP8_SW 1
#endif
constexpr bool MOE_FP8 = MOE_FP8_SW != 0;
constexpr int MOE_ES = MOE_FP8 ? 1 : 2;
constexpr float MOE_WSCALE = MOE_FP8 ? 64.0f : 1.0f, MOE_WINV = MOE_FP8 ? (1.0f / 64.0f) : 1.0f;
constexpr float C2F = 0.125f * 1.4426950408889634f;
constexpr float LOG2E = 1.4426950408889634f;
constexpr float RMS_EPS = 1e-6f;
constexpr int LIST_CAP = 16384;
constexpr int MAX_TILES = 288;

namespace pg8 {
#define PG8_LAS __attribute__((address_space(3)))
typedef unsigned short bf16_t;
typedef short bf16x8 __attribute__((ext_vector_type(8)));
typedef float f32x4 __attribute__((ext_vector_type(4)));
typedef float f32x2 __attribute__((ext_vector_type(2)));
typedef unsigned u32x4 __attribute__((ext_vector_type(4)));
typedef unsigned u32x2 __attribute__((ext_vector_type(2)));
constexpr int BM = 256, BK = 64, HALF = 128, HTB = HALF * BK * 2, STAGE_BYTES = 8 * HTB, NXCD = 8, WGM = 8;

__host__ __device__ __forceinline__ int lds_byte(int r, int c) { const int st = (r >> 4) * 2 + (c >> 5), rr = r & 15, cc = c & 31, ob = rr * 64 + cc * 2; return st * 1024 + (ob ^ (((ob >> 9) & 1) << 5)); }
__host__ __device__ __forceinline__ void stage_rc(int b, int& R, int& C) { const int st = b / 1024, sb = b % 1024, swz = sb ^ (((sb >> 9) & 1) << 5); R = (st >> 1) * 16 + swz / 64; C = (st & 1) * 32 + (swz % 64) / 2; }
__host__ __device__ __forceinline__ int perm32(int rho) { const int n = rho >> 4, i = rho & 15; return 8 * (i >> 2) + 4 * n + (i & 3); }

typedef int i32x8 __attribute__((ext_vector_type(8)));
typedef int i32x4 __attribute__((ext_vector_type(4)));
__device__ __forceinline__ i32x8 pk32(bf16x8 lo, bf16x8 hi) { const i32x4 a = __builtin_bit_cast(i32x4, lo), b = __builtin_bit_cast(i32x4, hi); return (i32x8){a[0], a[1], a[2], a[3], b[0], b[1], b[2], b[3]}; }
struct Unit { int pm, pn, e, aux; };

__device__ __forceinline__ bool static_tile(int i, int G, int c, int nM, int nN, int& pm, int& pn) {
    const int nwg = nM * nN; const long L = (long)i * G + c; if (L >= nwg) return false;
    int wgid = (int)L; { const int q = nwg / NXCD, r = nwg % NXCD, xcd = wgid % NXCD, off = wgid / NXCD; wgid = (xcd < r ? xcd * (q + 1) : r * (q + 1) + (xcd - r) * q) + off; }
    const int nig = WGM * nN, gid = wgid / nig, fm = gid * WGM, gsz = (nM - fm) < WGM ? (nM - fm) : WGM;
    pm = fm + ((wgid % nig) % gsz); pn = (wgid % nig) / gsz; return true;
}

typedef __bf16 bf16x2_t __attribute__((ext_vector_type(2)));
__device__ __forceinline__ unsigned cvt_pk_bf16(float lo, float hi) { f32x2 v = {lo, hi}; bf16x2_t b = __builtin_convertvector(v, bf16x2_t); return __builtin_bit_cast(unsigned, b); }
__device__ __forceinline__ unsigned pk4_fp8(float a, float b, float c, float d) { int p = __builtin_amdgcn_cvt_pk_fp8_f32(a, b, 0, false); p = __builtin_amdgcn_cvt_pk_fp8_f32(c, d, p, true); return (unsigned)p; }
__device__ __forceinline__ float bf_lo(unsigned w) { return __uint_as_float(w << 16); }
__device__ __forceinline__ float bf_hi(unsigned w) { return __uint_as_float(w & 0xffff0000u); }

template <class Epi, class Sched, bool ALIGN_EPI, bool GATHER, bool FP8 = false>
__device__ __forceinline__ void gemm_phase(PG8_LAS unsigned char* lds, const Sched& S, const Epi& E, const int KB, const int ldaB, const int ldbB) {
    const int tid = threadIdx.x, wid = __builtin_amdgcn_readfirstlane(tid >> 6), lane = tid & 63, wr = wid >> 2, wc = wid & 3, fr = lane & 15, fq = lane >> 4;
    const int nt = KB / (BK * 2);
    unsigned voA[2][2], voN[2][2], voffB[2]; int RA[2], CA[2];
#pragma unroll
    for (int i = 0; i < 2; ++i) { int R, C; stage_rc(tid * 16 + i * 8192, R, C); const int Rb = Epi::PERM ? ((R & ~31) + perm32(R & 31)) : R;
        RA[i] = R; CA[i] = C; voffB[i] = (unsigned)(Rb * ldbB + C * 2);
#pragma unroll
        for (int h = 0; h < 2; ++h) voA[h][i] = (unsigned)((h * HALF + R) * ldaB + C * 2); }
    const size_t kstep = (size_t)(BK * 2);
    const size_t hstepB = (size_t)HALF * ldbB;
    const unsigned ldsw = (unsigned)wid * 1024u;
    const int aoff = lds_byte(wr * 64 + fr, fq * 8), boff = lds_byte(wc * 32 + fr, fq * 8);
#define PG8_SA(b, h) (((b) * 2 + (h)) * HTB)
#define PG8_SB(b, h) ((4 + (b) * 2 + (h)) * HTB)
#define PG8_STAGE(bufoff, gbase, voff) do { _Pragma("unroll") for (int _i = 0; _i < 2; ++_i) \
        __builtin_amdgcn_global_load_lds((const unsigned*)((const char*)(gbase) + (voff)[_i]), (PG8_LAS unsigned*)(lds + (bufoff) + ldsw + _i * 8192), 16, 0, 0); } while (0)
#define PG8_LD8(dst, off) do { const i32x4 _lo = *(const PG8_LAS i32x4*)(lds + (off)); const i32x4 _hi = *(const PG8_LAS i32x4*)(lds + (off) + 1024); dst = __builtin_shufflevector(_lo, _hi, 0, 1, 2, 3, 4, 5, 6, 7); } while (0)
#define PG8_LDA(dst, b, h) do { _Pragma("unroll") for (int m = 0; m < 4; ++m) PG8_LD8(dst[m], PG8_SA(b, h) + aoff + m * 2048); } while (0)
#define PG8_LDB(dst, b, h) do { _Pragma("unroll") for (int n = 0; n < 2; ++n) PG8_LD8(dst[n], PG8_SB(b, h) + boff + n * 2048); } while (0)
#define PG8_LO(x) __builtin_bit_cast(bf16x8, __builtin_shufflevector(x, x, 0, 1, 2, 3))
#define PG8_HI(x) __builtin_bit_cast(bf16x8, __builtin_shufflevector(x, x, 4, 5, 6, 7))
#define PG8_MMA(ai, bj, At, Bt) do { __builtin_amdgcn_s_setprio(1); _Pragma("unroll") for (int m = 0; m < 4; ++m) _Pragma("unroll") for (int n = 0; n < 2; ++n) { \
        if constexpr (FP8) { asm volatile("v_mfma_f32_16x16x128_f8f6f4 %0, %1, %2, %0" : "+v"(acc[ai][bj][m][n]) : "v"(Bt[n]), "v"(At[m])); } \
        else { acc[ai][bj][m][n] = __builtin_amdgcn_mfma_f32_16x16x32_bf16(PG8_LO(Bt[n]), PG8_LO(At[m]), acc[ai][bj][m][n], 0, 0, 0); \
               acc[ai][bj][m][n] = __builtin_amdgcn_mfma_f32_16x16x32_bf16(PG8_HI(Bt[n]), PG8_HI(At[m]), acc[ai][bj][m][n], 0, 0, 0); } } __builtin_amdgcn_s_setprio(0); } while (0)
#define PG8_WAIT_V(n) asm volatile("s_waitcnt vmcnt(" #n ")" ::: "memory")
#define PG8_WAIT_L(n) asm volatile("s_waitcnt lgkmcnt(" #n ")" ::: "memory")
#define PG8_BAR __builtin_amdgcn_s_barrier()
#define PG8_SCHED __builtin_amdgcn_sched_barrier(0)
    Unit cur, nxt; int ui = 0;
    if (!S.next(0, cur)) return;
    if constexpr (GATHER) S.a_rows(cur, RA, CA, voA);
#pragma unroll
    for (int h = 0; h < 2; ++h)
#pragma unroll
        for (int i = 0; i < 2; ++i) voN[h][i] = voA[h][i];
    f32x4 acc[2][2][4][2];
#pragma unroll
    for (int a = 0; a < 2; ++a)
#pragma unroll
        for (int b = 0; b < 2; ++b)
#pragma unroll
            for (int m = 0; m < 4; ++m)
#pragma unroll
                for (int n = 0; n < 2; ++n) acc[a][b][m][n] = (f32x4){0.f, 0.f, 0.f, 0.f};
    i32x8 At[4], B0[2], B1[2];
    const char* cA = S.a_base(cur); const char* cB = S.b_base(cur);
    PG8_STAGE(PG8_SB(0, 0), cB, voffB); PG8_STAGE(PG8_SB(0, 1), cB + hstepB, voffB); PG8_STAGE(PG8_SA(0, 0), cA, voA[0]); PG8_STAGE(PG8_SA(0, 1), cA, voA[1]);
    if (wr == 1) PG8_BAR;
    PG8_WAIT_V(2); PG8_BAR;
    PG8_STAGE(PG8_SB(1, 0), cB + kstep, voffB); PG8_STAGE(PG8_SA(1, 0), cA + kstep, voA[0]); PG8_STAGE(PG8_SB(1, 1), cB + hstepB + kstep, voffB);
    PG8_WAIT_V(6); PG8_BAR;
    for (;;) {
        const bool has_next = S.next(ui + 1, nxt);
        const char* nA = has_next ? S.a_base(nxt) : cA; const char* nB = has_next ? S.b_base(nxt) : cB;
        if constexpr (GATHER) { if (has_next) S.a_rows(nxt, RA, CA, voN); }
#pragma unroll 1
        for (int t = 0; t < nt; t += 2) {
            const bool last = (t == nt - 2);
            const char* a1 = cA + (size_t)(t + 1) * kstep;
            const char* a2 = last ? nA : cA + (size_t)(t + 2) * kstep; const char* b2 = last ? nB : cB + (size_t)(t + 2) * kstep;
            const char* a3 = a2 + kstep; const char* b3 = b2 + kstep;
            unsigned v2[2][2];
#pragma unroll
            for (int h = 0; h < 2; ++h)
#pragma unroll
                for (int i = 0; i < 2; ++i) v2[h][i] = voA[h][i];
            if constexpr (GATHER) { if (last) { asm volatile("" : "+v"(voN[0][0]), "+v"(voN[0][1]), "+v"(voN[1][0]), "+v"(voN[1][1]));
#pragma unroll
                for (int h = 0; h < 2; ++h)
#pragma unroll
                    for (int i = 0; i < 2; ++i) v2[h][i] = voN[h][i]; } }
            PG8_LDB(B0, 0, 0); PG8_LDB(B1, 0, 1); PG8_SCHED; PG8_LDA(At, 0, 0); PG8_STAGE(PG8_SA(1, 1), a1, voA[1]);
            PG8_WAIT_V(8); PG8_WAIT_L(0); PG8_BAR; PG8_MMA(0, 0, At, B0); PG8_MMA(0, 1, At, B1); PG8_BAR; PG8_SCHED;
            PG8_LDA(At, 0, 1); PG8_STAGE(PG8_SB(0, 0), b2, voffB); PG8_STAGE(PG8_SB(0, 1), b2 + hstepB, voffB); PG8_STAGE(PG8_SA(0, 0), a2, v2[0]);
            PG8_WAIT_V(8); PG8_WAIT_L(0); PG8_BAR; PG8_MMA(1, 0, At, B0); PG8_MMA(1, 1, At, B1); PG8_BAR; PG8_SCHED;
            PG8_LDB(B0, 1, 0); PG8_LDB(B1, 1, 1); PG8_SCHED; PG8_LDA(At, 1, 0); PG8_STAGE(PG8_SA(0, 1), a2, v2[1]);
            PG8_WAIT_V(8); PG8_WAIT_L(0); PG8_BAR; PG8_MMA(0, 0, At, B0); PG8_MMA(0, 1, At, B1); PG8_BAR; PG8_SCHED;
            PG8_LDA(At, 1, 1); PG8_STAGE(PG8_SB(1, 0), b3, voffB); PG8_STAGE(PG8_SB(1, 1), b3 + hstepB, voffB); PG8_STAGE(PG8_SA(1, 0), a3, v2[0]);
            PG8_WAIT_V(8); PG8_WAIT_L(0); PG8_BAR; PG8_MMA(1, 0, At, B0); PG8_MMA(1, 1, At, B1); PG8_BAR; PG8_SCHED;
        }
        if constexpr (ALIGN_EPI) { if (wr == 0) PG8_BAR; }
        if constexpr (FP8) {
            asm volatile("s_nop 15\n\ts_nop 15" : "+v"(acc[0][0][0][0]), "+v"(acc[0][0][0][1]), "+v"(acc[0][0][1][0]), "+v"(acc[0][0][1][1]), "+v"(acc[0][0][2][0]), "+v"(acc[0][0][2][1]), "+v"(acc[0][0][3][0]), "+v"(acc[0][0][3][1]),
                         "+v"(acc[0][1][0][0]), "+v"(acc[0][1][0][1]), "+v"(acc[0][1][1][0]), "+v"(acc[0][1][1][1]), "+v"(acc[0][1][2][0]), "+v"(acc[0][1][2][1]), "+v"(acc[0][1][3][0]), "+v"(acc[0][1][3][1]));
            asm volatile("" : "+v"(acc[1][0][0][0]), "+v"(acc[1][0][0][1]), "+v"(acc[1][0][1][0]), "+v"(acc[1][0][1][1]), "+v"(acc[1][0][2][0]), "+v"(acc[1][0][2][1]), "+v"(acc[1][0][3][0]), "+v"(acc[1][0][3][1]),
                         "+v"(acc[1][1][0][0]), "+v"(acc[1][1][0][1]), "+v"(acc[1][1][1][0]), "+v"(acc[1][1][1][1]), "+v"(acc[1][1][2][0]), "+v"(acc[1][1][2][1]), "+v"(acc[1][1][3][0]), "+v"(acc[1][1][3][1])); }
        E(acc, cur, wr, wc, fr, fq);
        if (!has_next) break;
#pragma unroll
        for (int a = 0; a < 2; ++a)
#pragma unroll
            for (int b = 0; b < 2; ++b)
#pragma unroll
                for (int m = 0; m < 4; ++m)
#pragma unroll
                    for (int n = 0; n < 2; ++n) acc[a][b][m][n] = (f32x4){0.f, 0.f, 0.f, 0.f};
        cur = nxt; cA = nA; cB = nB; ++ui;
#pragma unroll
        for (int h = 0; h < 2; ++h)
#pragma unroll
            for (int i = 0; i < 2; ++i) voA[h][i] = voN[h][i];
        if constexpr (ALIGN_EPI) { if (wr == 1) PG8_BAR; }
    }
    PG8_WAIT_V(0);
    if constexpr (!ALIGN_EPI) { if (wr == 0) PG8_BAR; }
    PG8_BAR;
#undef PG8_SA
#undef PG8_SB
#undef PG8_STAGE
#undef PG8_LDA
#undef PG8_LDB
#undef PG8_LD8
#undef PG8_LO
#undef PG8_HI
#undef PG8_MMA
#undef PG8_WAIT_V
#undef PG8_WAIT_L
#undef PG8_BAR
#undef PG8_SCHED
}

__device__ __forceinline__ float sigmoidf_fast(float x) { return __builtin_amdgcn_rcpf(1.0f + __builtin_amdgcn_exp2f(-LOG2E * x)); }

struct EpiInProj {
    static constexpr bool PERM = true;
    bf16_t* qkv; bf16_t* gates; float* kpart;
    __device__ __forceinline__ void operator()(const f32x4 (&acc)[2][2][4][2], const Unit& u, int wr, int wc, int fr, int fq) const {
        const int row0 = u.pm * BM + wr * 64 + fr; const int pn = u.pn;
        const int cw = wc * 32 + 8 * fq;
        if (pn < 12) {
            const float sc = (pn < 2 || pn == 6 || pn == 7) ? C2F : 1.0f;
            bf16_t* base = qkv + pn * BM + cw;
#pragma unroll
            for (int ai = 0; ai < 2; ++ai)
#pragma unroll
                for (int m = 0; m < 4; ++m) { bf16_t* rowp = base + (size_t)(row0 + ai * HALF + m * 16) * QKV_LD;
#pragma unroll
                    for (int bj = 0; bj < 2; ++bj) { const f32x4 v0 = acc[ai][bj][m][0] * sc, v1 = acc[ai][bj][m][1] * sc;
                        u32x4 w; w.x = cvt_pk_bf16(v0[0], v0[1]); w.y = cvt_pk_bf16(v0[2], v0[3]); w.z = cvt_pk_bf16(v1[0], v1[1]); w.w = cvt_pk_bf16(v1[2], v1[3]);
                        *(u32x4*)(rowp + bj * HALF) = w; } }
            if (pn == 8 || pn == 9) {
#pragma unroll
                for (int bj = 0; bj < 2; ++bj)
#pragma unroll
                    for (int n = 0; n < 2; ++n) { f32x4 s = (f32x4){0.f, 0.f, 0.f, 0.f};
#pragma unroll
                        for (int ai = 0; ai < 2; ++ai)
#pragma unroll
                            for (int m = 0; m < 4; ++m) s += acc[ai][bj][m][n];
#pragma unroll
                        for (int o = 1; o < 16; o <<= 1) { s[0] += __shfl_xor(s[0], o); s[1] += __shfl_xor(s[1], o); s[2] += __shfl_xor(s[2], o); s[3] += __shfl_xor(s[3], o); }
                        if (fr == 0) *(f32x4*)(kpart + (size_t)(u.pm * 2 + wr) * 512 + (pn - 8) * BM + bj * HALF + cw + 4 * n) = s; }
            }
        } else {
            bf16_t* base = gates + (pn - 12) * BM + cw;
#pragma unroll
            for (int ai = 0; ai < 2; ++ai)
#pragma unroll
                for (int m = 0; m < 4; ++m) { bf16_t* rowp = base + (size_t)(row0 + ai * HALF + m * 16) * GATE_LD;
#pragma unroll
                    for (int bj = 0; bj < 2; ++bj) { const f32x4 a0 = acc[ai][bj][m][0], a1 = acc[ai][bj][m][1];
                        u32x4 w; w.x = cvt_pk_bf16(sigmoidf_fast(a0[0]), sigmoidf_fast(a0[1])); w.y = cvt_pk_bf16(sigmoidf_fast(a0[2]), sigmoidf_fast(a0[3]));
                        w.z = cvt_pk_bf16(sigmoidf_fast(a1[0]), sigmoidf_fast(a1[1])); w.w = cvt_pk_bf16(sigmoidf_fast(a1[2]), sigmoidf_fast(a1[3]));
                        *(u32x4*)(rowp + bj * HALF) = w; } }
        }
    }
};

struct EpiProjGate {
    static constexpr bool PERM = true;
    const bf16_t* gates; bf16_t* merged;
    __device__ __forceinline__ void operator()(const f32x4 (&acc)[2][2][4][2], const Unit& u, int wr, int wc, int fr, int fq) const {
        const int row0 = u.pm * BM + wr * 64 + fr; const int col0 = u.pn * BM + wc * 32 + 8 * fq; const int br = u.e;
#pragma unroll
        for (int ai = 0; ai < 2; ++ai)
#pragma unroll
            for (int m = 0; m < 4; ++m) { const size_t row = (size_t)(row0 + ai * HALF + m * 16);
#pragma unroll
                for (int bj = 0; bj < 2; ++bj) {
                    const u32x4 g = *(const u32x4*)(gates + row * GATE_LD + br * DM + col0 + bj * HALF);
                    f32x4 v0 = acc[ai][bj][m][0], v1 = acc[ai][bj][m][1];
                    v0[0] *= bf_lo(g.x); v0[1] *= bf_hi(g.x); v0[2] *= bf_lo(g.y); v0[3] *= bf_hi(g.y);
                    v1[0] *= bf_lo(g.z); v1[1] *= bf_hi(g.z); v1[2] *= bf_lo(g.w); v1[3] *= bf_hi(g.w);
                    bf16_t* op = merged + row * DM + col0 + bj * HALF;
                    if (br == 1) { const u32x4 p = *(const u32x4*)op;
                        v0[0] += bf_lo(p.x); v0[1] += bf_hi(p.x); v0[2] += bf_lo(p.y); v0[3] += bf_hi(p.y);
                        v1[0] += bf_lo(p.z); v1[1] += bf_hi(p.z); v1[2] += bf_lo(p.w); v1[3] += bf_hi(p.w); }
                    u32x4 w; w.x = cvt_pk_bf16(v0[0], v0[1]); w.y = cvt_pk_bf16(v0[2], v0[3]); w.z = cvt_pk_bf16(v1[0], v1[1]); w.w = cvt_pk_bf16(v1[2], v1[3]);
                    *(u32x4*)op = w; } }
    }
};

struct EpiResF32 {
    static constexpr bool PERM = false;
    const float* x; float* h1;
    __device__ __forceinline__ void operator()(const f32x4 (&acc)[2][2][4][2], const Unit& u, int wr, int wc, int fr, int fq) const {
        const int row0 = u.pm * BM + wr * 64 + fr; const int col0 = u.pn * BM + wc * 32 + 4 * fq;
#pragma unroll
        for (int ai = 0; ai < 2; ++ai)
#pragma unroll
            for (int m = 0; m < 4; ++m) { const size_t off = (size_t)(row0 + ai * HALF + m * 16) * DM + col0;
#pragma unroll
                for (int bj = 0; bj < 2; ++bj)
#pragma unroll
                    for (int n = 0; n < 2; ++n) { const f32x4 b = *(const f32x4*)(x + off + bj * HALF + n * 16); *(f32x4*)(h1 + off + bj * HALF + n * 16) = b + acc[ai][bj][m][n]; } }
    }
};

struct EpiSwiglu {
    static constexpr bool PERM = true;
    const float* bgu; unsigned char* act;
    __device__ __forceinline__ void operator()(const f32x4 (&acc)[2][2][4][2], const Unit& u, int wr, int wc, int fr, int fq) const {
        const int row0 = u.pm * BM + wr * 64 + fr; const int f0 = u.pn * HALF + wc * 32 + 8 * fq;
        const float* bp = bgu + (size_t)u.e * 2048 + f0;
        const f32x4 bg0 = *(const f32x4*)(bp), bg1 = *(const f32x4*)(bp + 4), bu0 = *(const f32x4*)(bp + 1024), bu1 = *(const f32x4*)(bp + 1028);
#pragma unroll
        for (int ai = 0; ai < 2; ++ai)
#pragma unroll
            for (int m = 0; m < 4; ++m) { float y[8];
#pragma unroll
                for (int n = 0; n < 2; ++n)
#pragma unroll
                    for (int j = 0; j < 4; ++j) { const float g = fminf(acc[ai][0][m][n][j] * MOE_WINV + (n ? bg1[j] : bg0[j]), 7.0f);
                        const float up = fminf(fmaxf(acc[ai][1][m][n][j] * MOE_WINV + (n ? bu1[j] : bu0[j]), -7.0f), 7.0f);
                        y[n * 4 + j] = (up + 1.0f) * (g * __builtin_amdgcn_rcpf(1.0f + __builtin_amdgcn_exp2f(-1.702f * LOG2E * g))); }
                unsigned char* op = act + ((size_t)(row0 + ai * HALF + m * 16) * DM + f0) * MOE_ES;
                if constexpr (MOE_FP8) { u32x2 w; w.x = pk4_fp8(y[0], y[1], y[2], y[3]); w.y = pk4_fp8(y[4], y[5], y[6], y[7]); *(u32x2*)op = w; }
                else { u32x4 w; w.x = cvt_pk_bf16(y[0], y[1]); w.y = cvt_pk_bf16(y[2], y[3]); w.z = cvt_pk_bf16(y[4], y[5]); w.w = cvt_pk_bf16(y[6], y[7]); *(u32x4*)op = w; } }
    }
};

struct EpiDown {
    static constexpr bool PERM = true;
    const float* bd; const int* list; const PG8_LAS int* cnt; const float* topw; bf16_t* yslot;
    __device__ __forceinline__ void operator()(const f32x4 (&acc)[2][2][4][2], const Unit& u, int wr, int wc, int fr, int fq) const {
        const int e = u.e, lt = u.aux; const int nvalid = cnt[e] - lt * BM; const int col0 = u.pn * BM + wc * 32 + 8 * fq;
        const float* bp = bd + (size_t)e * DM + col0;
        f32x4 bv[2][2];
#pragma unroll
        for (int bj = 0; bj < 2; ++bj)
#pragma unroll
            for (int n = 0; n < 2; ++n) bv[bj][n] = *(const f32x4*)(bp + bj * HALF + 4 * n);
#pragma unroll
        for (int ai = 0; ai < 2; ++ai)
#pragma unroll
            for (int m = 0; m < 4; ++m) { const int r = ai * HALF + wr * 64 + m * 16 + fr;
                if (r < nvalid) { const int id = list[(size_t)e * LIST_CAP + lt * BM + r]; const float w = topw[id]; bf16_t* rowp = yslot + (size_t)id * DM + col0;
#pragma unroll
                    for (int bj = 0; bj < 2; ++bj) { const f32x4 v0 = (acc[ai][bj][m][0] * MOE_WINV + bv[bj][0]) * w, v1 = (acc[ai][bj][m][1] * MOE_WINV + bv[bj][1]) * w;
                        u32x4 o; o.x = cvt_pk_bf16(v0[0], v0[1]); o.y = cvt_pk_bf16(v0[2], v0[3]); o.z = cvt_pk_bf16(v1[0], v1[1]); o.w = cvt_pk_bf16(v1[2], v1[3]);
                        *(u32x4*)(rowp + bj * HALF) = o; } } }
    }
};

struct DenseOrder {
    int nM, nN, G, c; const char* A; const char* Bt; size_t astep, bstep;
    __device__ __forceinline__ bool next(int i, Unit& u) const { u.e = 0; u.aux = 0; return static_tile(i, G, c, nM, nN, u.pm, u.pn); }
    __device__ __forceinline__ const char* a_base(const Unit& u) const { return A + (size_t)u.pm * astep; }
    __device__ __forceinline__ const char* b_base(const Unit& u) const { return Bt + (size_t)u.pn * bstep; }
    __device__ __forceinline__ void a_rows(const Unit&, const int (&)[2], const int (&)[2], unsigned (&)[2][2]) const {}
};
struct ProjOrder {
    int G, c; const char* Y; const char* Wp;
    __device__ __forceinline__ bool next(int i, Unit& u) const { u.e = i & 1; u.aux = 0; return static_tile(i >> 1, G, c, T_TOK / BM, DM / BM, u.pm, u.pn); }
    __device__ __forceinline__ const char* a_base(const Unit& u) const { return Y + ((size_t)u.pm * BM * DM + u.e * 512) * 2; }
    __device__ __forceinline__ const char* b_base(const Unit& u) const { return Wp + ((size_t)u.pn * BM * DM + u.e * 512) * 2; }
    __device__ __forceinline__ void a_rows(const Unit&, const int (&)[2], const int (&)[2], unsigned (&)[2][2]) const {}
};
struct MoeOrder {
    int NT, nN, G, c; const PG8_LAS int* tile_e; const PG8_LAS int* tileoff; const PG8_LAS int* cnt;
    const char* A; const char* Bt; size_t astep, bstep, bexp; const int* list; int lda; bool gather;
    __device__ __forceinline__ bool next(int i, Unit& u) const { if (!static_tile(i, G, c, NT, nN, u.pm, u.pn)) return false; u.e = tile_e[u.pm]; u.aux = u.pm - tileoff[u.e]; return true; }
    __device__ __forceinline__ const char* a_base(const Unit& u) const { return gather ? A : A + (size_t)u.pm * astep; }
    __device__ __forceinline__ const char* b_base(const Unit& u) const { return Bt + (size_t)u.e * bexp + (size_t)u.pn * bstep; }
    __device__ __forceinline__ void a_rows(const Unit& u, const int (&RA)[2], const int (&CA)[2], unsigned (&vo)[2][2]) const {
        const int n = cnt[u.e] - u.aux * BM; const int* lp = list + (size_t)u.e * LIST_CAP + u.aux * BM;
#pragma unroll
        for (int h = 0; h < 2; ++h)
#pragma unroll
            for (int i = 0; i < 2; ++i) { const int r = h * HALF + RA[i]; const int id = (r < n) ? lp[r] : 0; vo[h][i] = (unsigned)((id >> 2) * lda + CA[i] * 2); }
    }
};
}

namespace att {
typedef unsigned short bf16;
using bf16x8 = __attribute__((ext_vector_type(8))) short;
using s16x4 = __attribute__((ext_vector_type(4))) short;
using f32x16 = __attribute__((ext_vector_type(16))) float;
using u32x4 = __attribute__((ext_vector_type(4))) unsigned;
using f32x4 = __attribute__((ext_vector_type(4))) float;
constexpr int NW = 8, KVBLK = 64, NSLOT = 3, SLOTB = 8192, PITCH = QKV_LD;
constexpr int LDS_K = 0, LDS_V = NSLOT * SLOTB, LDS_WS = 2 * NSLOT * SLOTB, LDS_OST = LDS_WS + NW * 64 * 4, LDS_KM = LDS_OST + NW * 4096, LDS_LUT = LDS_KM + 2048, LDS_FLG = LDS_LUT + 512, LDS_BYTES = LDS_FLG + 64;
__device__ __forceinline__ int crow(int r, int hi) { return (r & 3) + 8 * (r >> 2) + 4 * hi; }
#define SBAR() __builtin_amdgcn_sched_barrier(0)
__device__ __forceinline__ void glds16(const void* gsrc, unsigned lds_dst) { unsigned keep;
    asm volatile("s_mov_b32 %0, m0\n\ts_mov_b32 m0, %2\n\ts_nop 0\n\tglobal_load_lds_dwordx4 %1, off\n\ts_mov_b32 m0, %0" : "=&s"(keep) : "v"(gsrc), "s"(lds_dst) : "memory"); }
typedef float f32x2_t __attribute__((ext_vector_type(2))); typedef __bf16 bf16x2_t __attribute__((ext_vector_type(2)));
__device__ __forceinline__ unsigned cvtpk_s(float lo, float hi) { f32x2_t v = {lo, hi}; bf16x2_t b = __builtin_convertvector(v, bf16x2_t); return __builtin_bit_cast(unsigned, b); }
#define WAIT_BAR(N) asm volatile("s_waitcnt vmcnt(" #N ") lgkmcnt(0)\n\ts_barrier" ::: "memory")
typedef __attribute__((address_space(3))) const char* lds_cptr;

__device__ __forceinline__ void qkt(f32x16& p0, f32x16& p1, lds_cptr Kslot, const bf16x8* qr, const f32x16& c0, int r32, int hi) {
    lds_cptr kb = Kslot + hi * 1024 + r32 * 16;
#pragma unroll
    for (int d0 = 0; d0 < 4; ++d0) {
        const bf16x8 b0 = *(const __attribute__((address_space(3))) bf16x8*)(kb + d0 * 2048);
        const bf16x8 b1 = *(const __attribute__((address_space(3))) bf16x8*)(kb + d0 * 2048 + 512);
        if (d0 == 0) { p0 = __builtin_amdgcn_mfma_f32_32x32x16_bf16(b0, qr[0], c0, 0, 0, 0); p1 = __builtin_amdgcn_mfma_f32_32x32x16_bf16(b1, qr[0], c0, 0, 0, 0); }
        else { p0 = __builtin_amdgcn_mfma_f32_32x32x16_bf16(b0, qr[d0], p0, 0, 0, 0); p1 = __builtin_amdgcn_mfma_f32_32x32x16_bf16(b1, qr[d0], p1, 0, 0, 0); } }
}
__device__ __forceinline__ void pv(f32x16* o, int vb, bf16x8 pa0, bf16x8 pa1, bf16x8 pa2, bf16x8 pa3) {
#pragma unroll
    for (int d0 = 0; d0 < 2; ++d0) { s16x4 lo[4], hi[4];
#pragma unroll
        for (int ks = 0; ks < 4; ++ks) {
            asm volatile("ds_read_b64_tr_b16 %0,%1 offset:%c2" : "=&v"(lo[ks]) : "v"(vb), "i"(d0 * 4096 + ks * 1024) : "memory");
            asm volatile("ds_read_b64_tr_b16 %0,%1 offset:%c2" : "=&v"(hi[ks]) : "v"(vb), "i"(d0 * 4096 + ks * 1024 + 512) : "memory"); }
        asm volatile("s_waitcnt lgkmcnt(0)" ::: "memory"); SBAR();
#define PK(k) (bf16x8){lo[k][0], lo[k][1], lo[k][2], lo[k][3], hi[k][0], hi[k][1], hi[k][2], hi[k][3]}
        o[d0] = __builtin_amdgcn_mfma_f32_32x32x16_bf16(pa0, PK(0), o[d0], 0, 0, 0);
        o[d0] = __builtin_amdgcn_mfma_f32_32x32x16_bf16(pa1, PK(1), o[d0], 0, 0, 0);
        o[d0] = __builtin_amdgcn_mfma_f32_32x32x16_bf16(pa2, PK(2), o[d0], 0, 0, 0);
        o[d0] = __builtin_amdgcn_mfma_f32_32x32x16_bf16(pa3, PK(3), o[d0], 0, 0, 0);
#undef PK
    }
}
__device__ __forceinline__ float swap32(float v, int hi) {
    auto rr = __builtin_amdgcn_permlane32_swap(__float_as_uint(v), __float_as_uint(v), false, false);
    return __uint_as_float(hi ? rr[0] : rr[1]);
}
__device__ __forceinline__ void store_o(const f32x16* o, const float* rs, bf16* Ow, int ldo, char* shm, int wid, int lane, int r32, int hi) {
    bf16* stg = (bf16*)(shm + LDS_OST) + wid * 2048;
#pragma unroll
    for (int r = 0; r < 16; ++r) { const int orow = crow(r, hi);
#pragma unroll
        for (int d0 = 0; d0 < 2; ++d0) { const float v = o[d0][r] * rs[r]; const unsigned u = __float_as_uint(v); stg[orow * 64 + d0 * 32 + r32] = (bf16)((u + 0x7fffu + ((u >> 16) & 1u)) >> 16); } }
    asm volatile("s_waitcnt lgkmcnt(0)" ::: "memory");
#pragma unroll
    for (int i = 0; i < 4; ++i) { const int row = i * 8 + (lane >> 3), ch = lane & 7; const u32x4 v = *(const u32x4*)(stg + row * 64 + ch * 8); *(u32x4*)(Ow + (long)row * ldo + ch * 8) = v; }
}
#define PKW(P, B) cvtpk_s(P[B], P[B + 1])

__device__ __forceinline__ void sb_unit(int b, int h, int qb, const bf16* QKV, bf16* Y, char* shm) {
    const int tid = threadIdx.x, lane = tid & 63, r32 = lane & 31, hi = lane >> 5; const int wid = __builtin_amdgcn_readfirstlane(tid >> 6);
    const long rowbase = (long)b * SEQ; const int q0 = qb * 256;
    const bf16* Qw = QKV + (rowbase + q0 + wid * 32) * PITCH + h * 64;
    const bf16* Kh = QKV + rowbase * PITCH + 512 + h * 64; const bf16* Vh = QKV + rowbase * PITCH + 1024 + h * 64;
    const unsigned lds0 = (unsigned)(uintptr_t)shm;
    const lds_cptr shm3 = (lds_cptr)shm;
    volatile __attribute__((address_space(3))) unsigned* flg = (volatile __attribute__((address_space(3))) unsigned*)(shm3 + LDS_FLG);
    const bf16* ksrc = Kh + (long)lane * PITCH + wid * 8;
    const bf16* vsrc = Vh + (long)(16 * (wid & 3) + (lane >> 2)) * PITCH + (wid >> 2) * 32 + (lane & 3) * 8;
    const unsigned kdst = lds0 + LDS_K + wid * 1024, vdst = lds0 + LDS_V + wid * 1024;
#define DMA_KV(t, slot) do { glds16(ksrc + (long)(t) * KVBLK * PITCH, (unsigned)__builtin_amdgcn_readfirstlane(kdst + (slot))); glds16(vsrc + (long)(t) * KVBLK * PITCH, (unsigned)__builtin_amdgcn_readfirstlane(vdst + (slot))); } while (0)
    const int vb0 = (int)(lds0 + LDS_V) + ((lane >> 4) & 1) * 32 + (lane & 3) * 8 + (4 * hi + ((lane & 15) >> 2)) * 64;
    bf16x8 qr[4];
#pragma unroll
    for (int d0 = 0; d0 < 4; ++d0) qr[d0] = *reinterpret_cast<const bf16x8*>(&Qw[(long)r32 * PITCH + d0 * 16 + hi * 8]);
    if (lane == 0) flg[wid] = 0u;
    const int ktop = 4 * qb + 3;
    DMA_KV(ktop, 0); DMA_KV(ktop - 1, SLOTB);
    f32x16 o[2]; o[0] = f32x16{}; o[1] = f32x16{}; const f32x16 zero16 = f32x16{};
    float carry = 0.f;
    const int ktd = 4 * qb + (wid >> 1);
    const int qpos = q0 + wid * 32 + r32;
    bool wdone = false;
    int sl_cur = 0, sl_n1 = SLOTB, sl_n2 = 2 * SLOTB;
    for (int kt = ktop; ; --kt) {
        if (kt > 0) { WAIT_BAR(2); } else { WAIT_BAR(0); }
        { const u32x4 f0 = *(const __attribute__((address_space(3))) u32x4*)(shm3 + LDS_FLG), f1 = *(const __attribute__((address_space(3))) u32x4*)(shm3 + LDS_FLG + 16);
          const unsigned all = f0.x & f0.y & f0.z & f0.w & f1.x & f1.y & f1.z & f1.w;
          if (__builtin_amdgcn_readfirstlane(all) != 0u) break; }
        if (kt >= 2) DMA_KV(kt - 2, sl_n2);
        if (!wdone && kt <= ktd) {
            f32x16 p0, p1;
            qkt(p0, p1, shm3 + LDS_K + sl_cur, qr, zero16, r32, hi);
            const bool diag = (kt == ktd);
            int qk = qpos - 4 * hi - 64 * kt; asm volatile("" : "+v"(qk));
            float lk[32], ls[32];
#pragma unroll
            for (int i = 0; i < 32; ++i) { const float z = (i < 16) ? p0[i] : p1[i - 16];
                const float e = __builtin_amdgcn_exp2f(-__builtin_fabsf(z)); const float l2 = __builtin_amdgcn_logf(1.0f + e);
                const float sp = __builtin_fmaxf(z, 0.f) + l2;
                float nk = -sp, lsv = z - sp;
                if (diag) { const bool valid = (8 * (i >> 2) + (i & 3)) < qk; nk = valid ? nk : 0.f; lsv = valid ? lsv : -INFINITY; }
                lk[i] = nk; ls[i] = lsv; }
            float gs[8], pg[8], S[8];
#pragma unroll
            for (int g = 0; g < 8; ++g) { gs[g] = (lk[4 * g] + lk[4 * g + 1]) + (lk[4 * g + 2] + lk[4 * g + 3]); pg[g] = swap32(gs[g], hi); }
            S[7] = 0.f;
#pragma unroll
            for (int g = 6; g >= 0; --g) S[g] = S[g + 1] + (gs[g + 1] + pg[g + 1]);
            const float tot = S[0] + (gs[0] + pg[0]);
#pragma unroll
            for (int g = 0; g < 8; ++g) { float t = carry + S[g] + (hi ? 0.f : pg[g]);
#pragma unroll
                for (int j = 3; j >= 0; --j) { const int i = 4 * g + j; const float a = __builtin_amdgcn_exp2f(ls[i] + t); t += lk[i]; if (i < 16) p0[i] = a; else p1[i - 16] = a; } }
            carry += tot;
            u32x4 pw0, pw1, pw2, pw3;
            pw0 = (u32x4){PKW(p0, 0), PKW(p0, 2), PKW(p0, 4), PKW(p0, 6)}; pw1 = (u32x4){PKW(p0, 8), PKW(p0, 10), PKW(p0, 12), PKW(p0, 14)};
            pw2 = (u32x4){PKW(p1, 0), PKW(p1, 2), PKW(p1, 4), PKW(p1, 6)}; pw3 = (u32x4){PKW(p1, 8), PKW(p1, 10), PKW(p1, 12), PKW(p1, 14)};
            SBAR();
            pv(o, vb0 + sl_cur, __builtin_bit_cast(bf16x8, pw0), __builtin_bit_cast(bf16x8, pw1), __builtin_bit_cast(bf16x8, pw2), __builtin_bit_cast(bf16x8, pw3));
            wdone = __all(carry < -36.0f);
            if (wdone && lane == 0) flg[wid] = 1u;
        }
        if (kt == 0) break;
        { const int t_ = sl_cur; sl_cur = sl_n1; sl_n1 = sl_n2; sl_n2 = t_; }
    }
    float ones[16];
#pragma unroll
    for (int r = 0; r < 16; ++r) ones[r] = 1.0f;
    store_o(o, ones, Y + (rowbase + q0 + wid * 32) * DM + h * 64, DM, shm, wid, lane, r32, hi);
    WAIT_BAR(0);
#undef DMA_KV
}

__device__ __forceinline__ void moba_unit(int b, int h, int qb, const bf16* QKV, bf16* Y, const float* kpart, const float* rel_bias, char* shm) {
    const int tid = threadIdx.x, lane = tid & 63, r32 = lane & 31, hi = lane >> 5; const int wid = __builtin_amdgcn_readfirstlane(tid >> 6);
    const long rowbase = (long)b * SEQ; const int q0 = qb * 256;
    const bf16* Qw = QKV + (rowbase + q0 + wid * 32) * PITCH + 1536 + h * 64;
    const bf16* Kh = QKV + rowbase * PITCH + 2048 + h * 64; const bf16* Vh = QKV + rowbase * PITCH + 2560 + h * 64;
    const unsigned lds0 = (unsigned)(uintptr_t)shm;
    const lds_cptr shm3 = (lds_cptr)shm;
    __attribute__((address_space(3))) float* wsf = (__attribute__((address_space(3))) float*)(shm3 + LDS_WS) + wid * 64;
    __attribute__((address_space(3))) float* kmean = (__attribute__((address_space(3))) float*)(shm3 + LDS_KM);
    __attribute__((address_space(3))) float* lut = (__attribute__((address_space(3))) float*)(shm3 + LDS_LUT);
    const bf16* ksrc = Kh + (long)lane * PITCH + wid * 8;
    const bf16* vsrc = Vh + (long)(16 * (wid & 3) + (lane >> 2)) * PITCH + (wid >> 2) * 32 + (lane & 3) * 8;
    const unsigned kdst = lds0 + LDS_K + wid * 1024, vdst = lds0 + LDS_V + wid * 1024;
#define DMA_KV(t, slot) do { glds16(ksrc + (long)(t) * KVBLK * PITCH, (unsigned)__builtin_amdgcn_readfirstlane(kdst + (slot))); glds16(vsrc + (long)(t) * KVBLK * PITCH, (unsigned)__builtin_amdgcn_readfirstlane(vdst + (slot))); } while (0)
    const int vb0 = (int)(lds0 + LDS_V) + ((lane >> 4) & 1) * 32 + (lane & 3) * 8 + (4 * hi + ((lane & 15) >> 2)) * 64;
    { const int j = tid >> 6, d = tid & 63; const float* kp = kpart + (size_t)((b * 8 + j) * 2) * 512 + h * 64 + d; kmean[j * 64 + d] = (kp[0] + kp[512]) * (1.0f / 256.0f);
      if (tid < 128) { const int n = tid; int bk; if (n < 16) bk = n; else { bk = 16 + (int)(logf((float)n * (1.0f / 16.0f)) / 2.0794415416798357f * 16.0f); bk = bk > 31 ? 31 : bk; }
          lut[n] = rel_bias[bk * NHEAD + h] * LOG2E; } }
    bf16x8 qr[4];
#pragma unroll
    for (int d0 = 0; d0 < 4; ++d0) qr[d0] = *reinterpret_cast<const bf16x8*>(&Qw[(long)r32 * PITCH + d0 * 16 + hi * 8]);
    const int ns = 4 * qb + 4;
#define TILE_OF(s) ((s) < 4 ? 4 * qb + (s) : (s) - 4)
    DMA_KV(TILE_OF(0), 0); DMA_KV(TILE_OF(1), SLOTB);
    float mhat = 0.f, l_reg = 0.f; f32x16 o[2]; o[0] = f32x16{}; o[1] = f32x16{};
    const int qpos = q0 + wid * 32 + r32; bool first = true; unsigned selmask = 0u; float bias31 = 0.f;
    int sl_cur = 0, sl_n1 = SLOTB, sl_n2 = 2 * SLOTB;
    for (int s = 0; s < ns; ++s) {
        if (s + 1 < ns) { WAIT_BAR(2); } else { WAIT_BAR(0); }
        if (s + 2 < ns) DMA_KV(TILE_OF(s + 2), sl_n2);
        if (s == 0) {
            bias31 = lut[127];
            __attribute__((address_space(3))) float* gsh = (__attribute__((address_space(3))) float*)(shm3 + LDS_OST) + wid * 1024;
#pragma unroll 1
            for (int j = 0; j < qb; ++j) { float a = 0.f;
#pragma unroll
                for (int d0 = 0; d0 < 4; ++d0) { const f32x4 k0 = *(const __attribute__((address_space(3))) f32x4*)(kmean + j * 64 + d0 * 16 + hi * 8), k1 = *(const __attribute__((address_space(3))) f32x4*)(kmean + j * 64 + d0 * 16 + hi * 8 + 4);
                    const bf16x8 q = qr[d0];
                    a += __uint_as_float((unsigned)(unsigned short)q[0] << 16) * k0[0] + __uint_as_float((unsigned)(unsigned short)q[1] << 16) * k0[1] + __uint_as_float((unsigned)(unsigned short)q[2] << 16) * k0[2] + __uint_as_float((unsigned)(unsigned short)q[3] << 16) * k0[3]
                       + __uint_as_float((unsigned)(unsigned short)q[4] << 16) * k1[0] + __uint_as_float((unsigned)(unsigned short)q[5] << 16) * k1[1] + __uint_as_float((unsigned)(unsigned short)q[6] << 16) * k1[2] + __uint_as_float((unsigned)(unsigned short)q[7] << 16) * k1[3]; }
                gsh[j * 64 + lane] = a + swap32(a, hi); }
            asm volatile("s_waitcnt lgkmcnt(0)" ::: "memory");
            float g[8];
#pragma unroll
            for (int j = 0; j < 8; ++j) { g[j] = -INFINITY; if (j < qb) g[j] = gsh[j * 64 + lane]; }
#pragma unroll
            for (int j = 0; j < 8; ++j) if (j < qb) { int rank = 0;
#pragma unroll
                for (int i = 0; i < 8; ++i) if (i != j && i < qb) rank += (g[i] > g[j] || (g[i] == g[j] && i < j)) ? 1 : 0;
                if (rank < 3) selmask |= 1u << j; }
        }
        const int kt = TILE_OF(s);
        const bool own = s < 4;
        const bool active = !own || (s <= (wid >> 1));
        if (active) {
            const int dmin = (q0 + wid * 32) - (64 * kt + 63);
            const bool far = dmin >= 113;
            float nb = -mhat;
            if (!own) nb = ((selmask >> (kt >> 2)) & 1u) ? nb : -INFINITY;
            if (far) nb += bias31;
            f32x16 c0;
#pragma unroll
            for (int r = 0; r < 16; ++r) c0[r] = nb;
            f32x16 p0, p1;
            qkt(p0, p1, shm3 + LDS_K + sl_cur, qr, c0, r32, hi);
            if (!far) {
                int qk = qpos - 4 * hi - 64 * kt; asm volatile("" : "+v"(qk));
#pragma unroll
                for (int i = 0; i < 32; ++i) { const int dist = qk - (8 * (i >> 2) + (i & 3)); const int dc = dist < 0 ? 0 : (dist > 127 ? 127 : dist);
                    const float bb = lut[dc]; float x = (i < 16) ? p0[i] : p1[i - 16]; x = (dist < 0) ? -INFINITY : x + bb; if (i < 16) p0[i] = x; else p1[i - 16] = x;
                    if ((i & 7) == 7) asm volatile("" ::: "memory"); }
            }
            float rm = __builtin_fmaxf(p0[0], p1[0]);
#pragma unroll
            for (int r = 1; r < 16; ++r) rm = __builtin_fmaxf(rm, __builtin_fmaxf(p0[r], p1[r]));
            rm = __builtin_fmaxf(rm, swap32(rm, hi));
            if (first) {
                mhat = rm; first = false;
#pragma unroll
                for (int r = 0; r < 16; ++r) { p0[r] -= rm; p1[r] -= rm; }
            } else if (__any(rm > 8.0f)) {
                const float dl = __builtin_fmaxf(rm, 0.f); mhat += dl;
#pragma unroll
                for (int r = 0; r < 16; ++r) { p0[r] -= dl; p1[r] -= dl; }
                const float f = __builtin_amdgcn_exp2f(-dl); l_reg *= f; if (hi == 0) wsf[r32] = f;
                asm volatile("s_waitcnt lgkmcnt(0)" ::: "memory");
#pragma unroll
                for (int r = 0; r < 16; ++r) { const float fr_ = wsf[crow(r, hi)]; o[0][r] *= fr_; o[1][r] *= fr_; }
            }
            float sacc = 0.f;
#pragma unroll
            for (int r = 0; r < 16; ++r) { p0[r] = __builtin_amdgcn_exp2f(p0[r]); p1[r] = __builtin_amdgcn_exp2f(p1[r]); sacc += p0[r] + p1[r]; }
            l_reg += sacc;
            u32x4 pw0, pw1, pw2, pw3;
            pw0 = (u32x4){PKW(p0, 0), PKW(p0, 2), PKW(p0, 4), PKW(p0, 6)}; pw1 = (u32x4){PKW(p0, 8), PKW(p0, 10), PKW(p0, 12), PKW(p0, 14)};
            pw2 = (u32x4){PKW(p1, 0), PKW(p1, 2), PKW(p1, 4), PKW(p1, 6)}; pw3 = (u32x4){PKW(p1, 8), PKW(p1, 10), PKW(p1, 12), PKW(p1, 14)};
            SBAR();
            pv(o, vb0 + sl_cur, __builtin_bit_cast(bf16x8, pw0), __builtin_bit_cast(bf16x8, pw1), __builtin_bit_cast(bf16x8, pw2), __builtin_bit_cast(bf16x8, pw3));
        }
        { const int t_ = sl_cur; sl_cur = sl_n1; sl_n1 = sl_n2; sl_n2 = t_; }
    }
    l_reg += swap32(l_reg, hi);
    if (hi == 0) wsf[32 + r32] = l_reg; asm volatile("s_waitcnt lgkmcnt(0)" ::: "memory");
    float rli[16];
#pragma unroll
    for (int r = 0; r < 16; ++r) rli[r] = __builtin_amdgcn_rcpf(wsf[32 + crow(r, hi)]);
    store_o(o, rli, Y + (rowbase + q0 + wid * 32) * DM + 512 + h * 64, DM, shm, wid, lane, r32, hi);
    WAIT_BAR(0);
#undef DMA_KV
#undef TILE_OF
}
#undef PKW
#undef SBAR
#undef WAIT_BAR
}

constexpr size_t MiB = 1u << 20;
constexpr size_t WS_CTL = 0, CTL_ZERO_BYTES = 1 * MiB;
constexpr size_t WS_WIN = 2 * MiB;
constexpr size_t WS_WPROJ = 12 * MiB;
constexpr size_t WS_WOUT = 14 * MiB;
constexpr size_t WS_WGU = 16 * MiB;
constexpr size_t WS_WD = 144 * MiB;
constexpr size_t WS_XN = 208 * MiB;
constexpr size_t WS_QKV = 240 * MiB;
constexpr size_t WS_GATES = 336 * MiB;
constexpr size_t WS_Y = 400 * MiB;
constexpr size_t WS_MERGED = 432 * MiB;
constexpr size_t WS_H1 = 464 * MiB;
constexpr size_t WS_HN = 528 * MiB;
constexpr size_t WS_ACT = 560 * MiB;
constexpr size_t WS_YSLOT = 704 * MiB;
constexpr size_t WS_LIST = 832 * MiB;
constexpr size_t WS_TOPW = 834 * MiB;
constexpr size_t WS_KPART = 835 * MiB;
constexpr size_t WS_END = 836 * MiB;
constexpr int CW_TMO = 0, CW_CODE = 1;
constexpr int CW_CNT = 8192;
constexpr int CW_BAR = 4096;

constexpr int RING_OFF = 0, RING_BYTES = 131072;
constexpr int LDSCTL_OFF = RING_BYTES;
constexpr int L_MISC = LDSCTL_OFF;
constexpr int L_CNT = LDSCTL_OFF + 128;
constexpr int L_TOFF = LDSCTL_OFF + 256;
constexpr int L_TILEE = LDSCTL_OFF + 512;
constexpr int L_HIST = LDSCTL_OFF + 2048;
constexpr int L_BASE = LDSCTL_OFF + 2176;
constexpr int L_TMP = LDSCTL_OFF + 2304;
constexpr int LDS_BYTES = LDSCTL_OFF + 8192;
constexpr int NWAVES = 8;

#define GAS __attribute__((address_space(1)))
#define LAS __attribute__((address_space(3)))
typedef unsigned short bf16;
typedef unsigned v4u __attribute__((ext_vector_type(4)));
typedef unsigned v2u __attribute__((ext_vector_type(2)));
typedef float f32x4 __attribute__((ext_vector_type(4)));
typedef GAS unsigned gu32;
#define RLX_AGENT __ATOMIC_RELAXED, __HIP_MEMORY_SCOPE_AGENT
#define LDS_WAIT() asm volatile("s_waitcnt lgkmcnt(0)" ::: "memory")
__device__ __forceinline__ unsigned f2bf(float f) { unsigned u = __builtin_bit_cast(unsigned, f); return (u + 0x7fffu + ((u >> 16) & 1u)) >> 16; }
__device__ __forceinline__ unsigned pk2(float lo, float hi) { return f2bf(lo) | (f2bf(hi) << 16); }

#define XB_TMO      128
#define XB_XCNT(j)  (256  + 64 * (j))
#define XB_XSUB(j)  (1280 + 64 * (j))
#define XB_XGEN(j)  (2304 + 64 * (j))
#define XB_TOP      3328
#define XB_TOPGEN   3392
#define XCD_BAR_WORDS 3456
#define XB_SPIN_CAP (1u << 18)
__device__ __forceinline__ unsigned xb_ld(unsigned* p)              { return __hip_atomic_load(p, __ATOMIC_RELAXED, __HIP_MEMORY_SCOPE_AGENT); }
__device__ __forceinline__ unsigned xb_add(unsigned* p, unsigned v) { return __hip_atomic_fetch_add(p, v, __ATOMIC_RELAXED, __HIP_MEMORY_SCOPE_AGENT); }
__device__ __forceinline__ unsigned xb_xcc_id() { return (unsigned)__builtin_amdgcn_s_getreg((3 << 11) | 20) & 0xFu; }
#define XB_SPIN(cond, bar) do { unsigned _sp = 0; while (cond) { __builtin_amdgcn_s_sleep(1); \
    if ((++_sp & 255u) == 0u) { if (xb_ld(&(bar)[XB_TMO])) break; if (_sp > XB_SPIN_CAP) { atomicAdd(&(bar)[XB_TMO], 1u); break; } } } } while (0)
struct XcdBarrier { unsigned* bar; unsigned x; volatile LAS unsigned* st; };
__device__ __forceinline__ XcdBarrier xcd_barrier_post(unsigned* bar, volatile LAS unsigned* st) {
    XcdBarrier b; b.bar = bar; b.x = xb_xcc_id(); b.st = st;
    if (threadIdx.x == 0) (void)xb_add(&bar[XB_XCNT(b.x)], 1u);
    return b;
}
__device__ __forceinline__ void xcd_barrier_complete(unsigned* bar, unsigned x, unsigned& nloc, unsigned& nx) {
    const unsigned G = gridDim.x * gridDim.y * gridDim.z;
    unsigned sum, cnt, mine, sp = 0u;
    for (;;) {
        sum = 0u; cnt = 0u; mine = 0u;
#pragma unroll
        for (unsigned j = 0; j < 16; ++j) { const unsigned c = xb_ld(&bar[XB_XCNT(j)]); sum += c; cnt += (c > 0u) ? 1u : 0u; mine = (j == x) ? c : mine; }
        if (sum == G) break;
        __builtin_amdgcn_s_sleep(1);
        if ((++sp & 255u) == 0u) { if (xb_ld(&bar[XB_TMO])) break; if (sp > XB_SPIN_CAP) { atomicAdd(&bar[XB_TMO], 1u); break; } }
    }
    nloc = mine > 0u ? mine : 1u; nx = cnt > 0u ? cnt : 1u;
}
__device__ __forceinline__ void xcd_barrier(const XcdBarrier& b) {
    asm volatile("s_waitcnt vmcnt(0)" ::: "memory");
    __syncthreads();
    if (threadIdx.x == 0) {
        unsigned* bar = b.bar;
        __builtin_amdgcn_s_waitcnt(0);
        unsigned nloc = b.st[0], nx = b.st[1];
        if (nloc == 0u) { xcd_barrier_complete(bar, b.x, nloc, nx); b.st[0] = nloc; b.st[1] = nx; }
        const unsigned old = xb_add(&bar[XB_XSUB(b.x)], 1u);
        const unsigned gen = old / nloc;
        if (old + 1u == (gen + 1u) * nloc) {
            __builtin_amdgcn_fence(__ATOMIC_RELEASE, "agent");
            asm volatile("s_waitcnt vmcnt(0)" ::: "memory");
            const unsigned og = xb_add(&bar[XB_TOP], 1u);
            const unsigned tg = og / nx;
            if (og + 1u == (tg + 1u) * nx) xb_add(&bar[XB_TOPGEN], 1u);
            else XB_SPIN(xb_ld(&bar[XB_TOPGEN]) == tg, bar);
            __builtin_amdgcn_fence(__ATOMIC_ACQUIRE, "agent");
            xb_add(&bar[XB_XGEN(b.x)], 1u);
            asm volatile("s_waitcnt vmcnt(0)" ::: "memory");
        } else {
            XB_SPIN(xb_ld(&bar[XB_XGEN(b.x)]) == gen, bar);
            __builtin_amdgcn_fence(__ATOMIC_ACQUIRE, "agent");
            asm volatile("s_waitcnt vmcnt(0)" ::: "memory");
        }
    }
    __syncthreads();
}

struct Frame {
    LAS unsigned char* lds; gu32* ctl; int tid, lane, wave, vcu, G;
    const float *x, *norm_mix_g, *w_in, *w_proj_sb, *w_proj_moba, *w_out, *rel_bias, *norm_ffn_g, *w_router, *b_router, *w_gate_up, *b_gate_up, *w_down, *b_down, *norm_final_g;
    float* out; unsigned char* ws;
};
__device__ __forceinline__ float wave_sum(float v) {
#pragma unroll
    for (int o = 1; o < 64; o <<= 1) v += __shfl_xor(v, o);
    return v;
}
template <bool FP8>
__device__ __forceinline__ void p0_item(const float* W, int ldw, int k0, int n0, unsigned char* WT, int ldtB, int dst_row0, int kdstB, int lane, float scale) {
    constexpr int KL = FP8 ? 16 : 8;
    const int lk = lane >> 3, ln = lane & 7;
    const GAS f32x4* src = (const GAS f32x4*)(W + (size_t)(k0 + KL * lk) * ldw + n0 + 4 * ln);
    f32x4 v[KL];
#pragma unroll
    for (int i = 0; i < KL; ++i) v[i] = src[(size_t)i * (ldw / 4)];
#pragma unroll
    for (int j = 0; j < 4; ++j) { v4u o;
        if constexpr (FP8) { o.x = pg8::pk4_fp8(v[0][j] * scale, v[1][j] * scale, v[2][j] * scale, v[3][j] * scale); o.y = pg8::pk4_fp8(v[4][j] * scale, v[5][j] * scale, v[6][j] * scale, v[7][j] * scale);
            o.z = pg8::pk4_fp8(v[8][j] * scale, v[9][j] * scale, v[10][j] * scale, v[11][j] * scale); o.w = pg8::pk4_fp8(v[12][j] * scale, v[13][j] * scale, v[14][j] * scale, v[15][j] * scale); }
        else { o.x = pg8::cvt_pk_bf16(v[0][j], v[1][j]); o.y = pg8::cvt_pk_bf16(v[2][j], v[3][j]); o.z = pg8::cvt_pk_bf16(v[4][j], v[5][j]); o.w = pg8::cvt_pk_bf16(v[6][j], v[7][j]); }
        *(GAS v4u*)(WT + (size_t)(dst_row0 + 4 * ln + j) * ldtB + kdstB + (size_t)(k0 + KL * lk) * (FP8 ? 1 : 2)) = o; }
}
__device__ __forceinline__ void rms_row_to_bf16(const float* xrow, const f32x4 (&g)[4], bf16* orow, int lane) {
    const GAS f32x4* xr = (const GAS f32x4*)xrow + lane;
    f32x4 v[4]; float s = 0.f;
#pragma unroll
    for (int j = 0; j < 4; ++j) { v[j] = xr[64 * j]; s += (v[j].x * v[j].x + v[j].y * v[j].y) + (v[j].z * v[j].z + v[j].w * v[j].w); }
    const float rstd = 1.0f / sqrtf(wave_sum(s) * (1.0f / DM) + RMS_EPS);
    GAS unsigned long long* o8 = (GAS unsigned long long*)orow + lane;
#pragma unroll
    for (int j = 0; j < 4; ++j) { const f32x4 y = v[j] * rstd * g[j]; o8[64 * j] = (unsigned long long)pk2(y.x, y.y) | ((unsigned long long)pk2(y.z, y.w) << 32); }
}
__device__ __forceinline__ void p0_prologue(Frame& F) {
    const int gw = F.vcu * NWAVES + F.wave, NGW = F.G * NWAVES;
    unsigned char* WIN = F.ws + WS_WIN; unsigned char* WPROJ = F.ws + WS_WPROJ; unsigned char* WOUT = F.ws + WS_WOUT; unsigned char* WGU = F.ws + WS_WGU; unsigned char* WD = F.ws + WS_WD;
    constexpr int KI = MOE_FP8 ? 128 : 64;
    constexpr int GU_PER = (1024 / KI) * 64, D_PER = (1024 / KI) * 32;
    constexpr int I_IN = 16 * 160, I_PS = 8 * 32, I_PM = 8 * 32, I_OUT = 16 * 32, I_GU = 32 * GU_PER, I_D = 32 * D_PER;
    constexpr int NITEMS = I_IN + I_PS + I_PM + I_OUT + I_GU + I_D;
    for (int it = gw; it < NITEMS; it += NGW) {
        int r = it;
        if (r < I_GU) { const int e = r / GU_PER, q = r % GU_PER, kb = q >> 6, nb = q & 63, n0 = 32 * nb;
            const int cc = n0 & 1023, drow = (cc >> 7) * 256 + (n0 >= 1024 ? 128 : 0) + (cc & 127);
            p0_item<MOE_FP8>(F.w_gate_up + (size_t)e * 1024 * 2048, 2048, KI * kb, n0, WGU + (size_t)e * 2048 * 1024 * MOE_ES, 1024 * MOE_ES, drow, 0, F.lane, MOE_WSCALE); continue; } r -= I_GU;
        if (r < I_D) { const int e = r / D_PER, q = r % D_PER, kb = q >> 5, nb = q & 31;
            p0_item<MOE_FP8>(F.w_down + (size_t)e * 1024 * 1024, 1024, KI * kb, 32 * nb, WD + (size_t)e * 1024 * 1024 * MOE_ES, 1024 * MOE_ES, 32 * nb, 0, F.lane, MOE_WSCALE); continue; } r -= I_D;
        if (r < I_IN) { const int kb = r / 160, nb = r % 160; p0_item<false>(F.w_in, DIN, 64 * kb, 32 * nb, WIN, 2048, 32 * nb, 0, F.lane, 1.f); continue; } r -= I_IN;
        if (r < I_PS) { const int kb = r >> 5, nb = r & 31; p0_item<false>(F.w_proj_sb, 1024, 64 * kb, 32 * nb, WPROJ, 2048, 32 * nb, 0, F.lane, 1.f); continue; } r -= I_PS;
        if (r < I_PM) { const int kb = r >> 5, nb = r & 31; p0_item<false>(F.w_proj_moba, 1024, 64 * kb, 32 * nb, WPROJ, 2048, 32 * nb, 1024, F.lane, 1.f); continue; } r -= I_PM;
        { const int kb = r >> 5, nb = r & 31; p0_item<false>(F.w_out, 1024, 64 * kb, 32 * nb, WOUT, 2048, 32 * nb, 0, F.lane, 1.f); }
    }
    f32x4 g[4];
#pragma unroll
    for (int j = 0; j < 4; ++j) g[j] = ((const f32x4*)F.norm_mix_g)[F.lane + 64 * j];
    bf16* XN = (bf16*)(F.ws + WS_XN);
    for (int m = gw; m < T_TOK; m += NGW) rms_row_to_bf16(F.x + (size_t)m * DM, g, XN + (size_t)m * DM, F.lane);
}

__device__ __forceinline__ void p5_router(Frame& F, const bool commit) {
    LAS float* wT = (LAS float*)(F.lds + RING_OFF);
    LAS int* hist = (LAS int*)(F.lds + L_HIST); LAS int* basel = (LAS int*)(F.lds + L_BASE); LAS int* tmp = (LAS int*)(F.lds + L_TMP);
    const int tid = F.tid, lane = F.lane;
    for (int kk = tid; kk < DM; kk += NWAVES * 64) {
#pragma unroll
        for (int q = 0; q < 8; ++q) { const f32x4 v = *(const f32x4*)(F.w_router + (size_t)kk * 32 + 4 * q);
            wT[(4 * q + 0) * DM + kk] = v.x; wT[(4 * q + 1) * DM + kk] = v.y; wT[(4 * q + 2) * DM + kk] = v.z; wT[(4 * q + 3) * DM + kk] = v.w; } }
    if (tid < 32) hist[tid] = 0;
    __syncthreads();
    f32x4 g[4];
#pragma unroll
    for (int j = 0; j < 4; ++j) g[j] = ((const f32x4*)F.norm_ffn_g)[lane + 64 * j];
    const float* H1 = (const float*)(F.ws + WS_H1); bf16* HN = (bf16*)(F.ws + WS_HN); float* topw = (float*)(F.ws + WS_TOPW); int* list = (int*)(F.ws + WS_LIST);
    const float brt = F.b_router[lane >> 1];
    const int hi5 = lane & 32, b4 = lane & 16, b3 = lane & 8, b2 = lane & 4, b1 = lane & 2;
#pragma unroll 1
    for (int rb = F.vcu; rb < T_TOK / 64; rb += F.G) {
#pragma unroll 1
        for (int rp = 0; rp < 4; ++rp) {
            const int rl0 = F.wave * 8 + rp * 2; const int row0 = rb * 64 + rl0;
            f32x4 hn[2][4];
#pragma unroll
            for (int r = 0; r < 2; ++r) { const GAS f32x4* xr = (const GAS f32x4*)(H1 + (size_t)(row0 + r) * DM) + lane; float s = 0.f;
#pragma unroll
                for (int j = 0; j < 4; ++j) { hn[r][j] = xr[64 * j]; s += (hn[r][j].x * hn[r][j].x + hn[r][j].y * hn[r][j].y) + (hn[r][j].z * hn[r][j].z + hn[r][j].w * hn[r][j].w); }
                const float rstd = 1.0f / sqrtf(wave_sum(s) * (1.0f / DM) + RMS_EPS);
#pragma unroll
                for (int j = 0; j < 4; ++j) { hn[r][j] = hn[r][j] * rstd * g[j];
                    if constexpr (MOE_FP8) ((GAS unsigned*)((unsigned char*)HN + (size_t)(row0 + r) * DM))[lane + 64 * j] = pg8::pk4_fp8(hn[r][j].x, hn[r][j].y, hn[r][j].z, hn[r][j].w);
                    else ((GAS unsigned long long*)(HN + (size_t)(row0 + r) * DM))[lane + 64 * j] = (unsigned long long)pk2(hn[r][j].x, hn[r][j].y) | ((unsigned long long)pk2(hn[r][j].z, hn[r][j].w) << 32); } }
            float acc[2][32];
#pragma unroll
            for (int e = 0; e < 32; ++e) { acc[0][e] = 0.f; acc[1][e] = 0.f; }
#pragma unroll
            for (int j = 0; j < 4; ++j)
#pragma unroll
                for (int eb = 0; eb < 32; eb += 8) {
#pragma unroll
                    for (int e = eb; e < eb + 8; ++e) { const f32x4 w = *(const LAS f32x4*)(wT + e * DM + 4 * (lane + 64 * j));
                        acc[0][e] += hn[0][j].x * w.x + hn[0][j].y * w.y + hn[0][j].z * w.z + hn[0][j].w * w.w;
                        acc[1][e] += hn[1][j].x * w.x + hn[1][j].y * w.y + hn[1][j].z * w.z + hn[1][j].w * w.w;
                        asm volatile("" : "+v"(acc[0][e]), "+v"(acc[1][e])); }
                    asm volatile("" ::: "memory"); }
#pragma unroll
            for (int r = 0; r < 2; ++r) {
                float b16[16], b8[8], b4v[4], b2v[2];
#pragma unroll
                for (int i = 0; i < 16; ++i) { const float send = hi5 ? acc[r][i] : acc[r][i + 16], keep = hi5 ? acc[r][i + 16] : acc[r][i]; b16[i] = keep + __shfl_xor(send, 32); }
#pragma unroll
                for (int i = 0; i < 8; ++i) { const float send = b4 ? b16[i] : b16[i + 8], keep = b4 ? b16[i + 8] : b16[i]; b8[i] = keep + __shfl_xor(send, 16); }
#pragma unroll
                for (int i = 0; i < 4; ++i) { const float send = b3 ? b8[i] : b8[i + 4], keep = b3 ? b8[i + 4] : b8[i]; b4v[i] = keep + __shfl_xor(send, 8); }
#pragma unroll
                for (int i = 0; i < 2; ++i) { const float send = b2 ? b4v[i] : b4v[i + 2], keep = b2 ? b4v[i + 2] : b4v[i]; b2v[i] = keep + __shfl_xor(send, 4); }
                float val; { const float send = b1 ? b2v[0] : b2v[1], keep = b1 ? b2v[1] : b2v[0]; val = keep + __shfl_xor(send, 2); }
                val += __shfl_xor(val, 1);
                val += brt;
                const int myidx = lane >> 1; float v = val; float selv[4]; int seli[4];
#pragma unroll
                for (int k = 0; k < 4; ++k) { float m = v;
#pragma unroll
                    for (int o = 2; o < 64; o <<= 1) m = fmaxf(m, __shfl_xor(m, o));
                    int cand = (v == m) ? myidx : 99;
#pragma unroll
                    for (int o = 2; o < 64; o <<= 1) { const int oc = __shfl_xor(cand, o); cand = oc < cand ? oc : cand; }
                    selv[k] = m; seli[k] = cand; if (myidx == cand) v = -INFINITY; }
                const float e1 = __expf(selv[1] - selv[0]), e2 = __expf(selv[2] - selv[0]), e3 = __expf(selv[3] - selv[0]); const float inv = 1.0f / (1.0f + e1 + e2 + e3);
                if (lane < 4) { const int k = lane; const int ex = k == 0 ? seli[0] : k == 1 ? seli[1] : k == 2 ? seli[2] : seli[3]; const float wk = (k == 0 ? 1.0f : k == 1 ? e1 : k == 2 ? e2 : e3) * inv;
                    const int slot = __hip_atomic_fetch_add(hist + ex, 1, __ATOMIC_RELAXED, __HIP_MEMORY_SCOPE_WORKGROUP);
                    tmp[(rl0 + r) * 4 + k] = ex | (slot << 8);
                    topw[(size_t)(row0 + r) * 4 + k] = wk; }
            }
        }
        __syncthreads();
        if (tid < 32) basel[tid] = commit ? (int)__hip_atomic_fetch_add((unsigned*)(F.ctl + CW_CNT + 64 * tid), (unsigned)hist[tid], RLX_AGENT) : 0;
        __syncthreads();
        if (tid < 256 && commit) { const int t = tmp[tid]; const int ex = t & 255, slot = t >> 8; list[(size_t)ex * LIST_CAP + basel[ex] + slot] = (rb * 64 + (tid >> 2)) * 4 + (tid & 3); }
        __syncthreads();
        if (tid < 32) hist[tid] = 0;
        __syncthreads();
    }
}
__device__ __forceinline__ int moe_tables(Frame& F) {
    LAS int* cnt = (LAS int*)(F.lds + L_CNT); LAS int* toff = (LAS int*)(F.lds + L_TOFF); LAS int* tile_e = (LAS int*)(F.lds + L_TILEE);
    __syncthreads();
    if (F.tid < 32) { const int e = F.tid; int off = 0, mine = 0;
        for (int j = 0; j < 32; ++j) { const int c = (int)__hip_atomic_load((unsigned*)(F.ctl + CW_CNT + 64 * j), RLX_AGENT); const int c2 = c > LIST_CAP ? LIST_CAP : c; const int ntl = (c2 + 255) >> 8; if (j < e) off += ntl; if (j == e) mine = c2; }
        cnt[e] = mine; toff[e] = off; const int ntl = (mine + 255) >> 8; if (e == 31) toff[32] = off + ntl;
        for (int t = 0; t < ntl; ++t) if (off + t < MAX_TILES) tile_e[off + t] = e; }
    __syncthreads();
    int NT = toff[32]; return NT > MAX_TILES ? MAX_TILES : NT;
}
__device__ __forceinline__ void p8_final(Frame& F) {
    const int gw = F.vcu * NWAVES + F.wave, NGW = F.G * NWAVES, lane = F.lane;
    f32x4 g[4];
#pragma unroll
    for (int j = 0; j < 4; ++j) g[j] = ((const f32x4*)F.norm_final_g)[lane + 64 * j];
    const float* H1 = (const float*)(F.ws + WS_H1); const bf16* YS = (const bf16*)(F.ws + WS_YSLOT);
#if PROBE_DUMP
    {
        const bf16* src = (const bf16*)(F.ws + PROBE_DUMP_OFF);
        for (int m = gw; m < T_TOK; m += NGW) { GAS f32x4* o = (GAS f32x4*)(F.out + (size_t)m * DM) + lane;
#pragma unroll
            for (int j = 0; j < 4; ++j) { const v2u w = *((const GAS v2u*)(src + (size_t)m * PROBE_DUMP_LD + PROBE_DUMP_C0) + lane + 64 * j); o[64 * j] = (f32x4){__uint_as_float(w.x << 16), __uint_as_float(w.x & 0xffff0000u), __uint_as_float(w.y << 16), __uint_as_float(w.y & 0xffff0000u)}; } }
        return;
    }
#endif
    for (int m = gw; m < T_TOK; m += NGW) {
        const GAS f32x4* xr = (const GAS f32x4*)(H1 + (size_t)m * DM) + lane; f32x4 v[4];
#pragma unroll
        for (int j = 0; j < 4; ++j) v[j] = xr[64 * j];
#pragma unroll
        for (int k = 0; k < PROBE_NSLOT; ++k) { const GAS v2u* yr = (const GAS v2u*)(YS + (size_t)(m * 4 + k) * DM) + lane;
#pragma unroll
            for (int j = 0; j < 4; ++j) { const v2u w = yr[64 * j]; v[j].x += __uint_as_float(w.x << 16); v[j].y += __uint_as_float(w.x & 0xffff0000u); v[j].z += __uint_as_float(w.y << 16); v[j].w += __uint_as_float(w.y & 0xffff0000u); } }
        float s = 0.f;
#pragma unroll
        for (int j = 0; j < 4; ++j) s += (v[j].x * v[j].x + v[j].y * v[j].y) + (v[j].z * v[j].z + v[j].w * v[j].w);
        const float rstd = 1.0f / sqrtf(wave_sum(s) * (1.0f / DM) + RMS_EPS);
        GAS f32x4* o = (GAS f32x4*)(F.out + (size_t)m * DM) + lane;
#pragma unroll
        for (int j = 0; j < 4; ++j) o[64 * j] = v[j] * rstd * g[j];
    }
}

constexpr int N_PHASES = 9;
struct Args { const float* in[15]; float* out; unsigned char* ws; int ph_lo, ph_hi; };
__global__ void __launch_bounds__(NWAVES * 64, 2) fwd_kernel(Args args) {
    extern __shared__ __attribute__((aligned(16))) unsigned char lds[];
    Frame F;
    F.lds = (LAS unsigned char*)lds;
    F.tid = threadIdx.x; F.lane = F.tid & 63; F.wave = __builtin_amdgcn_readfirstlane(F.tid >> 6);
    F.G = gridDim.x; { const int bx = blockIdx.x; F.vcu = (F.G % 8 == 0) ? (bx % 8) * (F.G / 8) + bx / 8 : bx; }
    F.ws = args.ws; F.ctl = (gu32*)(args.ws + WS_CTL); F.out = args.out;
    F.x = args.in[0]; F.norm_mix_g = args.in[1]; F.w_in = args.in[2]; F.w_proj_sb = args.in[3]; F.w_proj_moba = args.in[4]; F.w_out = args.in[5]; F.rel_bias = args.in[6]; F.norm_ffn_g = args.in[7];
    F.w_router = args.in[8]; F.b_router = args.in[9]; F.w_gate_up = args.in[10]; F.b_gate_up = args.in[11]; F.w_down = args.in[12]; F.b_down = args.in[13]; F.norm_final_g = args.in[14];
    for (int u = F.tid; u < (LDS_BYTES - LDSCTL_OFF) / 4; u += NWAVES * 64) ((LAS unsigned*)(F.lds + LDSCTL_OFF))[u] = 0u;
    __syncthreads();
    XcdBarrier bar; bar.bar = (unsigned*)(F.ctl + CW_BAR); bar.x = 0; bar.st = nullptr;
    if (MK_N_LAUNCHES == 1) bar = xcd_barrier_post((unsigned*)(F.ctl + CW_BAR), (volatile LAS unsigned*)(F.lds + L_MISC) + 8);
#define GRID_BAR() do { if (MK_N_LAUNCHES == 1) xcd_barrier(bar); } while (0)
    const int lo = args.ph_lo, hi = args.ph_hi;
#ifndef PH_MASK
#define PH_MASK 0x1ff
#endif
#define IN(k) ((((PH_MASK) >> (k)) & 1) && lo <= (k) && (k) < hi)
#define BOTH(k) (IN(k) && IN((k) + 1))
    unsigned char* ws = args.ws;

    if (IN(0)) { _Pragma("unroll") for (int rep = 0; rep < 1 + ((PROBE_REP >> 0) & 1); ++rep) { p0_prologue(F); if (BOTH(0)) GRID_BAR(); } }

    if (IN(1)) { _Pragma("unroll") for (int rep = 0; rep < 1 + ((PROBE_REP >> 1) & 1); ++rep) {
        pg8::DenseOrder S{T_TOK / 256, DIN / 256, F.G, (int)blockIdx.x, (const char*)(ws + WS_XN), (const char*)(ws + WS_WIN), (size_t)256 * DM * 2, (size_t)256 * DM * 2};
        pg8::EpiInProj E{(bf16*)(ws + WS_QKV), (bf16*)(ws + WS_GATES), (float*)(ws + WS_KPART)};
        pg8::gemm_phase<pg8::EpiInProj, pg8::DenseOrder, true, false>(F.lds + RING_OFF, S, E, DM * 2, DM * 2, DM * 2);
        if (BOTH(1)) GRID_BAR();
    } }

    if (IN(2)) { _Pragma("unroll") for (int rep = 0; rep < 1 + ((PROBE_REP >> 2) & 1); ++rep) {
        const att::bf16* QKV = (const att::bf16*)(ws + WS_QKV); att::bf16* Y = (att::bf16*)(ws + WS_Y);
        for (int v = F.vcu; v < 256; v += F.G) {
            const int bh = v >> 2, s = v & 3, b = bh >> 3, h = bh & 7;
            _Pragma("unroll") for (int r2 = 0; r2 < 1 + ((PROBE_REP >> 9) & 1); ++r2) {
            att::moba_unit(b, h, 7 - s, QKV, Y, (const float*)(ws + WS_KPART), F.rel_bias, (char*)lds + RING_OFF);
            att::moba_unit(b, h, s, QKV, Y, (const float*)(ws + WS_KPART), F.rel_bias, (char*)lds + RING_OFF); }
            _Pragma("unroll") for (int r2 = 0; r2 < 1 + ((PROBE_REP >> 10) & 1); ++r2) {
            att::sb_unit(b, h, 7 - s, QKV, Y, (char*)lds + RING_OFF);
            att::sb_unit(b, h, s, QKV, Y, (char*)lds + RING_OFF); }
        }
        if (BOTH(2)) GRID_BAR();
    } }

    if (IN(3)) { _Pragma("unroll") for (int rep = 0; rep < 1 + ((PROBE_REP >> 3) & 1); ++rep) {
        pg8::ProjOrder S{F.G, (int)blockIdx.x, (const char*)(ws + WS_Y), (const char*)(ws + WS_WPROJ)};
        pg8::EpiProjGate E{(const bf16*)(ws + WS_GATES), (bf16*)(ws + WS_MERGED)};
        pg8::gemm_phase<pg8::EpiProjGate, pg8::ProjOrder, true, false>(F.lds + RING_OFF, S, E, 512 * 2, DM * 2, DM * 2);
        if (BOTH(3)) GRID_BAR();
    } }

    if (IN(4)) { _Pragma("unroll") for (int rep = 0; rep < 1 + ((PROBE_REP >> 4) & 1); ++rep) {
        pg8::DenseOrder S{T_TOK / 256, DM / 256, F.G, (int)blockIdx.x, (const char*)(ws + WS_MERGED), (const char*)(ws + WS_WOUT), (size_t)256 * DM * 2, (size_t)256 * DM * 2};
        pg8::EpiResF32 E{F.x, (float*)(ws + WS_H1)};
        pg8::gemm_phase<pg8::EpiResF32, pg8::DenseOrder, true, false>(F.lds + RING_OFF, S, E, DM * 2, DM * 2, DM * 2);
        if (BOTH(4)) GRID_BAR();
    } }

    if (IN(5)) { if ((PROBE_REP >> 5) & 1) { p5_router(F, false); __syncthreads(); } p5_router(F, true); if (BOTH(5)) GRID_BAR(); }

    if (IN(6)) { _Pragma("unroll") for (int rep = 0; rep < 1 + ((PROBE_REP >> 6) & 1); ++rep) {
        const int NT = moe_tables(F);
        pg8::MoeOrder S{NT, 8, F.G, (int)blockIdx.x, (const LAS int*)(F.lds + L_TILEE), (const LAS int*)(F.lds + L_TOFF), (const LAS int*)(F.lds + L_CNT),
                        (const char*)(ws + WS_HN), (const char*)(ws + WS_WGU), (size_t)256 * DM * MOE_ES, (size_t)256 * DM * MOE_ES, (size_t)2048 * DM * MOE_ES, (const int*)(ws + WS_LIST), DM * MOE_ES, true};
        pg8::EpiSwiglu E{F.b_gate_up, (unsigned char*)(ws + WS_ACT)};
        pg8::gemm_phase<pg8::EpiSwiglu, pg8::MoeOrder, true, true, MOE_FP8>(F.lds + RING_OFF, S, E, DM * MOE_ES, DM * MOE_ES, DM * MOE_ES);
        if (BOTH(6)) GRID_BAR();
    } }

    if (IN(7)) { _Pragma("unroll") for (int rep = 0; rep < 1 + ((PROBE_REP >> 7) & 1); ++rep) {
        const int NT = moe_tables(F);
        pg8::MoeOrder S{NT, 4, F.G, (int)blockIdx.x, (const LAS int*)(F.lds + L_TILEE), (const LAS int*)(F.lds + L_TOFF), (const LAS int*)(F.lds + L_CNT),
                        (const char*)(ws + WS_ACT), (const char*)(ws + WS_WD), (size_t)256 * DM * MOE_ES, (size_t)256 * DM * MOE_ES, (size_t)1024 * DM * MOE_ES, (const int*)(ws + WS_LIST), DM * MOE_ES, false};
        pg8::EpiDown E{F.b_down, (const int*)(ws + WS_LIST), (const LAS int*)(F.lds + L_CNT), (const float*)(ws + WS_TOPW), (bf16*)(ws + WS_YSLOT)};
        pg8::gemm_phase<pg8::EpiDown, pg8::MoeOrder, true, false, MOE_FP8>(F.lds + RING_OFF, S, E, DM * MOE_ES, DM * MOE_ES, DM * MOE_ES);
        if (BOTH(7)) GRID_BAR();
    } }

    if (IN(8)) { for (int rep = 0; rep < 1 + ((PROBE_REP >> 8) & 1); ++rep) p8_final(F); }
#undef IN
#undef BOTH
#undef GRID_BAR
}

extern "C" void kernel_launch(void* const* d_in, const int* in_sizes, int n_in, void* d_out, int out_size, void* d_ws, size_t ws_size, hipStream_t stream) {
    static int grid = 0;
    if (grid == 0) {
        if (n_in != 15 || in_sizes[0] != T_TOK * DM || out_size != T_TOK * DM || ws_size < WS_END) { fprintf(stderr, "kernel_launch: unexpected shapes (n_in %d, in0 %d, out %d, ws %zu); nothing launched\n", n_in, n_in > 0 ? in_sizes[0] : -1, out_size, ws_size); grid = -1; return; }
        int dev = 0, cus = 0, per_cu = 0;
        if (hipGetDevice(&dev) != hipSuccess || hipDeviceGetAttribute(&cus, hipDeviceAttributeMultiprocessorCount, dev) != hipSuccess) { grid = -1; return; }
        if (hipFuncSetAttribute((const void*)fwd_kernel, hipFuncAttributeMaxDynamicSharedMemorySize, LDS_BYTES) != hipSuccess) { fprintf(stderr, "kernel_launch: hipFuncSetAttribute failed\n"); grid = -1; return; }
        if (hipOccupancyMaxActiveBlocksPerMultiprocessor(&per_cu, (const void*)fwd_kernel, NWAVES * 64, LDS_BYTES) != hipSuccess || per_cu < 1) { fprintf(stderr, "kernel_launch: occupancy query reports %d workgroups per CU\n", per_cu); }
        (void)hipGetLastError();
        grid = cus;
    }
    if (grid < 0) return;
    if (hipMemsetAsync((char*)d_ws + WS_CTL, 0, CTL_ZERO_BYTES, stream) != hipSuccess) return;
    Args a{};
    for (int i = 0; i < 15; ++i) a.in[i] = (const float*)d_in[i];
    a.out = (float*)d_out; a.ws = (unsigned char*)d_ws;
    if (MK_N_LAUNCHES == 1) { a.ph_lo = 0; a.ph_hi = N_PHASES; hipLaunchKernelGGL(fwd_kernel, dim3(grid), dim3(NWAVES * 64), LDS_BYTES, stream, a); }
    else { for (int p = 0; p < N_PHASES; ++p) { a.ph_lo = p; a.ph_hi = p + 1; hipLaunchKernelGGL(fwd_kernel, dim3(grid), dim3(NWAVES * 64), LDS_BYTES, stream, a); } }
}
```

```cpp
#include <hip/hip_runtime.h>
#include <cstdio>
#include <cstdint>
#include <cmath>

#ifndef PROBE_DUMP
#define PROBE_DUMP 0
#define PROBE_DUMP_OFF WS_GATES
#define PROBE_DUMP_LD 2048
#define PROBE_DUMP_C0 0
#endif
#ifndef PROBE_REP
#define PROBE_REP 0
#endif
#ifndef PROBE_NSLOT
#define PROBE_NSLOT 4
#endif
#ifndef MK_N_LAUNCHES
#define MK_N_LAUNCHES 1
#endif

constexpr int T_TOK = 16384, DM = 1024, DIN = 5120, NEXP = 32, TOPK = 4, SEQ = 2048, NBATCH = 8, NHEAD = 8;
constexpr int QKV_LD = 3072, GATE_LD = 2048;
#ifndef MOE_FP8_SW
#define MOE_FP8_SW 1
#endif
constexpr bool MOE_FP8 = MOE_FP8_SW != 0;
constexpr int MOE_ES = MOE_FP8 ? 1 : 2;
constexpr float MOE_WSCALE = MOE_FP8 ? 64.0f : 1.0f, MOE_WINV = MOE_FP8 ? (1.0f / 64.0f) : 1.0f;
constexpr float C2F = 0.125f * 1.4426950408889634f;
constexpr float LOG2E = 1.4426950408889634f;
constexpr float RMS_EPS = 1e-6f;
constexpr int LIST_CAP = 16384;
constexpr int MAX_TILES = 288;

namespace pg8 {
#define PG8_LAS __attribute__((address_space(3)))
typedef unsigned short bf16_t;
typedef short bf16x8 __attribute__((ext_vector_type(8)));
typedef float f32x4 __attribute__((ext_vector_type(4)));
typedef float f32x2 __attribute__((ext_vector_type(2)));
typedef unsigned u32x4 __attribute__((ext_vector_type(4)));
typedef unsigned u32x2 __attribute__((ext_vector_type(2)));
constexpr int BM = 256, BK = 64, HALF = 128, HTB = HALF * BK * 2, STAGE_BYTES = 8 * HTB, NXCD = 8, WGM = 8;

__host__ __device__ __forceinline__ int lds_byte(int r, int c) { const int st = (r >> 4) * 2 + (c >> 5), rr = r & 15, cc = c & 31, ob = rr * 64 + cc * 2; return st * 1024 + (ob ^ (((ob >> 9) & 1) << 5)); }
__host__ __device__ __forceinline__ void stage_rc(int b, int& R, int& C) { const int st = b / 1024, sb = b % 1024, swz = sb ^ (((sb >> 9) & 1) << 5); R = (st >> 1) * 16 + swz / 64; C = (st & 1) * 32 + (swz % 64) / 2; }
__host__ __device__ __forceinline__ int perm32(int rho) { const int n = rho >> 4, i = rho & 15; return 8 * (i >> 2) + 4 * n + (i & 3); }

typedef int i32x8 __attribute__((ext_vector_type(8)));
typedef int i32x4 __attribute__((ext_vector_type(4)));
__device__ __forceinline__ i32x8 pk32(bf16x8 lo, bf16x8 hi) { const i32x4 a = __builtin_bit_cast(i32x4, lo), b = __builtin_bit_cast(i32x4, hi); return (i32x8){a[0], a[1], a[2], a[3], b[0], b[1], b[2], b[3]}; }
struct Unit { int pm, pn, e, aux; };

__device__ __forceinline__ bool static_tile(int i, int G, int c, int nM, int nN, int& pm, int& pn) {
    const int nwg = nM * nN; const long L = (long)i * G + c; if (L >= nwg) return false;
    int wgid = (int)L; { const int q = nwg / NXCD, r = nwg % NXCD, xcd = wgid % NXCD, off = wgid / NXCD; wgid = (xcd < r ? xcd * (q + 1) : r * (q + 1) + (xcd - r) * q) + off; }
    const int nig = WGM * nN, gid = wgid / nig, fm = gid * WGM, gsz = (nM - fm) < WGM ? (nM - fm) : WGM;
    pm = fm + ((wgid % nig) % gsz); pn = (wgid % nig) / gsz; return true;
}

typedef __bf16 bf16x2_t __attribute__((ext_vector_type(2)));
__device__ __forceinline__ unsigned cvt_pk_bf16(float lo, float hi) { f32x2 v = {lo, hi}; bf16x2_t b = __builtin_convertvector(v, bf16x2_t); return __builtin_bit_cast(unsigned, b); }
__device__ __forceinline__ unsigned pk4_fp8(float a, float b, float c, float d) { int p = __builtin_amdgcn_cvt_pk_fp8_f32(a, b, 0, false); p = __builtin_amdgcn_cvt_pk_fp8_f32(c, d, p, true); return (unsigned)p; }
__device__ __forceinline__ float bf_lo(unsigned w) { return __uint_as_float(w << 16); }
__device__ __forceinline__ float bf_hi(unsigned w) { return __uint_as_float(w & 0xffff0000u); }

template <class Epi, class Sched, bool ALIGN_EPI, bool GATHER, bool FP8 = false>
__device__ __forceinline__ void gemm_phase(PG8_LAS unsigned char* lds, const Sched& S, const Epi& E, const int KB, const int ldaB, const int ldbB) {
    const int tid = threadIdx.x, wid = __builtin_amdgcn_readfirstlane(tid >> 6), lane = tid & 63, wr = wid >> 2, wc = wid & 3, fr = lane & 15, fq = lane >> 4;
    const int nt = KB / (BK * 2);
    unsigned voA[2][2], voN[2][2], voffB[2]; int RA[2], CA[2];
#pragma unroll
    for (int i = 0; i < 2; ++i) { int R, C; stage_rc(tid * 16 + i * 8192, R, C); const int Rb = Epi::PERM ? ((R & ~31) + perm32(R & 31)) : R;
        RA[i] = R; CA[i] = C; voffB[i] = (unsigned)(Rb * ldbB + C * 2);
#pragma unroll
        for (int h = 0; h < 2; ++h) voA[h][i] = (unsigned)((h * HALF + R) * ldaB + C * 2); }
    const size_t kstep = (size_t)(BK * 2);
    const size_t hstepB = (size_t)HALF * ldbB;
    const unsigned ldsw = (unsigned)wid * 1024u;
    const int aoff = lds_byte(wr * 64 + fr, fq * 8), boff = lds_byte(wc * 32 + fr, fq * 8);
#define PG8_SA(b, h) (((b) * 2 + (h)) * HTB)
#define PG8_SB(b, h) ((4 + (b) * 2 + (h)) * HTB)
#define PG8_STAGE(bufoff, gbase, voff) do { _Pragma("unroll") for (int _i = 0; _i < 2; ++_i) \
        __builtin_amdgcn_global_load_lds((const unsigned*)((const char*)(gbase) + (voff)[_i]), (PG8_LAS unsigned*)(lds + (bufoff) + ldsw + _i * 8192), 16, 0, 0); } while (0)
#define PG8_LD8(dst, off) do { const i32x4 _lo = *(const PG8_LAS i32x4*)(lds + (off)); const i32x4 _hi = *(const PG8_LAS i32x4*)(lds + (off) + 1024); dst = __builtin_shufflevector(_lo, _hi, 0, 1, 2, 3, 4, 5, 6, 7); } while (0)
#define PG8_LDA(dst, b, h) do { _Pragma("unroll") for (int m = 0; m < 4; ++m) PG8_LD8(dst[m], PG8_SA(b, h) + aoff + m * 2048); } while (0)
#define PG8_LDB(dst, b, h) do { _Pragma("unroll") for (int n = 0; n < 2; ++n) PG8_LD8(dst[n], PG8_SB(b, h) + boff + n * 2048); } while (0)
#define PG8_LO(x) __builtin_bit_cast(bf16x8, __builtin_shufflevector(x, x, 0, 1, 2, 3))
#define PG8_HI(x) __builtin_bit_cast(bf16x8, __builtin_shufflevector(x, x, 4, 5, 6, 7))
#define PG8_MMA(ai, bj, At, Bt) do { __builtin_amdgcn_s_setprio(1); _Pragma("unroll") for (int m = 0; m < 4; ++m) _Pragma("unroll") for (int n = 0; n < 2; ++n) { \
        if constexpr (FP8) { asm volatile("v_mfma_f32_16x16x128_f8f6f4 %0, %1, %2, %0" : "+v"(acc[ai][bj][m][n]) : "v"(Bt[n]), "v"(At[m])); } \
        else { acc[ai][bj][m][n] = __builtin_amdgcn_mfma_f32_16x16x32_bf16(PG8_LO(Bt[n]), PG8_LO(At[m]), acc[ai][bj][m][n], 0, 0, 0); \
               acc[ai][bj][m][n] = __builtin_amdgcn_mfma_f32_16x16x32_bf16(PG8_HI(Bt[n]), PG8_HI(At[m]), acc[ai][bj][m][n], 0, 0, 0); } } __builtin_amdgcn_s_setprio(0); } while (0)
#define PG8_WAIT_V(n) asm volatile("s_waitcnt vmcnt(" #n ")" ::: "memory")
#define PG8_WAIT_L(n) asm volatile("s_waitcnt lgkmcnt(" #n ")" ::: "memory")
#define PG8_BAR __builtin_amdgcn_s_barrier()
#define PG8_SCHED __builtin_amdgcn_sched_barrier(0)
    Unit cur, nxt; int ui = 0;
    if (!S.next(0, cur)) return;
    if constexpr (GATHER) S.a_rows(cur, RA, CA, voA);
#pragma unroll
    for (int h = 0; h < 2; ++h)
#pragma unroll
        for (int i = 0; i < 2; ++i) voN[h][i] = voA[h][i];
    f32x4 acc[2][2][4][2];
#pragma unroll
    for (int a = 0; a < 2; ++a)
#pragma unroll
        for (int b = 0; b < 2; ++b)
#pragma unroll
            for (int m = 0; m < 4; ++m)
#pragma unroll
                for (int n = 0; n < 2; ++n) acc[a][b][m][n] = (f32x4){0.f, 0.f, 0.f, 0.f};
    i32x8 At[4], B0[2], B1[2];
    const char* cA = S.a_base(cur); const char* cB = S.b_base(cur);
    PG8_STAGE(PG8_SB(0, 0), cB, voffB); PG8_STAGE(PG8_SB(0, 1), cB + hstepB, voffB); PG8_STAGE(PG8_SA(0, 0), cA, voA[0]); PG8_STAGE(PG8_SA(0, 1), cA, voA[1]);
    if (wr == 1) PG8_BAR;
    PG8_WAIT_V(2); PG8_BAR;
    PG8_STAGE(PG8_SB(1, 0), cB + kstep, voffB); PG8_STAGE(PG8_SA(1, 0), cA + kstep, voA[0]); PG8_STAGE(PG8_SB(1, 1), cB + hstepB + kstep, voffB);
    PG8_WAIT_V(6); PG8_BAR;
    for (;;) {
        const bool has_next = S.next(ui + 1, nxt);
        const char* nA = has_next ? S.a_base(nxt) : cA; const char* nB = has_next ? S.b_base(nxt) : cB;
        if constexpr (GATHER) { if (has_next) S.a_rows(nxt, RA, CA, voN); }
#pragma unroll 1
        for (int t = 0; t < nt; t += 2) {
            const bool last = (t == nt - 2);
            const char* a1 = cA + (size_t)(t + 1) * kstep;
            const char* a2 = last ? nA : cA + (size_t)(t + 2) * kstep; const char* b2 = last ? nB : cB + (size_t)(t + 2) * kstep;
            const char* a3 = a2 + kstep; const char* b3 = b2 + kstep;
            unsigned v2[2][2];
#pragma unroll
            for (int h = 0; h < 2; ++h)
#pragma unroll
                for (int i = 0; i < 2; ++i) v2[h][i] = voA[h][i];
            if constexpr (GATHER) { if (last) { asm volatile("" : "+v"(voN[0][0]), "+v"(voN[0][1]), "+v"(voN[1][0]), "+v"(voN[1][1]));
#pragma unroll
                for (int h = 0; h < 2; ++h)
#pragma unroll
                    for (int i = 0; i < 2; ++i) v2[h][i] = voN[h][i]; } }
            PG8_LDB(B0, 0, 0); PG8_LDB(B1, 0, 1); PG8_SCHED; PG8_LDA(At, 0, 0); PG8_STAGE(PG8_SA(1, 1), a1, voA[1]);
            PG8_WAIT_V(8); PG8_WAIT_L(0); PG8_BAR; PG8_MMA(0, 0, At, B0); PG8_MMA(0, 1, At, B1); PG8_BAR; PG8_SCHED;
            PG8_LDA(At, 0, 1); PG8_STAGE(PG8_SB(0, 0), b2, voffB); PG8_STAGE(PG8_SB(0, 1), b2 + hstepB, voffB); PG8_STAGE(PG8_SA(0, 0), a2, v2[0]);
            PG8_WAIT_V(8); PG8_WAIT_L(0); PG8_BAR; PG8_MMA(1, 0, At, B0); PG8_MMA(1, 1, At, B1); PG8_BAR; PG8_SCHED;
            PG8_LDB(B0, 1, 0); PG8_LDB(B1, 1, 1); PG8_SCHED; PG8_LDA(At, 1, 0); PG8_STAGE(PG8_SA(0, 1), a2, v2[1]);
            PG8_WAIT_V(8); PG8_WAIT_L(0); PG8_BAR; PG8_MMA(0, 0, At, B0); PG8_MMA(0, 1, At, B1); PG8_BAR; PG8_SCHED;
            PG8_LDA(At, 1, 1); PG8_STAGE(PG8_SB(1, 0), b3, voffB); PG8_STAGE(PG8_SB(1, 1), b3 + hstepB, voffB); PG8_STAGE(PG8_SA(1, 0), a3, v2[0]);
            PG8_WAIT_V(8); PG8_WAIT_L(0); PG8_BAR; PG8_MMA(1, 0, At, B0); PG8_MMA(1, 1, At, B1); PG8_BAR; PG8_SCHED;
        }
        if constexpr (ALIGN_EPI) { if (wr == 0) PG8_BAR; }
        if constexpr (FP8) {
            asm volatile("s_nop 15\n\ts_nop 15" : "+v"(acc[0][0][0][0]), "+v"(acc[0][0][0][1]), "+v"(acc[0][0][1][0]), "+v"(acc[0][0][1][1]), "+v"(acc[0][0][2][0]), "+v"(acc[0][0][2][1]), "+v"(acc[0][0][3][0]), "+v"(acc[0][0][3][1]),
                         "+v"(acc[0][1][0][0]), "+v"(acc[0][1][0][1]), "+v"(acc[0][1][1][0]), "+v"(acc[0][1][1][1]), "+v"(acc[0][1][2][0]), "+v"(acc[0][1][2][1]), "+v"(acc[0][1][3][0]), "+v"(acc[0][1][3][1]));
            asm volatile("" : "+v"(acc[1][0][0][0]), "+v"(acc[1][0][0][1]), "+v"(acc[1][0][1][0]), "+v"(acc[1][0][1][1]), "+v"(acc[1][0][2][0]), "+v"(acc[1][0][2][1]), "+v"(acc[1][0][3][0]), "+v"(acc[1][0][3][1]),
                         "+v"(acc[1][1][0][0]), "+v"(acc[1][1][0][1]), "+v"(acc[1][1][1][0]), "+v"(acc[1][1][1][1]), "+v"(acc[1][1][2][0]), "+v"(acc[1][1][2][1]), "+v"(acc[1][1][3][0]), "+v"(acc[1][1][3][1])); }
        E(acc, cur, wr, wc, fr, fq);
        if (!has_next) break;
#pragma unroll
        for (int a = 0; a < 2; ++a)
#pragma unroll
            for (int b = 0; b < 2; ++b)
#pragma unroll
                for (int m = 0; m < 4; ++m)
#pragma unroll
                    for (int n = 0; n < 2; ++n) acc[a][b][m][n] = (f32x4){0.f, 0.f, 0.f, 0.f};
        cur = nxt; cA = nA; cB = nB; ++ui;
#pragma unroll
        for (int h = 0; h < 2; ++h)
#pragma unroll
            for (int i = 0; i < 2; ++i) voA[h][i] = voN[h][i];
        if constexpr (ALIGN_EPI) { if (wr == 1) PG8_BAR; }
    }
    PG8_WAIT_V(0);
    if constexpr (!ALIGN_EPI) { if (wr == 0) PG8_BAR; }
    PG8_BAR;
#undef PG8_SA
#undef PG8_SB
#undef PG8_STAGE
#undef PG8_LDA
#undef PG8_LDB
#undef PG8_LD8
#undef PG8_LO
#undef PG8_HI
#undef PG8_MMA
#undef PG8_WAIT_V
#undef PG8_WAIT_L
#undef PG8_BAR
#undef PG8_SCHED
}

__device__ __forceinline__ float sigmoidf_fast(float x) { return __builtin_amdgcn_rcpf(1.0f + __builtin_amdgcn_exp2f(-LOG2E * x)); }

struct EpiInProj {
    static constexpr bool PERM = true;
    bf16_t* qkv; bf16_t* gates; float* kpart;
    __device__ __forceinline__ void operator()(const f32x4 (&acc)[2][2][4][2], const Unit& u, int wr, int wc, int fr, int fq) const {
        const int row0 = u.pm * BM + wr * 64 + fr; const int pn = u.pn;
        const int cw = wc * 32 + 8 * fq;
        if (pn < 12) {
            const float sc = (pn < 2 || pn == 6 || pn == 7) ? C2F : 1.0f;
            bf16_t* base = qkv + pn * BM + cw;
#pragma unroll
            for (int ai = 0; ai < 2; ++ai)
#pragma unroll
                for (int m = 0; m < 4; ++m) { bf16_t* rowp = base + (size_t)(row0 + ai * HALF + m * 16) * QKV_LD;
#pragma unroll
                    for (int bj = 0; bj < 2; ++bj) { const f32x4 v0 = acc[ai][bj][m][0] * sc, v1 = acc[ai][bj][m][1] * sc;
                        u32x4 w; w.x = cvt_pk_bf16(v0[0], v0[1]); w.y = cvt_pk_bf16(v0[2], v0[3]); w.z = cvt_pk_bf16(v1[0], v1[1]); w.w = cvt_pk_bf16(v1[2], v1[3]);
                        *(u32x4*)(rowp + bj * HALF) = w; } }
            if (pn == 8 || pn == 9) {
#pragma unroll
                for (int bj = 0; bj < 2; ++bj)
#pragma unroll
                    for (int n = 0; n < 2; ++n) { f32x4 s = (f32x4){0.f, 0.f, 0.f, 0.f};
#pragma unroll
                        for (int ai = 0; ai < 2; ++ai)
#pragma unroll
                            for (int m = 0; m < 4; ++m) s += acc[ai][bj][m][n];
#pragma unroll
                        for (int o = 1; o < 16; o <<= 1) { s[0] += __shfl_xor(s[0], o); s[1] += __shfl_xor(s[1], o); s[2] += __shfl_xor(s[2], o); s[3] += __shfl_xor(s[3], o); }
                        if (fr == 0) *(f32x4*)(kpart + (size_t)(u.pm * 2 + wr) * 512 + (pn - 8) * BM + bj * HALF + cw + 4 * n) = s; }
            }
        } else {
            bf16_t* base = gates + (pn - 12) * BM + cw;
#pragma unroll
            for (int ai = 0; ai < 2; ++ai)
#pragma unroll
                for (int m = 0; m < 4; ++m) { bf16_t* rowp = base + (size_t)(row0 + ai * HALF + m * 16) * GATE_LD;
#pragma unroll
                    for (int bj = 0; bj < 2; ++bj) { const f32x4 a0 = acc[ai][bj][m][0], a1 = acc[ai][bj][m][1];
                        u32x4 w; w.x = cvt_pk_bf16(sigmoidf_fast(a0[0]), sigmoidf_fast(a0[1])); w.y = cvt_pk_bf16(sigmoidf_fast(a0[2]), sigmoidf_fast(a0[3]));
                        w.z = cvt_pk_bf16(sigmoidf_fast(a1[0]), sigmoidf_fast(a1[1])); w.w = cvt_pk_bf16(sigmoidf_fast(a1[2]), sigmoidf_fast(a1[3]));
                        *(u32x4*)(rowp + bj * HALF) = w; } }
        }
    }
};

struct EpiProjGate {
    static constexpr bool PERM = true;
    const bf16_t* gates; bf16_t* merged;
    __device__ __forceinline__ void operator()(const f32x4 (&acc)[2][2][4][2], const Unit& u, int wr, int wc, int fr, int fq) const {
        const int row0 = u.pm * BM + wr * 64 + fr; const int col0 = u.pn * BM + wc * 32 + 8 * fq; const int br = u.e;
#pragma unroll
        for (int ai = 0; ai < 2; ++ai)
#pragma unroll
            for (int m = 0; m < 4; ++m) { const size_t row = (size_t)(row0 + ai * HALF + m * 16);
#pragma unroll
                for (int bj = 0; bj < 2; ++bj) {
                    const u32x4 g = *(const u32x4*)(gates + row * GATE_LD + br * DM + col0 + bj * HALF);
                    f32x4 v0 = acc[ai][bj][m][0], v1 = acc[ai][bj][m][1];
                    v0[0] *= bf_lo(g.x); v0[1] *= bf_hi(g.x); v0[2] *= bf_lo(g.y); v0[3] *= bf_hi(g.y);
                    v1[0] *= bf_lo(g.z); v1[1] *= bf_hi(g.z); v1[2] *= bf_lo(g.w); v1[3] *= bf_hi(g.w);
                    bf16_t* op = merged + row * DM + col0 + bj * HALF;
                    if (br == 1) { const u32x4 p = *(const u32x4*)op;
                        v0[0] += bf_lo(p.x); v0[1] += bf_hi(p.x); v0[2] += bf_lo(p.y); v0[3] += bf_hi(p.y);
                        v1[0] += bf_lo(p.z); v1[1] += bf_hi(p.z); v1[2] += bf_lo(p.w); v1[3] += bf_hi(p.w); }
                    u32x4 w; w.x = cvt_pk_bf16(v0[0], v0[1]); w.y = cvt_pk_bf16(v0[2], v0[3]); w.z = cvt_pk_bf16(v1[0], v1[1]); w.w = cvt_pk_bf16(v1[2], v1[3]);
                    *(u32x4*)op = w; } }
    }
};

struct EpiResF32 {
    static constexpr bool PERM = false;
    const float* x; float* h1;
    __device__ __forceinline__ void operator()(const f32x4 (&acc)[2][2][4][2], const Unit& u, int wr, int wc, int fr, int fq) const {
        const int row0 = u.pm * BM + wr * 64 + fr; const int col0 = u.pn * BM + wc * 32 + 4 * fq;
#pragma unroll
        for (int ai = 0; ai < 2; ++ai)
#pragma unroll
            for (int m = 0; m < 4; ++m) { const size_t off = (size_t)(row0 + ai * HALF + m * 16) * DM + col0;
#pragma unroll
                for (int bj = 0; bj < 2; ++bj)
#pragma unroll
                    for (int n = 0; n < 2; ++n) { const f32x4 b = *(const f32x4*)(x + off + bj * HALF + n * 16); *(f32x4*)(h1 + off + bj * HALF + n * 16) = b + acc[ai][bj][m][n]; } }
    }
};

struct EpiSwiglu {
    static constexpr bool PERM = true;
    const float* bgu; unsigned char* act;
    __device__ __forceinline__ void operator()(const f32x4 (&acc)[2][2][4][2], const Unit& u, int wr, int wc, int fr, int fq) const {
        const int row0 = u.pm * BM + wr * 64 + fr; const int f0 = u.pn * HALF + wc * 32 + 8 * fq;
        const float* bp = bgu + (size_t)u.e * 2048 + f0;
        const f32x4 bg0 = *(const f32x4*)(bp), bg1 = *(const f32x4*)(bp + 4), bu0 = *(const f32x4*)(bp + 1024), bu1 = *(const f32x4*)(bp + 1028);
#pragma unroll
        for (int ai = 0; ai < 2; ++ai)
#pragma unroll
            for (int m = 0; m < 4; ++m) { float y[8];
#pragma unroll
                for (int n = 0; n < 2; ++n)
#pragma unroll
                    for (int j = 0; j < 4; ++j) { const float g = fminf(acc[ai][0][m][n][j] * MOE_WINV + (n ? bg1[j] : bg0[j]), 7.0f);
                        const float up = fminf(fmaxf(acc[ai][1][m][n][j] * MOE_WINV + (n ? bu1[j] : bu0[j]), -7.0f), 7.0f);
                        y[n * 4 + j] = (up + 1.0f) * (g * __builtin_amdgcn_rcpf(1.0f + __builtin_amdgcn_exp2f(-1.702f * LOG2E * g))); }
                unsigned char* op = act + ((size_t)(row0 + ai * HALF + m * 16) * DM + f0) * MOE_ES;
                if constexpr (MOE_FP8) { u32x2 w; w.x = pk4_fp8(y[0], y[1], y[2], y[3]); w.y = pk4_fp8(y[4], y[5], y[6], y[7]); *(u32x2*)op = w; }
                else { u32x4 w; w.x = cvt_pk_bf16(y[0], y[1]); w.y = cvt_pk_bf16(y[2], y[3]); w.z = cvt_pk_bf16(y[4], y[5]); w.w = cvt_pk_bf16(y[6], y[7]); *(u32x4*)op = w; } }
    }
};

struct EpiDown {
    static constexpr bool PERM = true;
    const float* bd; const int* list; const PG8_LAS int* cnt; const float* topw; bf16_t* yslot;
    __device__ __forceinline__ void operator()(const f32x4 (&acc)[2][2][4][2], const Unit& u, int wr, int wc, int fr, int fq) const {
        const int e = u.e, lt = u.aux; const int nvalid = cnt[e] - lt * BM; const int col0 = u.pn * BM + wc * 32 + 8 * fq;
        const float* bp = bd + (size_t)e * DM + col0;
        f32x4 bv[2][2];
#pragma unroll
        for (int bj = 0; bj < 2; ++bj)
#pragma unroll
            for (int n = 0; n < 2; ++n) bv[bj][n] = *(const f32x4*)(bp + bj * HALF + 4 * n);
#pragma unroll
        for (int ai = 0; ai < 2; ++ai)
#pragma unroll
            for (int m = 0; m < 4; ++m) { const int r = ai * HALF + wr * 64 + m * 16 + fr;
                if (r < nvalid) { const int id = list[(size_t)e * LIST_CAP + lt * BM + r]; const float w = topw[id]; bf16_t* rowp = yslot + (size_t)id * DM + col0;
#pragma unroll
                    for (int bj = 0; bj < 2; ++bj) { const f32x4 v0 = (acc[ai][bj][m][0] * MOE_WINV + bv[bj][0]) * w, v1 = (acc[ai][bj][m][1] * MOE_WINV + bv[bj][1]) * w;
                        u32x4 o; o.x = cvt_pk_bf16(v0[0], v0[1]); o.y = cvt_pk_bf16(v0[2], v0[3]); o.z = cvt_pk_bf16(v1[0], v1[1]); o.w = cvt_pk_bf16(v1[2], v1[3]);
                        *(u32x4*)(rowp + bj * HALF) = o; } } }
    }
};

struct DenseOrder {
    int nM, nN, G, c; const char* A; const char* Bt; size_t astep, bstep;
    __device__ __forceinline__ bool next(int i, Unit& u) const { u.e = 0; u.aux = 0; return static_tile(i, G, c, nM, nN, u.pm, u.pn); }
    __device__ __forceinline__ const char* a_base(const Unit& u) const { return A + (size_t)u.pm * astep; }
    __device__ __forceinline__ const char* b_base(const Unit& u) const { return Bt + (size_t)u.pn * bstep; }
    __device__ __forceinline__ void a_rows(const Unit&, const int (&)[2], const int (&)[2], unsigned (&)[2][2]) const {}
};
struct ProjOrder {
    int G, c; const char* Y; const char* Wp;
    __device__ __forceinline__ bool next(int i, Unit& u) const { u.e = i & 1; u.aux = 0; return static_tile(i >> 1, G, c, T_TOK / BM, DM / BM, u.pm, u.pn); }
    __device__ __forceinline__ const char* a_base(const Unit& u) const { return Y + ((size_t)u.pm * BM * DM + u.e * 512) * 2; }
    __device__ __forceinline__ const char* b_base(const Unit& u) const { return Wp + ((size_t)u.pn * BM * DM + u.e * 512) * 2; }
    __device__ __forceinline__ void a_rows(const Unit&, const int (&)[2], const int (&)[2], unsigned (&)[2][2]) const {}
};
struct MoeOrder {
    int NT, nN, G, c; const PG8_LAS int* tile_e; const PG8_LAS int* tileoff; const PG8_LAS int* cnt;
    const char* A; const char* Bt; size_t astep, bstep, bexp; const int* list; int lda; bool gather;
    __device__ __forceinline__ bool next(int i, Unit& u) const { if (!static_tile(i, G, c, NT, nN, u.pm, u.pn)) return false; u.e = tile_e[u.pm]; u.aux = u.pm - tileoff[u.e]; return true; }
    __device__ __forceinline__ const char* a_base(const Unit& u) const { return gather ? A : A + (size_t)u.pm * astep; }
    __device__ __forceinline__ const char* b_base(const Unit& u) const { return Bt + (size_t)u.e * bexp + (size_t)u.pn * bstep; }
    __device__ __forceinline__ void a_rows(const Unit& u, const int (&RA)[2], const int (&CA)[2], unsigned (&vo)[2][2]) const {
        const int n = cnt[u.e] - u.aux * BM; const int* lp = list + (size_t)u.e * LIST_CAP + u.aux * BM;
#pragma unroll
        for (int h = 0; h < 2; ++h)
#pragma unroll
            for (int i = 0; i < 2; ++i) { const int r = h * HALF + RA[i]; const int id = (r < n) ? lp[r] : 0; vo[h][i] = (unsigned)((id >> 2) * lda + CA[i] * 2); }
    }
};
}

namespace att {
typedef unsigned short bf16;
using bf16x8 = __attribute__((ext_vector_type(8))) short;
using s16x4 = __attribute__((ext_vector_type(4))) short;
using f32x16 = __attribute__((ext_vector_type(16))) float;
using u32x4 = __attribute__((ext_vector_type(4))) unsigned;
using f32x4 = __attribute__((ext_vector_type(4))) float;
constexpr int NW = 8, KVBLK = 64, NSLOT = 3, SLOTB = 8192, PITCH = QKV_LD;
constexpr int LDS_K = 0, LDS_V = NSLOT * SLOTB, LDS_WS = 2 * NSLOT * SLOTB, LDS_OST = LDS_WS + NW * 64 * 4, LDS_KM = LDS_OST + NW * 4096, LDS_LUT = LDS_KM + 2048, LDS_FLG = LDS_LUT + 512, LDS_BYTES = LDS_FLG + 64;
__device__ __forceinline__ int crow(int r, int hi) { return (r & 3) + 8 * (r >> 2) + 4 * hi; }
#define SBAR() __builtin_amdgcn_sched_barrier(0)
__device__ __forceinline__ void glds16(const void* gsrc, unsigned lds_dst) { unsigned keep;
    asm volatile("s_mov_b32 %0, m0\n\ts_mov_b32 m0, %2\n\ts_nop 0\n\tglobal_load_lds_dwordx4 %1, off\n\ts_mov_b32 m0, %0" : "=&s"(keep) : "v"(gsrc), "s"(lds_dst) : "memory"); }
typedef float f32x2_t __attribute__((ext_vector_type(2))); typedef __bf16 bf16x2_t __attribute__((ext_vector_type(2)));
__device__ __forceinline__ unsigned cvtpk_s(float lo, float hi) { f32x2_t v = {lo, hi}; bf16x2_t b = __builtin_convertvector(v, bf16x2_t); return __builtin_bit_cast(unsigned, b); }
#define WAIT_BAR(N) asm volatile("s_waitcnt vmcnt(" #N ") lgkmcnt(0)\n\ts_barrier" ::: "memory")
typedef __attribute__((address_space(3))) const char* lds_cptr;

__device__ __forceinline__ void qkt(f32x16& p0, f32x16& p1, lds_cptr Kslot, const bf16x8* qr, const f32x16& c0, int r32, int hi) {
    lds_cptr kb = Kslot + hi * 1024 + r32 * 16;
#pragma unroll
    for (int d0 = 0; d0 < 4; ++d0) {
        const bf16x8 b0 = *(const __attribute__((address_space(3))) bf16x8*)(kb + d0 * 2048);
        const bf16x8 b1 = *(const __attribute__((address_space(3))) bf16x8*)(kb + d0 * 2048 + 512);
        if (d0 == 0) { p0 = __builtin_amdgcn_mfma_f32_32x32x16_bf16(b0, qr[0], c0, 0, 0, 0); p1 = __builtin_amdgcn_mfma_f32_32x32x16_bf16(b1, qr[0], c0, 0, 0, 0); }
        else { p0 = __builtin_amdgcn_mfma_f32_32x32x16_bf16(b0, qr[d0], p0, 0, 0, 0); p1 = __builtin_amdgcn_mfma_f32_32x32x16_bf16(b1, qr[d0], p1, 0, 0, 0); } }
}
__device__ __forceinline__ void pv(f32x16* o, int vb, bf16x8 pa0, bf16x8 pa1, bf16x8 pa2, bf16x8 pa3) {
#pragma unroll
    for (int d0 = 0; d0 < 2; ++d0) { s16x4 lo[4], hi[4];
#pragma unroll
        for (int ks = 0; ks < 4; ++ks) {
            asm volatile("ds_read_b64_tr_b16 %0,%1 offset:%c2" : "=&v"(lo[ks]) : "v"(vb), "i"(d0 * 4096 + ks * 1024) : "memory");
            asm volatile("ds_read_b64_tr_b16 %0,%1 offset:%c2" : "=&v"(hi[ks]) : "v"(vb), "i"(d0 * 4096 + ks * 1024 + 512) : "memory"); }
        asm volatile("s_waitcnt lgkmcnt(0)" ::: "memory"); SBAR();
#define PK(k) (bf16x8){lo[k][0], lo[k][1], lo[k][2], lo[k][3], hi[k][0], hi[k][1], hi[k][2], hi[k][3]}
        o[d0] = __builtin_amdgcn_mfma_f32_32x32x16_bf16(pa0, PK(0), o[d0], 0, 0, 0);
        o[d0] = __builtin_amdgcn_mfma_f32_32x32x16_bf16(pa1, PK(1), o[d0], 0, 0, 0);
        o[d0] = __builtin_amdgcn_mfma_f32_32x32x16_bf16(pa2, PK(2), o[d0], 0, 0, 0);
        o[d0] = __builtin_amdgcn_mfma_f32_32x32x16_bf16(pa3, PK(3), o[d0], 0, 0, 0);
#undef PK
    }
}
__device__ __forceinline__ float swap32(float v, int hi) {
    auto rr = __builtin_amdgcn_permlane32_swap(__float_as_uint(v), __float_as_uint(v), false, false);
    return __uint_as_float(hi ? rr[0] : rr[1]);
}
__device__ __forceinline__ void store_o(const f32x16* o, const float* rs, bf16* Ow, int ldo, char* shm, int wid, int lane, int r32, int hi) {
    bf16* stg = (bf16*)(shm + LDS_OST) + wid * 2048;
#pragma unroll
    for (int r = 0; r < 16; ++r) { const int orow = crow(r, hi);
#pragma unroll
        for (int d0 = 0; d0 < 2; ++d0) { const float v = o[d0][r] * rs[r]; const unsigned u = __float_as_uint(v); stg[orow * 64 + d0 * 32 + r32] = (bf16)((u + 0x7fffu + ((u >> 16) & 1u)) >> 16); } }
    asm volatile("s_waitcnt lgkmcnt(0)" ::: "memory");
#pragma unroll
    for (int i = 0; i < 4; ++i) { const int row = i * 8 + (lane >> 3), ch = lane & 7; const u32x4 v = *(const u32x4*)(stg + row * 64 + ch * 8); *(u32x4*)(Ow + (long)row * ldo + ch * 8) = v; }
}
#define PKW(P, B) cvtpk_s(P[B], P[B + 1])

__device__ __forceinline__ void sb_unit(int b, int h, int qb, const bf16* QKV, bf16* Y, char* shm) {
    const int tid = threadIdx.x, lane = tid & 63, r32 = lane & 31, hi = lane >> 5; const int wid = __builtin_amdgcn_readfirstlane(tid >> 6);
    const long rowbase = (long)b * SEQ; const int q0 = qb * 256;
    const bf16* Qw = QKV + (rowbase + q0 + wid * 32) * PITCH + h * 64;
    const bf16* Kh = QKV + rowbase * PITCH + 512 + h * 64; const bf16* Vh = QKV + rowbase * PITCH + 1024 + h * 64;
    const unsigned lds0 = (unsigned)(uintptr_t)shm;
    const lds_cptr shm3 = (lds_cptr)shm;
    volatile __attribute__((address_space(3))) unsigned* flg = (volatile __attribute__((address_space(3))) unsigned*)(shm3 + LDS_FLG);
    const bf16* ksrc = Kh + (long)lane * PITCH + wid * 8;
    const bf16* vsrc = Vh + (long)(16 * (wid & 3) + (lane >> 2)) * PITCH + (wid >> 2) * 32 + (lane & 3) * 8;
    const unsigned kdst = lds0 + LDS_K + wid * 1024, vdst = lds0 + LDS_V + wid * 1024;
#define DMA_KV(t, slot) do { glds16(ksrc + (long)(t) * KVBLK * PITCH, (unsigned)__builtin_amdgcn_readfirstlane(kdst + (slot))); glds16(vsrc + (long)(t) * KVBLK * PITCH, (unsigned)__builtin_amdgcn_readfirstlane(vdst + (slot))); } while (0)
    const int vb0 = (int)(lds0 + LDS_V) + ((lane >> 4) & 1) * 32 + (lane & 3) * 8 + (4 * hi + ((lane & 15) >> 2)) * 64;
    bf16x8 qr[4];
#pragma unroll
    for (int d0 = 0; d0 < 4; ++d0) qr[d0] = *reinterpret_cast<const bf16x8*>(&Qw[(long)r32 * PITCH + d0 * 16 + hi * 8]);
    if (lane == 0) flg[wid] = 0u;
    const int ktop = 4 * qb + 3;
    DMA_KV(ktop, 0); DMA_KV(ktop - 1, SLOTB);
    f32x16 o[2]; o[0] = f32x16{}; o[1] = f32x16{}; const f32x16 zero16 = f32x16{};
    float carry = 0.f;
    const int ktd = 4 * qb + (wid >> 1);
    const int qpos = q0 + wid * 32 + r32;
    bool wdone = false;
    int sl_cur = 0, sl_n1 = SLOTB, sl_n2 = 2 * SLOTB;
    for (int kt = ktop; ; --kt) {
        if (kt > 0) { WAIT_BAR(2); } else { WAIT_BAR(0); }
        { const u32x4 f0 = *(const __attribute__((address_space(3))) u32x4*)(shm3 + LDS_FLG), f1 = *(const __attribute__((address_space(3))) u32x4*)(shm3 + LDS_FLG + 16);
          const unsigned all = f0.x & f0.y & f0.z & f0.w & f1.x & f1.y & f1.z & f1.w;
          if (__builtin_amdgcn_readfirstlane(all) != 0u) break; }
        if (kt >= 2) DMA_KV(kt - 2, sl_n2);
        if (!wdone && kt <= ktd) {
            f32x16 p0, p1;
            qkt(p0, p1, shm3 + LDS_K + sl_cur, qr, zero16, r32, hi);
            const bool diag = (kt == ktd);
            int qk = qpos - 4 * hi - 64 * kt; asm volatile("" : "+v"(qk));
            float lk[32], ls[32];
#pragma unroll
            for (int i = 0; i < 32; ++i) { const float z = (i < 16) ? p0[i] : p1[i - 16];
                const float e = __builtin_amdgcn_exp2f(-__builtin_fabsf(z)); const float l2 = __builtin_amdgcn_logf(1.0f + e);
                const float sp = __builtin_fmaxf(z, 0.f) + l2;
                float nk = -sp, lsv = z - sp;
                if (diag) { const bool valid = (8 * (i >> 2) + (i & 3)) < qk; nk = valid ? nk : 0.f; lsv = valid ? lsv : -INFINITY; }
                lk[i] = nk; ls[i] = lsv; }
            float gs[8], pg[8], S[8];
#pragma unroll
            for (int g = 0; g < 8; ++g) { gs[g] = (lk[4 * g] + lk[4 * g + 1]) + (lk[4 * g + 2] + lk[4 * g + 3]); pg[g] = swap32(gs[g], hi); }
            S[7] = 0.f;
#pragma unroll
            for (int g = 6; g >= 0; --g) S[g] = S[g + 1] + (gs[g + 1] + pg[g + 1]);
            const float tot = S[0] + (gs[0] + pg[0]);
#pragma unroll
            for (int g = 0; g < 8; ++g) { float t = carry + S[g] + (hi ? 0.f : pg[g]);
#pragma unroll
                for (int j = 3; j >= 0; --j) { const int i = 4 * g + j; const float a = __builtin_amdgcn_exp2f(ls[i] + t); t += lk[i]; if (i < 16) p0[i] = a; else p1[i - 16] = a; } }
            carry += tot;
            u32x4 pw0, pw1, pw2, pw3;
            pw0 = (u32x4){PKW(p0, 0), PKW(p0, 2), PKW(p0, 4), PKW(p0, 6)}; pw1 = (u32x4){PKW(p0, 8), PKW(p0, 10), PKW(p0, 12), PKW(p0, 14)};
            pw2 = (u32x4){PKW(p1, 0), PKW(p1, 2), PKW(p1, 4), PKW(p1, 6)}; pw3 = (u32x4){PKW(p1, 8), PKW(p1, 10), PKW(p1, 12), PKW(p1, 14)};
            SBAR();
            pv(o, vb0 + sl_cur, __builtin_bit_cast(bf16x8, pw0), __builtin_bit_cast(bf16x8, pw1), __builtin_bit_cast(bf16x8, pw2), __builtin_bit_cast(bf16x8, pw3));
            wdone = __all(carry < -36.0f);
            if (wdone && lane == 0) flg[wid] = 1u;
        }
        if (kt == 0) break;
        { const int t_ = sl_cur; sl_cur = sl_n1; sl_n1 = sl_n2; sl_n2 = t_; }
    }
    float ones[16];
#pragma unroll
    for (int r = 0; r < 16; ++r) ones[r] = 1.0f;
    store_o(o, ones, Y + (rowbase + q0 + wid * 32) * DM + h * 64, DM, shm, wid, lane, r32, hi);
    WAIT_BAR(0);
#undef DMA_KV
}

constexpr int M_K = 0, M_V = 32768, M_WS = 65536, M_OST = M_WS + NW * 64 * 4, M_KM = M_OST + NW * 4096, M_LUT = M_KM + 2048, M_BYTES = M_LUT + 512;
__device__ __forceinline__ float max3f(float a, float b, float c) { return __builtin_fmaxf(__builtin_fmaxf(a, b), c); }
__device__ __forceinline__ void moba_unit(int b, int h, int qb, const bf16* QKV, bf16* Y, const float* kpart, const float* rel_bias, char* shm) {
    const int tid = threadIdx.x, lane = tid & 63, r32 = lane & 31, hi = lane >> 5; const int wid = __builtin_amdgcn_readfirstlane(tid >> 6);
    const long rowbase = (long)b * SEQ; const int q0 = qb * 256;
    const bf16* Qw = QKV + (rowbase + q0 + wid * 32) * PITCH + 1536 + h * 64;
    const bf16* Kh = QKV + rowbase * PITCH + 2048 + h * 64; const bf16* Vh = QKV + rowbase * PITCH + 2560 + h * 64;
    const unsigned lds0 = (unsigned)(uintptr_t)shm;
    const lds_cptr shm3 = (lds_cptr)shm;
    __attribute__((address_space(3))) float* wsf = (__attribute__((address_space(3))) float*)(shm3 + M_WS) + wid * 64;
    __attribute__((address_space(3))) float* kmean = (__attribute__((address_space(3))) float*)(shm3 + M_KM);
    __attribute__((address_space(3))) float* lut = (__attribute__((address_space(3))) float*)(shm3 + M_LUT);
    const bf16* ksrc = Kh + (long)lane * PITCH + wid * 8;
    const bf16* vsrc = Vh + (long)(16 * (wid & 3) + (lane >> 2)) * PITCH + (wid >> 2) * 32 + (lane & 3) * 8;
    const unsigned kdst = lds0 + M_K + wid * 1024, vdst = lds0 + M_V + wid * 1024;
#define TILE2(S, i) ((S) < 2 ? 4 * qb + 2 * (S) + (i) : 2 * ((S) - 2) + (i))
#define DMA2(S, buf) do { _Pragma("unroll") for (int i_ = 0; i_ < 2; ++i_) { const long to_ = (long)TILE2(S, i_) * KVBLK * PITCH; \
        glds16(ksrc + to_, (unsigned)__builtin_amdgcn_readfirstlane(kdst + (buf) * 16384 + i_ * 8192)); glds16(vsrc + to_, (unsigned)__builtin_amdgcn_readfirstlane(vdst + (buf) * 16384 + i_ * 8192)); } } while (0)
    const int vb0 = (int)(lds0 + M_V) + ((lane >> 4) & 1) * 32 + (lane & 3) * 8 + (4 * hi + ((lane & 15) >> 2)) * 64;
    { const int j = tid >> 6, d = tid & 63; const float* kp = kpart + (size_t)((b * 8 + j) * 2) * 512 + h * 64 + d; kmean[j * 64 + d] = (kp[0] + kp[512]) * (1.0f / 256.0f);
      if (tid < 128) { const int n = tid; int bk; if (n < 16) bk = n; else { bk = 16 + (int)(logf((float)n * (1.0f / 16.0f)) / 2.0794415416798357f * 16.0f); bk = bk > 31 ? 31 : bk; }
          lut[n] = rel_bias[bk * NHEAD + h] * LOG2E; } }
    bf16x8 qr[4];
#pragma unroll
    for (int d0 = 0; d0 < 4; ++d0) qr[d0] = *reinterpret_cast<const bf16x8*>(&Qw[(long)r32 * PITCH + d0 * 16 + hi * 8]);
    const int NS = 2 + 2 * qb;
    DMA2(0, 0);
    float mhat = 0.f, l_reg = 0.f; f32x16 o[2]; o[0] = f32x16{}; o[1] = f32x16{};
    const int qpos = q0 + wid * 32 + r32; bool first = true; unsigned selmask = 0u; float bias31 = 0.f;
#pragma unroll 1
    for (int S = 0; S < NS; ++S) {
        WAIT_BAR(0);
        const int buf = S & 1;
        if (S + 1 < NS) DMA2(S + 1, buf ^ 1);
        if (S == 0) {
            bias31 = lut[127];
            __attribute__((address_space(3))) float* gsh = (__attribute__((address_space(3))) float*)(shm3 + M_OST) + wid * 1024;
#pragma unroll 1
            for (int j = 0; j < qb; ++j) { float a = 0.f;
#pragma unroll
                for (int d0 = 0; d0 < 4; ++d0) { const f32x4 k0 = *(const __attribute__((address_space(3))) f32x4*)(kmean + j * 64 + d0 * 16 + hi * 8), k1 = *(const __attribute__((address_space(3))) f32x4*)(kmean + j * 64 + d0 * 16 + hi * 8 + 4);
                    const bf16x8 q = qr[d0];
                    a += __uint_as_float((unsigned)(unsigned short)q[0] << 16) * k0[0] + __uint_as_float((unsigned)(unsigned short)q[1] << 16) * k0[1] + __uint_as_float((unsigned)(unsigned short)q[2] << 16) * k0[2] + __uint_as_float((unsigned)(unsigned short)q[3] << 16) * k0[3]
                       + __uint_as_float((unsigned)(unsigned short)q[4] << 16) * k1[0] + __uint_as_float((unsigned)(unsigned short)q[5] << 16) * k1[1] + __uint_as_float((unsigned)(unsigned short)q[6] << 16) * k1[2] + __uint_as_float((unsigned)(unsigned short)q[7] << 16) * k1[3]; }
                gsh[j * 64 + lane] = a + swap32(a, hi); }
            asm volatile("s_waitcnt lgkmcnt(0)" ::: "memory");
            float g[8];
#pragma unroll
            for (int j = 0; j < 8; ++j) { g[j] = -INFINITY; if (j < qb) g[j] = gsh[j * 64 + lane]; }
#pragma unroll
            for (int j = 0; j < 8; ++j) if (j < qb) { int rank = 0;
#pragma unroll
                for (int i = 0; i < 8; ++i) if (i != j && i < qb) rank += (g[i] > g[j] || (g[i] == g[j] && i < j)) ? 1 : 0;
                if (rank < 3) selmask |= 1u << j; }
        }
#pragma unroll
        for (int ti = 0; ti < 2; ++ti) {
        const int kt = TILE2(S, ti);
        const bool own = S < 2;
        const bool active = !own || (2 * S + ti <= (wid >> 1));
        if (active) {
            const int slot = buf * 16384 + ti * 8192;
            const int dmin = (q0 + wid * 32) - (64 * kt + 63);
            const bool far = dmin >= 113;
            float nb = -mhat;
            if (!own) nb = ((selmask >> (kt >> 2)) & 1u) ? nb : -INFINITY;
            if (far) nb += bias31;
            f32x16 c0;
#pragma unroll
            for (int r = 0; r < 16; ++r) c0[r] = nb;
            f32x16 p0, p1;
            qkt(p0, p1, shm3 + M_K + slot, qr, c0, r32, hi);
            if (!far) {
                int qk = qpos - 4 * hi - 64 * kt; asm volatile("" : "+v"(qk));
#pragma unroll
                for (int i = 0; i < 32; ++i) { const int dist = qk - (8 * (i >> 2) + (i & 3)); const int dc = dist < 0 ? 0 : (dist > 127 ? 127 : dist);
                    const float bb = lut[dc]; float x = (i < 16) ? p0[i] : p1[i - 16]; x = (dist < 0) ? -INFINITY : x + bb; if (i < 16) p0[i] = x; else p1[i - 16] = x;
                    if ((i & 7) == 7) asm volatile("" ::: "memory"); }
            }
            float ra = max3f(p0[0], p0[1], p1[0]), rb = max3f(p0[2], p0[3], p1[1]); ra = max3f(ra, p1[2], p1[3]);
#pragma unroll
            for (int r = 4; r < 16; r += 4) { ra = max3f(ra, p0[r], p0[r + 1]); rb = max3f(rb, p0[r + 2], p0[r + 3]); ra = max3f(ra, p1[r], p1[r + 1]); rb = max3f(rb, p1[r + 2], p1[r + 3]); }
            float rm = __builtin_fmaxf(ra, rb);
            rm = __builtin_fmaxf(rm, swap32(rm, hi));
            if (__builtin_expect(first || __any(rm > 8.0f), 0)) {
                const float dl = first ? rm : __builtin_fmaxf(rm, 0.f); mhat += dl;
#pragma unroll
                for (int r = 0; r < 16; ++r) { asm volatile("v_sub_f32 %0, %0, %1" : "+v"(p0[r]) : "v"(dl)); asm volatile("v_sub_f32 %0, %0, %1" : "+v"(p1[r]) : "v"(dl)); }
                if (!first) { const float f = __builtin_amdgcn_exp2f(-dl); l_reg *= f; if (hi == 0) wsf[r32] = f;
                    asm volatile("s_waitcnt lgkmcnt(0)" ::: "memory");
#pragma unroll
                    for (int r = 0; r < 16; ++r) { const float fr_ = wsf[crow(r, hi)]; o[0][r] *= fr_; o[1][r] *= fr_; } }
                first = false;
            }
            float sa = 0.f, sb = 0.f;
#pragma unroll
            for (int r = 0; r < 16; ++r) { p0[r] = __builtin_amdgcn_exp2f(p0[r]); p1[r] = __builtin_amdgcn_exp2f(p1[r]); sa += p0[r]; sb += p1[r]; }
            l_reg += sa + sb;
            u32x4 pw0, pw1, pw2, pw3;
            pw0 = (u32x4){PKW(p0, 0), PKW(p0, 2), PKW(p0, 4), PKW(p0, 6)}; pw1 = (u32x4){PKW(p0, 8), PKW(p0, 10), PKW(p0, 12), PKW(p0, 14)};
            pw2 = (u32x4){PKW(p1, 0), PKW(p1, 2), PKW(p1, 4), PKW(p1, 6)}; pw3 = (u32x4){PKW(p1, 8), PKW(p1, 10), PKW(p1, 12), PKW(p1, 14)};
            SBAR();
            pv(o, vb0 + slot, __builtin_bit_cast(bf16x8, pw0), __builtin_bit_cast(bf16x8, pw1), __builtin_bit_cast(bf16x8, pw2), __builtin_bit_cast(bf16x8, pw3));
        }
        }
    }
    l_reg += swap32(l_reg, hi);
    if (hi == 0) wsf[32 + r32] = l_reg; asm volatile("s_waitcnt lgkmcnt(0)" ::: "memory");
    float rli[16];
#pragma unroll
    for (int r = 0; r < 16; ++r) rli[r] = __builtin_amdgcn_rcpf(wsf[32 + crow(r, hi)]);
    store_o(o, rli, Y + (rowbase + q0 + wid * 32) * DM + 512 + h * 64, DM, shm + (M_OST - LDS_OST), wid, lane, r32, hi);
    WAIT_BAR(0);
#undef DMA2
#undef TILE2
}
#undef PKW
#undef SBAR
#undef WAIT_BAR
}

constexpr size_t MiB = 1u << 20;
constexpr size_t WS_CTL = 0, CTL_ZERO_BYTES = 1 * MiB;
constexpr size_t WS_WIN = 2 * MiB;
constexpr size_t WS_WPROJ = 12 * MiB;
constexpr size_t WS_WOUT = 14 * MiB;
constexpr size_t WS_WGU = 16 * MiB;
constexpr size_t WS_WD = 144 * MiB;
constexpr size_t WS_XN = 208 * MiB;
constexpr size_t WS_QKV = 240 * MiB;
constexpr size_t WS_GATES = 336 * MiB;
constexpr size_t WS_Y = 400 * MiB;
constexpr size_t WS_MERGED = 432 * MiB;
constexpr size_t WS_H1 = 464 * MiB;
constexpr size_t WS_HN = 528 * MiB;
constexpr size_t WS_ACT = 560 * MiB;
constexpr size_t WS_YSLOT = 704 * MiB;
constexpr size_t WS_LIST = 832 * MiB;
constexpr size_t WS_TOPW = 834 * MiB;
constexpr size_t WS_KPART = 835 * MiB;
constexpr size_t WS_END = 836 * MiB;
constexpr int CW_TMO = 0, CW_CODE = 1;
constexpr int CW_CNT = 8192;
constexpr int CW_BAR = 4096;

constexpr int RING_OFF = 0, RING_BYTES = 131072;
constexpr int LDSCTL_OFF = RING_BYTES;
constexpr int L_MISC = LDSCTL_OFF;
constexpr int L_CNT = LDSCTL_OFF + 128;
constexpr int L_TOFF = LDSCTL_OFF + 256;
constexpr int L_TILEE = LDSCTL_OFF + 512;
constexpr int L_HIST = LDSCTL_OFF + 2048;
constexpr int L_BASE = LDSCTL_OFF + 2176;
constexpr int L_TMP = LDSCTL_OFF + 2304;
constexpr int LDS_BYTES = LDSCTL_OFF + 8192;
constexpr int NWAVES = 8;

#define GAS __attribute__((address_space(1)))
#define LAS __attribute__((address_space(3)))
typedef unsigned short bf16;
typedef unsigned v4u __attribute__((ext_vector_type(4)));
typedef unsigned v2u __attribute__((ext_vector_type(2)));
typedef float f32x4 __attribute__((ext_vector_type(4)));
typedef GAS unsigned gu32;
#define RLX_AGENT __ATOMIC_RELAXED, __HIP_MEMORY_SCOPE_AGENT
#define LDS_WAIT() asm volatile("s_waitcnt lgkmcnt(0)" ::: "memory")
__device__ __forceinline__ unsigned f2bf(float f) { unsigned u = __builtin_bit_cast(unsigned, f); return (u + 0x7fffu + ((u >> 16) & 1u)) >> 16; }
__device__ __forceinline__ unsigned pk2(float lo, float hi) { return f2bf(lo) | (f2bf(hi) << 16); }

#define XB_TMO      128
#define XB_XCNT(j)  (256  + 64 * (j))
#define XB_XSUB(j)  (1280 + 64 * (j))
#define XB_XGEN(j)  (2304 + 64 * (j))
#define XB_TOP      3328
#define XB_TOPGEN   3392
#define XCD_BAR_WORDS 3456
#define XB_SPIN_CAP (1u << 18)
__device__ __forceinline__ unsigned xb_ld(unsigned* p)              { return __hip_atomic_load(p, __ATOMIC_RELAXED, __HIP_MEMORY_SCOPE_AGENT); }
__device__ __forceinline__ unsigned xb_add(unsigned* p, unsigned v) { return __hip_atomic_fetch_add(p, v, __ATOMIC_RELAXED, __HIP_MEMORY_SCOPE_AGENT); }
__device__ __forceinline__ unsigned xb_xcc_id() { return (unsigned)__builtin_amdgcn_s_getreg((3 << 11) | 20) & 0xFu; }
#define XB_SPIN(cond, bar) do { unsigned _sp = 0; while (cond) { __builtin_amdgcn_s_sleep(1); \
    if ((++_sp & 255u) == 0u) { if (xb_ld(&(bar)[XB_TMO])) break; if (_sp > XB_SPIN_CAP) { atomicAdd(&(bar)[XB_TMO], 1u); break; } } } } while (0)
struct XcdBarrier { unsigned* bar; unsigned x; volatile LAS unsigned* st; };
__device__ __forceinline__ XcdBarrier xcd_barrier_post(unsigned* bar, volatile LAS unsigned* st) {
    XcdBarrier b; b.bar = bar; b.x = xb_xcc_id(); b.st = st;
    if (threadIdx.x == 0) (void)xb_add(&bar[XB_XCNT(b.x)], 1u);
    return b;
}
__device__ __forceinline__ void xcd_barrier_complete(unsigned* bar, unsigned x, unsigned& nloc, unsigned& nx) {
    const unsigned G = gridDim.x * gridDim.y * gridDim.z;
    unsigned sum, cnt, mine, sp = 0u;
    for (;;) {
        sum = 0u; cnt = 0u; mine = 0u;
#pragma unroll
        for (unsigned j = 0; j < 16; ++j) { const unsigned c = xb_ld(&bar[XB_XCNT(j)]); sum += c; cnt += (c > 0u) ? 1u : 0u; mine = (j == x) ? c : mine; }
        if (sum == G) break;
        __builtin_amdgcn_s_sleep(1);
        if ((++sp & 255u) == 0u) { if (xb_ld(&bar[XB_TMO])) break; if (sp > XB_SPIN_CAP) { atomicAdd(&bar[XB_TMO], 1u); break; } }
    }
    nloc = mine > 0u ? mine : 1u; nx = cnt > 0u ? cnt : 1u;
}
__device__ __forceinline__ void xcd_barrier(const XcdBarrier& b) {
    asm volatile("s_waitcnt vmcnt(0)" ::: "memory");
    __syncthreads();
    if (threadIdx.x == 0) {
        unsigned* bar = b.bar;
        __builtin_amdgcn_s_waitcnt(0);
        unsigned nloc = b.st[0], nx = b.st[1];
        if (nloc == 0u) { xcd_barrier_complete(bar, b.x, nloc, nx); b.st[0] = nloc; b.st[1] = nx; }
        const unsigned old = xb_add(&bar[XB_XSUB(b.x)], 1u);
        const unsigned gen = old / nloc;
        if (old + 1u == (gen + 1u) * nloc) {
            __builtin_amdgcn_fence(__ATOMIC_RELEASE, "agent");
            asm volatile("s_waitcnt vmcnt(0)" ::: "memory");
            const unsigned og = xb_add(&bar[XB_TOP], 1u);
            const unsigned tg = og / nx;
            if (og + 1u == (tg + 1u) * nx) xb_add(&bar[XB_TOPGEN], 1u);
            else XB_SPIN(xb_ld(&bar[XB_TOPGEN]) == tg, bar);
            __builtin_amdgcn_fence(__ATOMIC_ACQUIRE, "agent");
            xb_add(&bar[XB_XGEN(b.x)], 1u);
            asm volatile("s_waitcnt vmcnt(0)" ::: "memory");
        } else {
            XB_SPIN(xb_ld(&bar[XB_XGEN(b.x)]) == gen, bar);
            __builtin_amdgcn_fence(__ATOMIC_ACQUIRE, "agent");
            asm volatile("s_waitcnt vmcnt(0)" ::: "memory");
        }
    }
    __syncthreads();
}

struct Frame {
    LAS unsigned char* lds; gu32* ctl; int tid, lane, wave, vcu, G;
    const float *x, *norm_mix_g, *w_in, *w_proj_sb, *w_proj_moba, *w_out, *rel_bias, *norm_ffn_g, *w_router, *b_router, *w_gate_up, *b_gate_up, *w_down, *b_down, *norm_final_g;
    float* out; unsigned char* ws;
};
__device__ __forceinline__ float wave_sum(float v) {
#pragma unroll
    for (int o = 1; o < 64; o <<= 1) v += __shfl_xor(v, o);
    return v;
}
template <bool FP8> struct P0Item { const float* src; unsigned char* dst; int ldw, ldtB; float scale; };
template <bool FP8>
__device__ __forceinline__ P0Item<FP8> p0_mk(const float* W, int ldw, int k0, int n0, unsigned char* WT, int ldtB, int dst_row0, int kdstB, int lane, float scale) {
    constexpr int KL = FP8 ? 16 : 8; const int lk = lane >> 3, ln = lane & 7;
    P0Item<FP8> it; it.src = W + (size_t)(k0 + KL * lk) * ldw + n0 + 4 * ln; it.dst = WT + (size_t)(dst_row0 + 4 * ln) * ldtB + kdstB + (size_t)(k0 + KL * lk) * (FP8 ? 1 : 2); it.ldw = ldw; it.ldtB = ldtB; it.scale = scale; return it;
}
template <bool FP8, int KL>
__device__ __forceinline__ void p0_load(const P0Item<FP8>& it, f32x4 (&v)[KL]) {
    const GAS f32x4* src = (const GAS f32x4*)it.src;
#pragma unroll
    for (int i = 0; i < KL; ++i) v[i] = __builtin_nontemporal_load(src + (size_t)i * (it.ldw / 4));
}
template <bool FP8, int KL>
__device__ __forceinline__ void p0_store(const P0Item<FP8>& it, const f32x4 (&v)[KL]) {
    const float scale = it.scale;
#pragma unroll
    for (int j = 0; j < 4; ++j) { v4u o;
        if constexpr (FP8) { o.x = pg8::pk4_fp8(v[0][j] * scale, v[1][j] * scale, v[2][j] * scale, v[3][j] * scale); o.y = pg8::pk4_fp8(v[4][j] * scale, v[5][j] * scale, v[6][j] * scale, v[7][j] * scale);
            o.z = pg8::pk4_fp8(v[8][j] * scale, v[9][j] * scale, v[10][j] * scale, v[11][j] * scale); o.w = pg8::pk4_fp8(v[12][j] * scale, v[13][j] * scale, v[14][j] * scale, v[15][j] * scale); }
        else { o.x = pg8::cvt_pk_bf16(v[0][j], v[1][j]); o.y = pg8::cvt_pk_bf16(v[2][j], v[3][j]); o.z = pg8::cvt_pk_bf16(v[4][j], v[5][j]); o.w = pg8::cvt_pk_bf16(v[6][j], v[7][j]); }
        *(GAS v4u*)(it.dst + (size_t)j * it.ldtB) = o; }
}
template <bool FP8>
__device__ __forceinline__ void p0_item(const float* W, int ldw, int k0, int n0, unsigned char* WT, int ldtB, int dst_row0, int kdstB, int lane, float scale) {
    constexpr int KL = FP8 ? 16 : 8;
    const P0Item<FP8> it = p0_mk<FP8>(W, ldw, k0, n0, WT, ldtB, dst_row0, kdstB, lane, scale);
    f32x4 v[KL]; p0_load<FP8, KL>(it, v); p0_store<FP8, KL>(it, v);
}
__device__ __forceinline__ void rms_row_to_bf16(const float* xrow, const f32x4 (&g)[4], bf16* orow, int lane) {
    const GAS f32x4* xr = (const GAS f32x4*)xrow + lane;
    f32x4 v[4]; float s = 0.f;
#pragma unroll
    for (int j = 0; j < 4; ++j) { v[j] = xr[64 * j]; s += (v[j].x * v[j].x + v[j].y * v[j].y) + (v[j].z * v[j].z + v[j].w * v[j].w); }
    const float rstd = 1.0f / sqrtf(wave_sum(s) * (1.0f / DM) + RMS_EPS);
    GAS unsigned long long* o8 = (GAS unsigned long long*)orow + lane;
#pragma unroll
    for (int j = 0; j < 4; ++j) { const f32x4 y = v[j] * rstd * g[j]; o8[64 * j] = (unsigned long long)pk2(y.x, y.y) | ((unsigned long long)pk2(y.z, y.w) << 32); }
}
__device__ __forceinline__ void p0_prologue(Frame& F) {
    const int gw = F.vcu * NWAVES + F.wave, NGW = F.G * NWAVES;
    unsigned char* WIN = F.ws + WS_WIN; unsigned char* WPROJ = F.ws + WS_WPROJ; unsigned char* WOUT = F.ws + WS_WOUT; unsigned char* WGU = F.ws + WS_WGU; unsigned char* WD = F.ws + WS_WD;
    constexpr int KI = MOE_FP8 ? 128 : 64;
    constexpr int GU_PER = (1024 / KI) * 64, D_PER = (1024 / KI) * 32;
    constexpr int I_IN = 16 * 160, I_PS = 8 * 32, I_PM = 8 * 32, I_OUT = 16 * 32, I_GU = 32 * GU_PER, I_D = 32 * D_PER;
    constexpr int NITEMS = I_IN + I_PS + I_PM + I_OUT + I_GU + I_D;
    {
        constexpr int KLE = MOE_FP8 ? 16 : 8; constexpr int I_E = I_GU + I_D;
        auto mk = [&](int r) -> P0Item<MOE_FP8> {
            if (r < I_GU) { const int e = r / GU_PER, q = r % GU_PER, kb = q >> 6, nb = q & 63, n0 = 32 * nb;
                const int cc = n0 & 1023, drow = (cc >> 7) * 256 + (n0 >= 1024 ? 128 : 0) + (cc & 127);
                return p0_mk<MOE_FP8>(F.w_gate_up + (size_t)e * 1024 * 2048, 2048, KI * kb, n0, WGU + (size_t)e * 2048 * 1024 * MOE_ES, 1024 * MOE_ES, drow, 0, F.lane, MOE_WSCALE); }
            r -= I_GU; const int e = r / D_PER, q = r % D_PER, kb = q >> 5, nb = q & 31;
            return p0_mk<MOE_FP8>(F.w_down + (size_t)e * 1024 * 1024, 1024, KI * kb, 32 * nb, WD + (size_t)e * 1024 * 1024 * MOE_ES, 1024 * MOE_ES, 32 * nb, 0, F.lane, MOE_WSCALE); };
        int it = gw;
#pragma unroll 1
        for (; it + NGW < I_E; it += 2 * NGW) { const P0Item<MOE_FP8> a = mk(it), b = mk(it + NGW); f32x4 va[KLE], vb[KLE];
            p0_load<MOE_FP8, KLE>(a, va); p0_load<MOE_FP8, KLE>(b, vb); p0_store<MOE_FP8, KLE>(a, va); p0_store<MOE_FP8, KLE>(b, vb); }
        if (it < I_E) { const P0Item<MOE_FP8> a = mk(it); f32x4 va[KLE]; p0_load<MOE_FP8, KLE>(a, va); p0_store<MOE_FP8, KLE>(a, va); }
    }
    for (int it = I_GU + I_D + gw; it < NITEMS; it += NGW) {
        int r = it - I_GU - I_D;
        if (r < I_IN) { const int kb = r / 160, nb = r % 160; p0_item<false>(F.w_in, DIN, 64 * kb, 32 * nb, WIN, 2048, 32 * nb, 0, F.lane, 1.f); continue; } r -= I_IN;
        if (r < I_PS) { const int kb = r >> 5, nb = r & 31; p0_item<false>(F.w_proj_sb, 1024, 64 * kb, 32 * nb, WPROJ, 2048, 32 * nb, 0, F.lane, 1.f); continue; } r -= I_PS;
        if (r < I_PM) { const int kb = r >> 5, nb = r & 31; p0_item<false>(F.w_proj_moba, 1024, 64 * kb, 32 * nb, WPROJ, 2048, 32 * nb, 1024, F.lane, 1.f); continue; } r -= I_PM;
        { const int kb = r >> 5, nb = r & 31; p0_item<false>(F.w_out, 1024, 64 * kb, 32 * nb, WOUT, 2048, 32 * nb, 0, F.lane, 1.f); }
    }
    f32x4 g[4];
#pragma unroll
    for (int j = 0; j < 4; ++j) g[j] = ((const f32x4*)F.norm_mix_g)[F.lane + 64 * j];
    bf16* XN = (bf16*)(F.ws + WS_XN);
#pragma unroll 1
    for (int m = gw; m < T_TOK; m += 4 * NGW) {
        f32x4 v[4][4];
#pragma unroll
        for (int r = 0; r < 4; ++r) { const GAS f32x4* xr = (const GAS f32x4*)(F.x + (size_t)(m + r * NGW) * DM) + F.lane;
#pragma unroll
            for (int j = 0; j < 4; ++j) v[r][j] = (m + r * NGW < T_TOK) ? __builtin_nontemporal_load(xr + 64 * j) : (f32x4){0.f, 0.f, 0.f, 0.f}; }
#pragma unroll
        for (int r = 0; r < 4; ++r) { if (m + r * NGW < T_TOK) { float s = 0.f;
#pragma unroll
            for (int j = 0; j < 4; ++j) s += (v[r][j].x * v[r][j].x + v[r][j].y * v[r][j].y) + (v[r][j].z * v[r][j].z + v[r][j].w * v[r][j].w);
            const float rstd = 1.0f / sqrtf(wave_sum(s) * (1.0f / DM) + RMS_EPS);
            GAS v2u* o8 = (GAS v2u*)(XN + (size_t)(m + r * NGW) * DM) + F.lane;
#pragma unroll
            for (int j = 0; j < 4; ++j) { const f32x4 y = v[r][j] * rstd * g[j]; v2u w; w.x = pg8::cvt_pk_bf16(y.x, y.y); w.y = pg8::cvt_pk_bf16(y.z, y.w); o8[64 * j] = w; } } }
    }
}

__device__ __forceinline__ void p5_router(Frame& F, const bool commit) {
    LAS float* wT = (LAS float*)(F.lds + RING_OFF);
    LAS int* hist = (LAS int*)(F.lds + L_HIST); LAS int* basel = (LAS int*)(F.lds + L_BASE); LAS int* tmp = (LAS int*)(F.lds + L_TMP);
    const int tid = F.tid, lane = F.lane;
    for (int kk = tid; kk < DM; kk += NWAVES * 64) {
#pragma unroll
        for (int q = 0; q < 8; ++q) { const f32x4 v = *(const f32x4*)(F.w_router + (size_t)kk * 32 + 4 * q);
            wT[(4 * q + 0) * DM + kk] = v.x; wT[(4 * q + 1) * DM + kk] = v.y; wT[(4 * q + 2) * DM + kk] = v.z; wT[(4 * q + 3) * DM + kk] = v.w; } }
    if (tid < 32) hist[tid] = 0;
    __syncthreads();
    f32x4 g[4];
#pragma unroll
    for (int j = 0; j < 4; ++j) g[j] = ((const f32x4*)F.norm_ffn_g)[lane + 64 * j];
    const float* H1 = (const float*)(F.ws + WS_H1); bf16* HN = (bf16*)(F.ws + WS_HN); float* topw = (float*)(F.ws + WS_TOPW); int* list = (int*)(F.ws + WS_LIST);
    const float brt = F.b_router[lane >> 1];
    const int hi5 = lane & 32, b4 = lane & 16, b3 = lane & 8, b2 = lane & 4, b1 = lane & 2;
#pragma unroll 1
    for (int rb = F.vcu; rb < T_TOK / 64; rb += F.G) {
#pragma unroll 1
        for (int rp = 0; rp < 4; ++rp) {
            const int rl0 = F.wave * 8 + rp * 2; const int row0 = rb * 64 + rl0;
            f32x4 hn[2][4];
#pragma unroll
            for (int r = 0; r < 2; ++r) { const GAS f32x4* xr = (const GAS f32x4*)(H1 + (size_t)(row0 + r) * DM) + lane; float s = 0.f;
#pragma unroll
                for (int j = 0; j < 4; ++j) { hn[r][j] = xr[64 * j]; s += (hn[r][j].x * hn[r][j].x + hn[r][j].y * hn[r][j].y) + (hn[r][j].z * hn[r][j].z + hn[r][j].w * hn[r][j].w); }
                const float rstd = 1.0f / sqrtf(wave_sum(s) * (1.0f / DM) + RMS_EPS);
#pragma unroll
                for (int j = 0; j < 4; ++j) { hn[r][j] = hn[r][j] * rstd * g[j];
                    if constexpr (MOE_FP8) ((GAS unsigned*)((unsigned char*)HN + (size_t)(row0 + r) * DM))[lane + 64 * j] = pg8::pk4_fp8(hn[r][j].x, hn[r][j].y, hn[r][j].z, hn[r][j].w);
                    else ((GAS unsigned long long*)(HN + (size_t)(row0 + r) * DM))[lane + 64 * j] = (unsigned long long)pk2(hn[r][j].x, hn[r][j].y) | ((unsigned long long)pk2(hn[r][j].z, hn[r][j].w) << 32); } }
            float acc[2][32];
#pragma unroll
            for (int e = 0; e < 32; ++e) { acc[0][e] = 0.f; acc[1][e] = 0.f; }
#pragma unroll
            for (int j = 0; j < 4; ++j)
#pragma unroll
                for (int eb = 0; eb < 32; eb += 8) {
#pragma unroll
                    for (int e = eb; e < eb + 8; ++e) { const f32x4 w = *(const LAS f32x4*)(wT + e * DM + 4 * (lane + 64 * j));
                        acc[0][e] += hn[0][j].x * w.x + hn[0][j].y * w.y + hn[0][j].z * w.z + hn[0][j].w * w.w;
                        acc[1][e] += hn[1][j].x * w.x + hn[1][j].y * w.y + hn[1][j].z * w.z + hn[1][j].w * w.w;
                        asm volatile("" : "+v"(acc[0][e]), "+v"(acc[1][e])); }
                    asm volatile("" ::: "memory"); }
#pragma unroll
            for (int r = 0; r < 2; ++r) {
                float b16[16], b8[8], b4v[4], b2v[2];
#pragma unroll
                for (int i = 0; i < 16; ++i) { const float send = hi5 ? acc[r][i] : acc[r][i + 16], keep = hi5 ? acc[r][i + 16] : acc[r][i]; b16[i] = keep + __shfl_xor(send, 32); }
#pragma unroll
                for (int i = 0; i < 8; ++i) { const float send = b4 ? b16[i] : b16[i + 8], keep = b4 ? b16[i + 8] : b16[i]; b8[i] = keep + __shfl_xor(send, 16); }
#pragma unroll
                for (int i = 0; i < 4; ++i) { const float send = b3 ? b8[i] : b8[i + 4], keep = b3 ? b8[i + 4] : b8[i]; b4v[i] = keep + __shfl_xor(send, 8); }
#pragma unroll
                for (int i = 0; i < 2; ++i) { const float send = b2 ? b4v[i] : b4v[i + 2], keep = b2 ? b4v[i + 2] : b4v[i]; b2v[i] = keep + __shfl_xor(send, 4); }
                float val; { const float send = b1 ? b2v[0] : b2v[1], keep = b1 ? b2v[1] : b2v[0]; val = keep + __shfl_xor(send, 2); }
                val += __shfl_xor(val, 1);
                val += brt;
                const int myidx = lane >> 1; float v = val; float selv[4]; int seli[4];
#pragma unroll
                for (int k = 0; k < 4; ++k) { float m = v;
#pragma unroll
                    for (int o = 2; o < 64; o <<= 1) m = fmaxf(m, __shfl_xor(m, o));
                    int cand = (v == m) ? myidx : 99;
#pragma unroll
                    for (int o = 2; o < 64; o <<= 1) { const int oc = __shfl_xor(cand, o); cand = oc < cand ? oc : cand; }
                    selv[k] = m; seli[k] = cand; if (myidx == cand) v = -INFINITY; }
                const float e1 = __expf(selv[1] - selv[0]), e2 = __expf(selv[2] - selv[0]), e3 = __expf(selv[3] - selv[0]); const float inv = 1.0f / (1.0f + e1 + e2 + e3);
                if (lane < 4) { const int k = lane; const int ex = k == 0 ? seli[0] : k == 1 ? seli[1] : k == 2 ? seli[2] : seli[3]; const float wk = (k == 0 ? 1.0f : k == 1 ? e1 : k == 2 ? e2 : e3) * inv;
                    const int slot = __hip_atomic_fetch_add(hist + ex, 1, __ATOMIC_RELAXED, __HIP_MEMORY_SCOPE_WORKGROUP);
                    tmp[(rl0 + r) * 4 + k] = ex | (slot << 8);
                    topw[(size_t)(row0 + r) * 4 + k] = wk; }
            }
        }
        __syncthreads();
        if (tid < 32) basel[tid] = commit ? (int)__hip_atomic_fetch_add((unsigned*)(F.ctl + CW_CNT + 64 * tid), (unsigned)hist[tid], RLX_AGENT) : 0;
        __syncthreads();
        if (tid < 256 && commit) { const int t = tmp[tid]; const int ex = t & 255, slot = t >> 8; list[(size_t)ex * LIST_CAP + basel[ex] + slot] = (rb * 64 + (tid >> 2)) * 4 + (tid & 3); }
        __syncthreads();
        if (tid < 32) hist[tid] = 0;
        __syncthreads();
    }
}
__device__ __forceinline__ int moe_tables(Frame& F) {
    LAS int* cnt = (LAS int*)(F.lds + L_CNT); LAS int* toff = (LAS int*)(F.lds + L_TOFF); LAS int* tile_e = (LAS int*)(F.lds + L_TILEE);
    __syncthreads();
    if (F.tid < 32) { const int e = F.tid; int off = 0, mine = 0;
        for (int j = 0; j < 32; ++j) { const int c = (int)__hip_atomic_load((unsigned*)(F.ctl + CW_CNT + 64 * j), RLX_AGENT); const int c2 = c > LIST_CAP ? LIST_CAP : c; const int ntl = (c2 + 255) >> 8; if (j < e) off += ntl; if (j == e) mine = c2; }
        cnt[e] = mine; toff[e] = off; const int ntl = (mine + 255) >> 8; if (e == 31) toff[32] = off + ntl;
        for (int t = 0; t < ntl; ++t) if (off + t < MAX_TILES) tile_e[off + t] = e; }
    __syncthreads();
    int NT = toff[32]; return NT > MAX_TILES ? MAX_TILES : NT;
}
__device__ __forceinline__ void p8_final(Frame& F) {
    const int gw = F.vcu * NWAVES + F.wave, NGW = F.G * NWAVES, lane = F.lane;
    f32x4 g[4];
#pragma unroll
    for (int j = 0; j < 4; ++j) g[j] = ((const f32x4*)F.norm_final_g)[lane + 64 * j];
    const float* H1 = (const float*)(F.ws + WS_H1); const bf16* YS = (const bf16*)(F.ws + WS_YSLOT);
#if PROBE_DUMP
    {
        const bf16* src = (const bf16*)(F.ws + PROBE_DUMP_OFF);
        for (int m = gw; m < T_TOK; m += NGW) { GAS f32x4* o = (GAS f32x4*)(F.out + (size_t)m * DM) + lane;
#pragma unroll
            for (int j = 0; j < 4; ++j) { const v2u w = *((const GAS v2u*)(src + (size_t)m * PROBE_DUMP_LD + PROBE_DUMP_C0) + lane + 64 * j); o[64 * j] = (f32x4){__uint_as_float(w.x << 16), __uint_as_float(w.x & 0xffff0000u), __uint_as_float(w.y << 16), __uint_as_float(w.y & 0xffff0000u)}; } }
        return;
    }
#endif
    for (int m = gw; m < T_TOK; m += NGW) {
        const GAS f32x4* xr = (const GAS f32x4*)(H1 + (size_t)m * DM) + lane; f32x4 v[4];
#pragma unroll
        for (int j = 0; j < 4; ++j) v[j] = xr[64 * j];
#pragma unroll
        for (int k = 0; k < PROBE_NSLOT; ++k) { const GAS v2u* yr = (const GAS v2u*)(YS + (size_t)(m * 4 + k) * DM) + lane;
#pragma unroll
            for (int j = 0; j < 4; ++j) { const v2u w = yr[64 * j]; v[j].x += __uint_as_float(w.x << 16); v[j].y += __uint_as_float(w.x & 0xffff0000u); v[j].z += __uint_as_float(w.y << 16); v[j].w += __uint_as_float(w.y & 0xffff0000u); } }
        float s = 0.f;
#pragma unroll
        for (int j = 0; j < 4; ++j) s += (v[j].x * v[j].x + v[j].y * v[j].y) + (v[j].z * v[j].z + v[j].w * v[j].w);
        const float rstd = 1.0f / sqrtf(wave_sum(s) * (1.0f / DM) + RMS_EPS);
        GAS f32x4* o = (GAS f32x4*)(F.out + (size_t)m * DM) + lane;
#pragma unroll
        for (int j = 0; j < 4; ++j) o[64 * j] = v[j] * rstd * g[j];
    }
}

constexpr int N_PHASES = 9;
struct Args { const float* in[15]; float* out; unsigned char* ws; int ph_lo, ph_hi; };
__global__ void __launch_bounds__(NWAVES * 64, 2) fwd_kernel(Args args) {
    extern __shared__ __attribute__((aligned(16))) unsigned char lds[];
    Frame F;
    F.lds = (LAS unsigned char*)lds;
    F.tid = threadIdx.x; F.lane = F.tid & 63; F.wave = __builtin_amdgcn_readfirstlane(F.tid >> 6);
    F.G = gridDim.x; { const int bx = blockIdx.x; F.vcu = (F.G % 8 == 0) ? (bx % 8) * (F.G / 8) + bx / 8 : bx; }
    F.ws = args.ws; F.ctl = (gu32*)(args.ws + WS_CTL); F.out = args.out;
    F.x = args.in[0]; F.norm_mix_g = args.in[1]; F.w_in = args.in[2]; F.w_proj_sb = args.in[3]; F.w_proj_moba = args.in[4]; F.w_out = args.in[5]; F.rel_bias = args.in[6]; F.norm_ffn_g = args.in[7];
    F.w_router = args.in[8]; F.b_router = args.in[9]; F.w_gate_up = args.in[10]; F.b_gate_up = args.in[11]; F.w_down = args.in[12]; F.b_down = args.in[13]; F.norm_final_g = args.in[14];
    for (int u = F.tid; u < (LDS_BYTES - LDSCTL_OFF) / 4; u += NWAVES * 64) ((LAS unsigned*)(F.lds + LDSCTL_OFF))[u] = 0u;
    __syncthreads();
    XcdBarrier bar; bar.bar = (unsigned*)(F.ctl + CW_BAR); bar.x = 0; bar.st = nullptr;
    if (MK_N_LAUNCHES == 1) bar = xcd_barrier_post((unsigned*)(F.ctl + CW_BAR), (volatile LAS unsigned*)(F.lds + L_MISC) + 8);
#define GRID_BAR() do { if (MK_N_LAUNCHES == 1) xcd_barrier(bar); } while (0)
    const int lo = args.ph_lo, hi = args.ph_hi;
#ifndef PH_MASK
#define PH_MASK 0x1ff
#endif
#define IN(k) ((((PH_MASK) >> (k)) & 1) && lo <= (k) && (k) < hi)
#define BOTH(k) (IN(k) && IN((k) + 1))
    unsigned char* ws = args.ws;

    if (IN(0)) { _Pragma("unroll") for (int rep = 0; rep < 1 + ((PROBE_REP >> 0) & 1); ++rep) { p0_prologue(F); if (BOTH(0)) GRID_BAR(); } }

    if (IN(1)) { _Pragma("unroll") for (int rep = 0; rep < 1 + ((PROBE_REP >> 1) & 1); ++rep) {
        pg8::DenseOrder S{T_TOK / 256, DIN / 256, F.G, (int)blockIdx.x, (const char*)(ws + WS_XN), (const char*)(ws + WS_WIN), (size_t)256 * DM * 2, (size_t)256 * DM * 2};
        pg8::EpiInProj E{(bf16*)(ws + WS_QKV), (bf16*)(ws + WS_GATES), (float*)(ws + WS_KPART)};
        pg8::gemm_phase<pg8::EpiInProj, pg8::DenseOrder, true, false>(F.lds + RING_OFF, S, E, DM * 2, DM * 2, DM * 2);
        if (BOTH(1)) GRID_BAR();
    } }

    if (IN(2)) { _Pragma("unroll") for (int rep = 0; rep < 1 + ((PROBE_REP >> 2) & 1); ++rep) {
        const att::bf16* QKV = (const att::bf16*)(ws + WS_QKV); att::bf16* Y = (att::bf16*)(ws + WS_Y);
        for (int v = F.vcu; v < 256; v += F.G) {
            const int bh = v >> 2, s = v & 3, b = bh >> 3, h = bh & 7;
            _Pragma("unroll") for (int r2 = 0; r2 < 1 + ((PROBE_REP >> 9) & 1); ++r2) {
            att::moba_unit(b, h, 7 - s, QKV, Y, (const float*)(ws + WS_KPART), F.rel_bias, (char*)lds + RING_OFF);
            att::moba_unit(b, h, s, QKV, Y, (const float*)(ws + WS_KPART), F.rel_bias, (char*)lds + RING_OFF); }
            _Pragma("unroll") for (int r2 = 0; r2 < 1 + ((PROBE_REP >> 10) & 1); ++r2) {
            att::sb_unit(b, h, 7 - s, QKV, Y, (char*)lds + RING_OFF);
            att::sb_unit(b, h, s, QKV, Y, (char*)lds + RING_OFF); }
        }
        if (BOTH(2)) GRID_BAR();
    } }

    if (IN(3)) { _Pragma("unroll") for (int rep = 0; rep < 1 + ((PROBE_REP >> 3) & 1); ++rep) {
        pg8::ProjOrder S{F.G, (int)blockIdx.x, (const char*)(ws + WS_Y), (const char*)(ws + WS_WPROJ)};
        pg8::EpiProjGate E{(const bf16*)(ws + WS_GATES), (bf16*)(ws + WS_MERGED)};
        pg8::gemm_phase<pg8::EpiProjGate, pg8::ProjOrder, true, false>(F.lds + RING_OFF, S, E, 512 * 2, DM * 2, DM * 2);
        if (BOTH(3)) GRID_BAR();
    } }

    if (IN(4)) { _Pragma("unroll") for (int rep = 0; rep < 1 + ((PROBE_REP >> 4) & 1); ++rep) {
        pg8::DenseOrder S{T_TOK / 256, DM / 256, F.G, (int)blockIdx.x, (const char*)(ws + WS_MERGED), (const char*)(ws + WS_WOUT), (size_t)256 * DM * 2, (size_t)256 * DM * 2};
        pg8::EpiResF32 E{F.x, (float*)(ws + WS_H1)};
        pg8::gemm_phase<pg8::EpiResF32, pg8::DenseOrder, true, false>(F.lds + RING_OFF, S, E, DM * 2, DM * 2, DM * 2);
        if (BOTH(4)) GRID_BAR();
    } }

    if (IN(5)) { if ((PROBE_REP >> 5) & 1) { p5_router(F, false); __syncthreads(); } p5_router(F, true); if (BOTH(5)) GRID_BAR(); }

    if (IN(6)) { _Pragma("unroll") for (int rep = 0; rep < 1 + ((PROBE_REP >> 6) & 1); ++rep) {
        const int NT = moe_tables(F);
        pg8::MoeOrder S{NT, 8, F.G, (int)blockIdx.x, (const LAS int*)(F.lds + L_TILEE), (const LAS int*)(F.lds + L_TOFF), (const LAS int*)(F.lds + L_CNT),
                        (const char*)(ws + WS_HN), (const char*)(ws + WS_WGU), (size_t)256 * DM * MOE_ES, (size_t)256 * DM * MOE_ES, (size_t)2048 * DM * MOE_ES, (const int*)(ws + WS_LIST), DM * MOE_ES, true};
        pg8::EpiSwiglu E{F.b_gate_up, (unsigned char*)(ws + WS_ACT)};
        pg8::gemm_phase<pg8::EpiSwiglu, pg8::MoeOrder, true, true, MOE_FP8>(F.lds + RING_OFF, S, E, DM * MOE_ES, DM * MOE_ES, DM * MOE_ES);
        if (BOTH(6)) GRID_BAR();
    } }

    if (IN(7)) { _Pragma("unroll") for (int rep = 0; rep < 1 + ((PROBE_REP >> 7) & 1); ++rep) {
        const int NT = moe_tables(F);
        pg8::MoeOrder S{NT, 4, F.G, (int)blockIdx.x, (const LAS int*)(F.lds + L_TILEE), (const LAS int*)(F.lds + L_TOFF), (const LAS int*)(F.lds + L_CNT),
                        (const char*)(ws + WS_ACT), (const char*)(ws + WS_WD), (size_t)256 * DM * MOE_ES, (size_t)256 * DM * MOE_ES, (size_t)1024 * DM * MOE_ES, (const int*)(ws + WS_LIST), DM * MOE_ES, false};
        pg8::EpiDown E{F.b_down, (const int*)(ws + WS_LIST), (const LAS int*)(F.lds + L_CNT), (const float*)(ws + WS_TOPW), (bf16*)(ws + WS_YSLOT)};
        pg8::gemm_phase<pg8::EpiDown, pg8::MoeOrder, true, false, MOE_FP8>(F.lds + RING_OFF, S, E, DM * MOE_ES, DM * MOE_ES, DM * MOE_ES);
        if (BOTH(7)) GRID_BAR();
    } }

    if (IN(8)) { for (int rep = 0; rep < 1 + ((PROBE_REP >> 8) & 1); ++rep) p8_final(F); }
#undef IN
#undef BOTH
#undef GRID_BAR
}

extern "C" void kernel_launch(void* const* d_in, const int* in_sizes, int n_in, void* d_out, int out_size, void* d_ws, size_t ws_size, hipStream_t stream) {
    static int grid = 0;
    if (grid == 0) {
        if (n_in != 15 || in_sizes[0] != T_TOK * DM || out_size != T_TOK * DM || ws_size < WS_END) { fprintf(stderr, "kernel_launch: unexpected shapes (n_in %d, in0 %d, out %d, ws %zu); nothing launched\n", n_in, n_in > 0 ? in_sizes[0] : -1, out_size, ws_size); grid = -1; return; }
        int dev = 0, cus = 0, per_cu = 0;
        if (hipGetDevice(&dev) != hipSuccess || hipDeviceGetAttribute(&cus, hipDeviceAttributeMultiprocessorCount, dev) != hipSuccess) { grid = -1; return; }
        if (hipFuncSetAttribute((const void*)fwd_kernel, hipFuncAttributeMaxDynamicSharedMemorySize, LDS_BYTES) != hipSuccess) { fprintf(stderr, "kernel_launch: hipFuncSetAttribute failed\n"); grid = -1; return; }
        if (hipOccupancyMaxActiveBlocksPerMultiprocessor(&per_cu, (const void*)fwd_kernel, NWAVES * 64, LDS_BYTES) != hipSuccess || per_cu < 1) { fprintf(stderr, "kernel_launch: occupancy query reports %d workgroups per CU\n", per_cu); }
        (void)hipGetLastError();
        grid = cus;
    }
    if (grid < 0) return;
    if (hipMemsetAsync((char*)d_ws + WS_CTL, 0, CTL_ZERO_BYTES, stream) != hipSuccess) return;
    Args a{};
    for (int i = 0; i < 15; ++i) a.in[i] = (const float*)d_in[i];
    a.out = (float*)d_out; a.ws = (unsigned char*)d_ws;
    if (MK_N_LAUNCHES == 1) { a.ph_lo = 0; a.ph_hi = N_PHASES; hipLaunchKernelGGL(fwd_kernel, dim3(grid), dim3(NWAVES * 64), LDS_BYTES, stream, a); }
    else { for (int p = 0; p < N_PHASES; ++p) { a.ph_lo = p; a.ph_hi = p + 1; hipLaunchKernelGGL(fwd_kernel, dim3(grid), dim3(NWAVES * 64), LDS_BYTES, stream, a); } }
}
```

```cpp
#include <hip/hip_runtime.h>
#include <cstdio>
#include <cstdint>
#include <cmath>

#ifndef PROBE_REP
#define PROBE_REP 0
#endif
#ifndef EXPERTS_LATE
#define EXPERTS_LATE 1
#endif
#ifndef CONV_INTERLEAVE
#define CONV_INTERLEAVE 1
#endif
#ifndef MOE_KROT
#define MOE_KROT 2
#endif
#ifndef MK_N_LAUNCHES
#define MK_N_LAUNCHES 1
#endif

constexpr int T_TOK = 16384, DM = 1024, DIN = 5120, NEXP = 32, TOPK = 4, SEQ = 2048, NBATCH = 8, NHEAD = 8;
constexpr int QKV_LD = 3072, GATE_LD = 2048;
#ifndef MOE_FP8_SW
#define MOE_FP8_SW 1
#endif
constexpr bool MOE_FP8 = MOE_FP8_SW != 0;
constexpr int MOE_ES = MOE_FP8 ? 1 : 2;
constexpr float MOE_WSCALE = MOE_FP8 ? 64.0f : 1.0f, MOE_WINV = MOE_FP8 ? (1.0f / 64.0f) : 1.0f;
constexpr float C2F = 0.125f * 1.4426950408889634f;
constexpr float LOG2E = 1.4426950408889634f;
constexpr float RMS_EPS = 1e-6f;
constexpr int LIST_CAP = 16384;
constexpr int MAX_TILES = 288;

namespace pg8 {
#define PG8_LAS __attribute__((address_space(3)))
typedef unsigned short bf16_t;
typedef short bf16x8 __attribute__((ext_vector_type(8)));
typedef float f32x4 __attribute__((ext_vector_type(4)));
typedef float f32x2 __attribute__((ext_vector_type(2)));
typedef unsigned u32x4 __attribute__((ext_vector_type(4)));
typedef unsigned u32x2 __attribute__((ext_vector_type(2)));
constexpr int BM = 256, BK = 64, HALF = 128, HTB = HALF * BK * 2, STAGE_BYTES = 8 * HTB, NXCD = 8, WGM = 8;

__host__ __device__ __forceinline__ int lds_byte(int r, int c) { const int st = (r >> 4) * 2 + (c >> 5), rr = r & 15, cc = c & 31, ob = rr * 64 + cc * 2; return st * 1024 + (ob ^ (((ob >> 9) & 1) << 5)); }
__host__ __device__ __forceinline__ void stage_rc(int b, int& R, int& C) { const int st = b / 1024, sb = b % 1024, swz = sb ^ (((sb >> 9) & 1) << 5); R = (st >> 1) * 16 + swz / 64; C = (st & 1) * 32 + (swz % 64) / 2; }
__host__ __device__ __forceinline__ int perm32(int rho) { const int n = rho >> 4, i = rho & 15; return 8 * (i >> 2) + 4 * n + (i & 3); }

typedef int i32x8 __attribute__((ext_vector_type(8)));
typedef int i32x4 __attribute__((ext_vector_type(4)));
__device__ __forceinline__ i32x8 pk32(bf16x8 lo, bf16x8 hi) { const i32x4 a = __builtin_bit_cast(i32x4, lo), b = __builtin_bit_cast(i32x4, hi); return (i32x8){a[0], a[1], a[2], a[3], b[0], b[1], b[2], b[3]}; }
struct Unit { int pm, pn, e, aux, rot; };

__device__ __forceinline__ bool static_tile(int i, int G, int c, int nM, int nN, int& pm, int& pn) {
    const int nwg = nM * nN; const long L = (long)i * G + c; if (L >= nwg) return false;
    int wgid = (int)L; { const int q = nwg / NXCD, r = nwg % NXCD, xcd = wgid % NXCD, off = wgid / NXCD; wgid = (xcd < r ? xcd * (q + 1) : r * (q + 1) + (xcd - r) * q) + off; }
    const int nig = WGM * nN, gid = wgid / nig, fm = gid * WGM, gsz = (nM - fm) < WGM ? (nM - fm) : WGM;
    pm = fm + ((wgid % nig) % gsz); pn = (wgid % nig) / gsz; return true;
}

typedef __bf16 bf16x2_t __attribute__((ext_vector_type(2)));
__device__ __forceinline__ unsigned cvt_pk_bf16(float lo, float hi) { f32x2 v = {lo, hi}; bf16x2_t b = __builtin_convertvector(v, bf16x2_t); return __builtin_bit_cast(unsigned, b); }
__device__ __forceinline__ unsigned pk4_fp8(float a, float b, float c, float d) { int p = __builtin_amdgcn_cvt_pk_fp8_f32(a, b, 0, false); p = __builtin_amdgcn_cvt_pk_fp8_f32(c, d, p, true); return (unsigned)p; }
__device__ __forceinline__ float bf_lo(unsigned w) { return __uint_as_float(w << 16); }
__device__ __forceinline__ float bf_hi(unsigned w) { return __uint_as_float(w & 0xffff0000u); }

struct NoHook { __device__ __forceinline__ void operator()(int) const {} };
template <class Epi, class Sched, bool ALIGN_EPI, bool GATHER, bool FP8 = false, class Hook = NoHook>
__device__ __forceinline__ void gemm_phase(PG8_LAS unsigned char* lds, const Sched& S, const Epi& E, const int KB, const int ldaB, const int ldbB, const Hook& H = Hook()) {
    const int tid = threadIdx.x, wid = __builtin_amdgcn_readfirstlane(tid >> 6), lane = tid & 63, wr = wid >> 2, wc = wid & 3, fr = lane & 15, fq = lane >> 4;
    const int nt = KB / (BK * 2);
    unsigned voA[2][2], voN[2][2], voffB[2]; int RA[2], CA[2];
#pragma unroll
    for (int i = 0; i < 2; ++i) { int R, C; stage_rc(tid * 16 + i * 8192, R, C); const int Rb = Epi::PERM ? ((R & ~31) + perm32(R & 31)) : R;
        RA[i] = R; CA[i] = C; voffB[i] = (unsigned)(Rb * ldbB + C * 2);
#pragma unroll
        for (int h = 0; h < 2; ++h) voA[h][i] = (unsigned)((h * HALF + R) * ldaB + C * 2); }
    const size_t kstep = (size_t)(BK * 2);
    const size_t hstepB = (size_t)HALF * ldbB;
    const unsigned ldsw = (unsigned)wid * 1024u;
    const int aoff = lds_byte(wr * 64 + fr, fq * 8), boff = lds_byte(wc * 32 + fr, fq * 8);
#define PG8_SA(b, h) (((b) * 2 + (h)) * HTB)
#define PG8_SB(b, h) ((4 + (b) * 2 + (h)) * HTB)
#define PG8_STAGE(bufoff, gbase, voff) do { _Pragma("unroll") for (int _i = 0; _i < 2; ++_i) \
        __builtin_amdgcn_global_load_lds((const unsigned*)((const char*)(gbase) + (voff)[_i]), (PG8_LAS unsigned*)(lds + (bufoff) + ldsw + _i * 8192), 16, 0, 0); } while (0)
#define PG8_LD8(dst, off) do { const i32x4 _lo = *(const PG8_LAS i32x4*)(lds + (off)); const i32x4 _hi = *(const PG8_LAS i32x4*)(lds + (off) + 1024); dst = __builtin_shufflevector(_lo, _hi, 0, 1, 2, 3, 4, 5, 6, 7); } while (0)
#define PG8_LDA(dst, b, h) do { _Pragma("unroll") for (int m = 0; m < 4; ++m) PG8_LD8(dst[m], PG8_SA(b, h) + aoff + m * 2048); } while (0)
#define PG8_LDB(dst, b, h) do { _Pragma("unroll") for (int n = 0; n < 2; ++n) PG8_LD8(dst[n], PG8_SB(b, h) + boff + n * 2048); } while (0)
#define PG8_LO(x) __builtin_bit_cast(bf16x8, __builtin_shufflevector(x, x, 0, 1, 2, 3))
#define PG8_HI(x) __builtin_bit_cast(bf16x8, __builtin_shufflevector(x, x, 4, 5, 6, 7))
#define PG8_MMA(ai, bj, At, Bt) do { __builtin_amdgcn_s_setprio(1); _Pragma("unroll") for (int m = 0; m < 4; ++m) _Pragma("unroll") for (int n = 0; n < 2; ++n) { \
        if constexpr (FP8) { asm volatile("v_mfma_f32_16x16x128_f8f6f4 %0, %1, %2, %0" : "+v"(acc[ai][bj][m][n]) : "v"(Bt[n]), "v"(At[m])); } \
        else { acc[ai][bj][m][n] = __builtin_amdgcn_mfma_f32_16x16x32_bf16(PG8_LO(Bt[n]), PG8_LO(At[m]), acc[ai][bj][m][n], 0, 0, 0); \
               acc[ai][bj][m][n] = __builtin_amdgcn_mfma_f32_16x16x32_bf16(PG8_HI(Bt[n]), PG8_HI(At[m]), acc[ai][bj][m][n], 0, 0, 0); } } __builtin_amdgcn_s_setprio(0); } while (0)
#define PG8_WAIT_V(n) asm volatile("s_waitcnt vmcnt(" #n ")" ::: "memory")
#define PG8_WAIT_L(n) asm volatile("s_waitcnt lgkmcnt(" #n ")" ::: "memory")
#define PG8_BAR __builtin_amdgcn_s_barrier()
#define PG8_SCHED __builtin_amdgcn_sched_barrier(0)
    Unit cur, nxt; int ui = 0;
    H(0);
    if (!S.next(0, cur)) return;
    if constexpr (GATHER) S.a_rows(cur, RA, CA, voA);
#pragma unroll
    for (int h = 0; h < 2; ++h)
#pragma unroll
        for (int i = 0; i < 2; ++i) voN[h][i] = voA[h][i];
    f32x4 acc[2][2][4][2];
#pragma unroll
    for (int a = 0; a < 2; ++a)
#pragma unroll
        for (int b = 0; b < 2; ++b)
#pragma unroll
            for (int m = 0; m < 4; ++m)
#pragma unroll
                for (int n = 0; n < 2; ++n) acc[a][b][m][n] = (f32x4){0.f, 0.f, 0.f, 0.f};
    i32x8 At[4], B0[2], B1[2];
    const char* cA = S.a_base(cur); const char* cB = S.b_base(cur);
    const int ntm = nt - 1;
    { const size_t o0 = (size_t)(cur.rot & ntm) * kstep;
    PG8_STAGE(PG8_SB(0, 0), cB + o0, voffB); PG8_STAGE(PG8_SB(0, 1), cB + hstepB + o0, voffB); PG8_STAGE(PG8_SA(0, 0), cA + o0, voA[0]); PG8_STAGE(PG8_SA(0, 1), cA + o0, voA[1]); }
    if (wr == 1) PG8_BAR;
    PG8_WAIT_V(2); PG8_BAR;
    { const size_t o1 = (size_t)((cur.rot + 1) & ntm) * kstep;
    PG8_STAGE(PG8_SB(1, 0), cB + o1, voffB); PG8_STAGE(PG8_SA(1, 0), cA + o1, voA[0]); PG8_STAGE(PG8_SB(1, 1), cB + hstepB + o1, voffB); }
    PG8_WAIT_V(6); PG8_BAR;
    for (;;) {
        const bool has_next = S.next(ui + 1, nxt);
        const char* nA = has_next ? S.a_base(nxt) : cA; const char* nB = has_next ? S.b_base(nxt) : cB;
        if constexpr (GATHER) { if (has_next) S.a_rows(nxt, RA, CA, voN); }
#pragma unroll 1
        for (int t = 0; t < nt; t += 2) {
            const bool last = (t == nt - 2);
            const int nrot = has_next ? nxt.rot : cur.rot;
            const char* a1 = cA + (size_t)((t + 1 + cur.rot) & ntm) * kstep;
            const size_t o2 = last ? (size_t)(nrot & ntm) * kstep : (size_t)((t + 2 + cur.rot) & ntm) * kstep;
            const char* a2 = (last ? nA : cA) + o2; const char* b2 = (last ? nB : cB) + o2;
            const char* a3 = a2 + kstep; const char* b3 = b2 + kstep;
            unsigned v2[2][2];
#pragma unroll
            for (int h = 0; h < 2; ++h)
#pragma unroll
                for (int i = 0; i < 2; ++i) v2[h][i] = voA[h][i];
            if constexpr (GATHER) { if (last) { asm volatile("" : "+v"(voN[0][0]), "+v"(voN[0][1]), "+v"(voN[1][0]), "+v"(voN[1][1]));
#pragma unroll
                for (int h = 0; h < 2; ++h)
#pragma unroll
                    for (int i = 0; i < 2; ++i) v2[h][i] = voN[h][i]; } }
            PG8_LDB(B0, 0, 0); PG8_LDB(B1, 0, 1); PG8_SCHED; PG8_LDA(At, 0, 0); PG8_STAGE(PG8_SA(1, 1), a1, voA[1]);
            PG8_WAIT_V(8); PG8_WAIT_L(0); PG8_BAR; PG8_MMA(0, 0, At, B0); PG8_MMA(0, 1, At, B1); PG8_BAR; PG8_SCHED;
            PG8_LDA(At, 0, 1); PG8_STAGE(PG8_SB(0, 0), b2, voffB); PG8_STAGE(PG8_SB(0, 1), b2 + hstepB, voffB); PG8_STAGE(PG8_SA(0, 0), a2, v2[0]);
            PG8_WAIT_V(8); PG8_WAIT_L(0); PG8_BAR; PG8_MMA(1, 0, At, B0); PG8_MMA(1, 1, At, B1); PG8_BAR; PG8_SCHED;
            PG8_LDB(B0, 1, 0); PG8_LDB(B1, 1, 1); PG8_SCHED; PG8_LDA(At, 1, 0); PG8_STAGE(PG8_SA(0, 1), a2, v2[1]);
            PG8_WAIT_V(8); PG8_WAIT_L(0); PG8_BAR; PG8_MMA(0, 0, At, B0); PG8_MMA(0, 1, At, B1); PG8_BAR; PG8_SCHED;
            PG8_LDA(At, 1, 1); PG8_STAGE(PG8_SB(1, 0), b3, voffB); PG8_STAGE(PG8_SB(1, 1), b3 + hstepB, voffB); PG8_STAGE(PG8_SA(1, 0), a3, v2[0]);
            PG8_WAIT_V(8); PG8_WAIT_L(0); PG8_BAR; PG8_MMA(1, 0, At, B0); PG8_MMA(1, 1, At, B1); PG8_BAR; PG8_SCHED;
        }
        if constexpr (ALIGN_EPI) { if (wr == 0) PG8_BAR; }
        if constexpr (FP8) {
            asm volatile("s_nop 15\n\ts_nop 15" : "+v"(acc[0][0][0][0]), "+v"(acc[0][0][0][1]), "+v"(acc[0][0][1][0]), "+v"(acc[0][0][1][1]), "+v"(acc[0][0][2][0]), "+v"(acc[0][0][2][1]), "+v"(acc[0][0][3][0]), "+v"(acc[0][0][3][1]),
                         "+v"(acc[0][1][0][0]), "+v"(acc[0][1][0][1]), "+v"(acc[0][1][1][0]), "+v"(acc[0][1][1][1]), "+v"(acc[0][1][2][0]), "+v"(acc[0][1][2][1]), "+v"(acc[0][1][3][0]), "+v"(acc[0][1][3][1]));
            asm volatile("" : "+v"(acc[1][0][0][0]), "+v"(acc[1][0][0][1]), "+v"(acc[1][0][1][0]), "+v"(acc[1][0][1][1]), "+v"(acc[1][0][2][0]), "+v"(acc[1][0][2][1]), "+v"(acc[1][0][3][0]), "+v"(acc[1][0][3][1]),
                         "+v"(acc[1][1][0][0]), "+v"(acc[1][1][0][1]), "+v"(acc[1][1][1][0]), "+v"(acc[1][1][1][1]), "+v"(acc[1][1][2][0]), "+v"(acc[1][1][2][1]), "+v"(acc[1][1][3][0]), "+v"(acc[1][1][3][1])); }
        E(acc, cur, wr, wc, fr, fq);
        asm volatile("" ::: "memory"); PG8_SCHED;
        H(ui + 1);
        asm volatile("" ::: "memory"); PG8_SCHED;
        if (!has_next) break;
#pragma unroll
        for (int a = 0; a < 2; ++a)
#pragma unroll
            for (int b = 0; b < 2; ++b)
#pragma unroll
                for (int m = 0; m < 4; ++m)
#pragma unroll
                    for (int n = 0; n < 2; ++n) acc[a][b][m][n] = (f32x4){0.f, 0.f, 0.f, 0.f};
        cur = nxt; cA = nA; cB = nB; ++ui;
#pragma unroll
        for (int h = 0; h < 2; ++h)
#pragma unroll
            for (int i = 0; i < 2; ++i) voA[h][i] = voN[h][i];
        if constexpr (ALIGN_EPI) { if (wr == 1) PG8_BAR; }
    }
    PG8_WAIT_V(0);
    if constexpr (!ALIGN_EPI) { if (wr == 0) PG8_BAR; }
    PG8_BAR;
#undef PG8_SA
#undef PG8_SB
#undef PG8_STAGE
#undef PG8_LDA
#undef PG8_LDB
#undef PG8_LD8
#undef PG8_LO
#undef PG8_HI
#undef PG8_MMA
#undef PG8_WAIT_V
#undef PG8_WAIT_L
#undef PG8_BAR
#undef PG8_SCHED
}

__device__ __forceinline__ float sigmoidf_fast(float x) { return __builtin_amdgcn_rcpf(1.0f + __builtin_amdgcn_exp2f(-LOG2E * x)); }

struct EpiInProj {
    static constexpr bool PERM = true;
    bf16_t* qkv; bf16_t* gates; float* kpart;
    __device__ __forceinline__ void operator()(const f32x4 (&acc)[2][2][4][2], const Unit& u, int wr, int wc, int fr, int fq) const {
        const int row0 = u.pm * BM + wr * 64 + fr; const int pn = u.pn;
        const int cw = wc * 32 + 8 * fq;
        if (pn < 12) {
            const float sc = (pn < 2 || pn == 6 || pn == 7) ? C2F : 1.0f;
            bf16_t* base = qkv + pn * BM + cw;
#pragma unroll
            for (int ai = 0; ai < 2; ++ai)
#pragma unroll
                for (int m = 0; m < 4; ++m) { bf16_t* rowp = base + (size_t)(row0 + ai * HALF + m * 16) * QKV_LD;
#pragma unroll
                    for (int bj = 0; bj < 2; ++bj) { const f32x4 v0 = acc[ai][bj][m][0] * sc, v1 = acc[ai][bj][m][1] * sc;
                        u32x4 w; w.x = cvt_pk_bf16(v0[0], v0[1]); w.y = cvt_pk_bf16(v0[2], v0[3]); w.z = cvt_pk_bf16(v1[0], v1[1]); w.w = cvt_pk_bf16(v1[2], v1[3]);
                        *(u32x4*)(rowp + bj * HALF) = w; } }
            if (pn == 8 || pn == 9) {
#pragma unroll
                for (int bj = 0; bj < 2; ++bj)
#pragma unroll
                    for (int n = 0; n < 2; ++n) { f32x4 s = (f32x4){0.f, 0.f, 0.f, 0.f};
#pragma unroll
                        for (int ai = 0; ai < 2; ++ai)
#pragma unroll
                            for (int m = 0; m < 4; ++m) s += acc[ai][bj][m][n];
#pragma unroll
                        for (int o = 1; o < 16; o <<= 1) { s[0] += __shfl_xor(s[0], o); s[1] += __shfl_xor(s[1], o); s[2] += __shfl_xor(s[2], o); s[3] += __shfl_xor(s[3], o); }
                        if (fr == 0) *(f32x4*)(kpart + (size_t)(u.pm * 2 + wr) * 512 + (pn - 8) * BM + bj * HALF + cw + 4 * n) = s; }
            }
        } else {
            bf16_t* base = gates + (pn - 12) * BM + cw;
#pragma unroll
            for (int ai = 0; ai < 2; ++ai)
#pragma unroll
                for (int m = 0; m < 4; ++m) { bf16_t* rowp = base + (size_t)(row0 + ai * HALF + m * 16) * GATE_LD;
#pragma unroll
                    for (int bj = 0; bj < 2; ++bj) { const f32x4 a0 = acc[ai][bj][m][0], a1 = acc[ai][bj][m][1];
                        u32x4 w; w.x = cvt_pk_bf16(sigmoidf_fast(a0[0]), sigmoidf_fast(a0[1])); w.y = cvt_pk_bf16(sigmoidf_fast(a0[2]), sigmoidf_fast(a0[3]));
                        w.z = cvt_pk_bf16(sigmoidf_fast(a1[0]), sigmoidf_fast(a1[1])); w.w = cvt_pk_bf16(sigmoidf_fast(a1[2]), sigmoidf_fast(a1[3]));
                        *(u32x4*)(rowp + bj * HALF) = w; } }
        }
    }
};

struct EpiProjGate {
    static constexpr bool PERM = true;
    const bf16_t* gates; bf16_t* merged;
    __device__ __forceinline__ void operator()(const f32x4 (&acc)[2][2][4][2], const Unit& u, int wr, int wc, int fr, int fq) const {
        const int row0 = u.pm * BM + wr * 64 + fr; const int col0 = u.pn * BM + wc * 32 + 8 * fq; const int br = u.e;
#pragma unroll
        for (int ai = 0; ai < 2; ++ai)
#pragma unroll
            for (int m = 0; m < 4; ++m) { const size_t row = (size_t)(row0 + ai * HALF + m * 16);
#pragma unroll
                for (int bj = 0; bj < 2; ++bj) {
                    const u32x4 g = *(const u32x4*)(gates + row * GATE_LD + br * DM + col0 + bj * HALF);
                    f32x4 v0 = acc[ai][bj][m][0], v1 = acc[ai][bj][m][1];
                    v0[0] *= bf_lo(g.x); v0[1] *= bf_hi(g.x); v0[2] *= bf_lo(g.y); v0[3] *= bf_hi(g.y);
                    v1[0] *= bf_lo(g.z); v1[1] *= bf_hi(g.z); v1[2] *= bf_lo(g.w); v1[3] *= bf_hi(g.w);
                    bf16_t* op = merged + row * DM + col0 + bj * HALF;
                    if (br == 1) { const u32x4 p = *(const u32x4*)op;
                        v0[0] += bf_lo(p.x); v0[1] += bf_hi(p.x); v0[2] += bf_lo(p.y); v0[3] += bf_hi(p.y);
                        v1[0] += bf_lo(p.z); v1[1] += bf_hi(p.z); v1[2] += bf_lo(p.w); v1[3] += bf_hi(p.w); }
                    u32x4 w; w.x = cvt_pk_bf16(v0[0], v0[1]); w.y = cvt_pk_bf16(v0[2], v0[3]); w.z = cvt_pk_bf16(v1[0], v1[1]); w.w = cvt_pk_bf16(v1[2], v1[3]);
                    *(u32x4*)op = w; } }
    }
};

struct EpiResF32 {
    static constexpr bool PERM = false;
    const float* x; bf16_t* h1;
    __device__ __forceinline__ void operator()(const f32x4 (&acc)[2][2][4][2], const Unit& u, int wr, int wc, int fr, int fq) const {
        const int row0 = u.pm * BM + wr * 64 + fr; const int col0 = u.pn * BM + wc * 32 + 4 * fq;
#pragma unroll
        for (int ai = 0; ai < 2; ++ai)
#pragma unroll
            for (int m = 0; m < 4; ++m) { const size_t off = (size_t)(row0 + ai * HALF + m * 16) * DM + col0;
#pragma unroll
                for (int bj = 0; bj < 2; ++bj)
#pragma unroll
                    for (int n = 0; n < 2; ++n) { const f32x4 b = *(const f32x4*)(x + off + bj * HALF + n * 16); const f32x4 r = b + acc[ai][bj][m][n];
                        u32x2 w; w.x = cvt_pk_bf16(r[0], r[1]); w.y = cvt_pk_bf16(r[2], r[3]); *(u32x2*)(h1 + off + bj * HALF + n * 16) = w; } }
    }
};

struct EpiSwiglu {
    static constexpr bool PERM = true;
    const float* bgu; unsigned char* act;
    __device__ __forceinline__ void operator()(const f32x4 (&acc)[2][2][4][2], const Unit& u, int wr, int wc, int fr, int fq) const {
        const int row0 = u.pm * BM + wr * 64 + fr; const int f0 = u.pn * HALF + wc * 32 + 8 * fq;
        const float* bp = bgu + (size_t)u.e * 2048 + f0;
        const f32x4 bg0 = *(const f32x4*)(bp), bg1 = *(const f32x4*)(bp + 4), bu0 = *(const f32x4*)(bp + 1024), bu1 = *(const f32x4*)(bp + 1028);
#pragma unroll
        for (int ai = 0; ai < 2; ++ai)
#pragma unroll
            for (int m = 0; m < 4; ++m) { float y[8];
#pragma unroll
                for (int n = 0; n < 2; ++n)
#pragma unroll
                    for (int j = 0; j < 4; ++j) { const float g = fminf(acc[ai][0][m][n][j] * MOE_WINV + (n ? bg1[j] : bg0[j]), 7.0f);
                        const float up = fminf(fmaxf(acc[ai][1][m][n][j] * MOE_WINV + (n ? bu1[j] : bu0[j]), -7.0f), 7.0f);
                        y[n * 4 + j] = (up + 1.0f) * (g * __builtin_amdgcn_rcpf(1.0f + __builtin_amdgcn_exp2f(-1.702f * LOG2E * g))); }
                unsigned char* op = act + ((size_t)(row0 + ai * HALF + m * 16) * DM + f0) * MOE_ES;
                if constexpr (MOE_FP8) { u32x2 w; w.x = pk4_fp8(y[0], y[1], y[2], y[3]); w.y = pk4_fp8(y[4], y[5], y[6], y[7]); *(u32x2*)op = w; }
                else { u32x4 w; w.x = cvt_pk_bf16(y[0], y[1]); w.y = cvt_pk_bf16(y[2], y[3]); w.z = cvt_pk_bf16(y[4], y[5]); w.w = cvt_pk_bf16(y[6], y[7]); *(u32x4*)op = w; } }
    }
};

struct EpiDown {
    static constexpr bool PERM = true;
    bf16_t* ys;
    __device__ __forceinline__ void operator()(const f32x4 (&acc)[2][2][4][2], const Unit& u, int wr, int wc, int fr, int fq) const {
        const int row0 = u.pm * BM + wr * 64 + fr; const int col0 = u.pn * BM + wc * 32 + 8 * fq;
#pragma unroll
        for (int ai = 0; ai < 2; ++ai)
#pragma unroll
            for (int m = 0; m < 4; ++m) { bf16_t* rowp = ys + (size_t)(row0 + ai * HALF + m * 16) * DM + col0;
#pragma unroll
                for (int bj = 0; bj < 2; ++bj) { const f32x4 v0 = acc[ai][bj][m][0] * MOE_WINV, v1 = acc[ai][bj][m][1] * MOE_WINV;
                    u32x4 o; o.x = cvt_pk_bf16(v0[0], v0[1]); o.y = cvt_pk_bf16(v0[2], v0[3]); o.z = cvt_pk_bf16(v1[0], v1[1]); o.w = cvt_pk_bf16(v1[2], v1[3]);
                    *(u32x4*)(rowp + bj * HALF) = o; } }
    }
};

struct DenseOrder {
    int nM, nN, G, c; const char* A; const char* Bt; size_t astep, bstep;
    __device__ __forceinline__ bool next(int i, Unit& u) const { u.e = 0; u.aux = 0; u.rot = 0; return static_tile(i, G, c, nM, nN, u.pm, u.pn); }
    __device__ __forceinline__ const char* a_base(const Unit& u) const { return A + (size_t)u.pm * astep; }
    __device__ __forceinline__ const char* b_base(const Unit& u) const { return Bt + (size_t)u.pn * bstep; }
    __device__ __forceinline__ void a_rows(const Unit&, const int (&)[2], const int (&)[2], unsigned (&)[2][2]) const {}
};
struct ProjOrder {
    int G, c; const char* Y; const char* Wp;
    __device__ __forceinline__ bool next(int i, Unit& u) const { u.e = i & 1; u.aux = 0; u.rot = 0; return static_tile(i >> 1, G, c, T_TOK / BM, DM / BM, u.pm, u.pn); }
    __device__ __forceinline__ const char* a_base(const Unit& u) const { return Y + ((size_t)u.pm * BM * DM + u.e * 512) * 2; }
    __device__ __forceinline__ const char* b_base(const Unit& u) const { return Wp + ((size_t)u.pn * BM * DM + u.e * 512) * 2; }
    __device__ __forceinline__ void a_rows(const Unit&, const int (&)[2], const int (&)[2], unsigned (&)[2][2]) const {}
};
struct MoeOrder {
    int NT, nN, G, c; const PG8_LAS int* tile_e; const PG8_LAS int* tileoff; const PG8_LAS int* cnt;
    const char* A; const char* Bt; size_t astep, bstep, bexp; const int* list; int lda; bool gather;
    int rep;
    __device__ __forceinline__ bool next(int i, Unit& u) const { const int per = (NT * nN + G - 1) / G; if (i >= per * rep) return false; if (!static_tile(i % per, G, c, NT, nN, u.pm, u.pn)) return false; u.e = tile_e[u.pm]; u.aux = u.pm - tileoff[u.e]; u.rot = MOE_KROT * ((u.pm + u.pn) & 1); return true; }
    __device__ __forceinline__ const char* a_base(const Unit& u) const { return gather ? A : A + (size_t)u.pm * astep; }
    __device__ __forceinline__ const char* b_base(const Unit& u) const { return Bt + (size_t)u.e * bexp + (size_t)u.pn * bstep; }
    __device__ __forceinline__ void a_rows(const Unit& u, const int (&RA)[2], const int (&CA)[2], unsigned (&vo)[2][2]) const {
        const int n = cnt[u.e] - u.aux * BM; const int* lp = list + (size_t)u.e * LIST_CAP + u.aux * BM;
#pragma unroll
        for (int h = 0; h < 2; ++h)
#pragma unroll
            for (int i = 0; i < 2; ++i) { const int r = h * HALF + RA[i]; const int id = (r < n) ? lp[r] : 0; vo[h][i] = (unsigned)((id >> 2) * lda + CA[i] * 2); }
    }
};
}

namespace att {
typedef unsigned short bf16;
using bf16x8 = __attribute__((ext_vector_type(8))) short;
using s16x4 = __attribute__((ext_vector_type(4))) short;
using f32x16 = __attribute__((ext_vector_type(16))) float;
using u32x4 = __attribute__((ext_vector_type(4))) unsigned;
using f32x4 = __attribute__((ext_vector_type(4))) float;
constexpr int NW = 8, KVBLK = 64, NSLOT = 3, SLOTB = 8192, PITCH = QKV_LD;
constexpr int LDS_K = 0, LDS_V = NSLOT * SLOTB, LDS_WS = 2 * NSLOT * SLOTB, LDS_OST = LDS_WS + NW * 64 * 4, LDS_KM = LDS_OST + NW * 4096, LDS_LUT = LDS_KM + 2048, LDS_FLG = LDS_LUT + 512, LDS_BYTES = LDS_FLG + 64;
__device__ __forceinline__ int crow(int r, int hi) { return (r & 3) + 8 * (r >> 2) + 4 * hi; }
#define SBAR() __builtin_amdgcn_sched_barrier(0)
__device__ __forceinline__ void glds16(const void* gsrc, unsigned lds_dst) { unsigned keep;
    asm volatile("s_mov_b32 %0, m0\n\ts_mov_b32 m0, %2\n\ts_nop 0\n\tglobal_load_lds_dwordx4 %1, off\n\ts_mov_b32 m0, %0" : "=&s"(keep) : "v"(gsrc), "s"(lds_dst) : "memory"); }
typedef float f32x2_t __attribute__((ext_vector_type(2))); typedef __bf16 bf16x2_t __attribute__((ext_vector_type(2)));
__device__ __forceinline__ unsigned cvtpk_s(float lo, float hi) { f32x2_t v = {lo, hi}; bf16x2_t b = __builtin_convertvector(v, bf16x2_t); return __builtin_bit_cast(unsigned, b); }
#define WAIT_BAR(N) asm volatile("s_waitcnt vmcnt(" #N ") lgkmcnt(0)\n\ts_barrier" ::: "memory")
typedef __attribute__((address_space(3))) const char* lds_cptr;

__device__ __forceinline__ void qkt(f32x16& p0, f32x16& p1, lds_cptr Kslot, const bf16x8* qr, const f32x16& c0, int r32, int hi) {
    lds_cptr kb = Kslot + hi * 1024 + r32 * 16;
#pragma unroll
    for (int d0 = 0; d0 < 4; ++d0) {
        const bf16x8 b0 = *(const __attribute__((address_space(3))) bf16x8*)(kb + d0 * 2048);
        const bf16x8 b1 = *(const __attribute__((address_space(3))) bf16x8*)(kb + d0 * 2048 + 512);
        if (d0 == 0) { p0 = __builtin_amdgcn_mfma_f32_32x32x16_bf16(b0, qr[0], c0, 0, 0, 0); p1 = __builtin_amdgcn_mfma_f32_32x32x16_bf16(b1, qr[0], c0, 0, 0, 0); }
        else { p0 = __builtin_amdgcn_mfma_f32_32x32x16_bf16(b0, qr[d0], p0, 0, 0, 0); p1 = __builtin_amdgcn_mfma_f32_32x32x16_bf16(b1, qr[d0], p1, 0, 0, 0); } }
}
__device__ __forceinline__ void pv(f32x16* o, int vb, bf16x8 pa0, bf16x8 pa1, bf16x8 pa2, bf16x8 pa3) {
#pragma unroll
    for (int d0 = 0; d0 < 2; ++d0) { s16x4 lo[4], hi[4];
#pragma unroll
        for (int ks = 0; ks < 4; ++ks) {
            asm volatile("ds_read_b64_tr_b16 %0,%1 offset:%c2" : "=&v"(lo[ks]) : "v"(vb), "i"(d0 * 4096 + ks * 1024) : "memory");
            asm volatile("ds_read_b64_tr_b16 %0,%1 offset:%c2" : "=&v"(hi[ks]) : "v"(vb), "i"(d0 * 4096 + ks * 1024 + 512) : "memory"); }
        asm volatile("s_waitcnt lgkmcnt(0)" ::: "memory"); SBAR();
#define PK(k) (bf16x8){lo[k][0], lo[k][1], lo[k][2], lo[k][3], hi[k][0], hi[k][1], hi[k][2], hi[k][3]}
        o[d0] = __builtin_amdgcn_mfma_f32_32x32x16_bf16(pa0, PK(0), o[d0], 0, 0, 0);
        o[d0] = __builtin_amdgcn_mfma_f32_32x32x16_bf16(pa1, PK(1), o[d0], 0, 0, 0);
        o[d0] = __builtin_amdgcn_mfma_f32_32x32x16_bf16(pa2, PK(2), o[d0], 0, 0, 0);
        o[d0] = __builtin_amdgcn_mfma_f32_32x32x16_bf16(pa3, PK(3), o[d0], 0, 0, 0);
#undef PK
    }
}
__device__ __forceinline__ float swap32(float v, int hi) {
    auto rr = __builtin_amdgcn_permlane32_swap(__float_as_uint(v), __float_as_uint(v), false, false);
    return __uint_as_float(hi ? rr[0] : rr[1]);
}
__device__ __forceinline__ void store_o(const f32x16* o, const float* rs, bf16* Ow, int ldo, char* shm, int wid, int lane, int r32, int hi) {
    bf16* stg = (bf16*)(shm + LDS_OST) + wid * 2048;
#pragma unroll
    for (int r = 0; r < 16; ++r) { const int orow = crow(r, hi);
#pragma unroll
        for (int d0 = 0; d0 < 2; ++d0) { const float v = o[d0][r] * rs[r]; const unsigned u = __float_as_uint(v); stg[orow * 64 + d0 * 32 + r32] = (bf16)((u + 0x7fffu + ((u >> 16) & 1u)) >> 16); } }
    asm volatile("s_waitcnt lgkmcnt(0)" ::: "memory");
#pragma unroll
    for (int i = 0; i < 4; ++i) { const int row = i * 8 + (lane >> 3), ch = lane & 7; const u32x4 v = *(const u32x4*)(stg + row * 64 + ch * 8); *(u32x4*)(Ow + (long)row * ldo + ch * 8) = v; }
}
#define PKW(P, B) cvtpk_s(P[B], P[B + 1])

__device__ __forceinline__ void sb_unit(int b, int h, int qb, const bf16* QKV, bf16* Y, char* shm) {
    int tid = threadIdx.x; asm volatile("" : "+v"(tid));
    const int lane = tid & 63, r32 = lane & 31, hi = lane >> 5; const int wid = __builtin_amdgcn_readfirstlane(tid >> 6);
    const long rowbase = (long)b * SEQ; const int q0 = qb * 256;
    const bf16* Qw = QKV + (rowbase + q0 + wid * 32) * PITCH + h * 64;
    const bf16* Kh = QKV + rowbase * PITCH + 512 + h * 64; const bf16* Vh = QKV + rowbase * PITCH + 1024 + h * 64;
    const unsigned lds0 = (unsigned)(uintptr_t)shm;
    const lds_cptr shm3 = (lds_cptr)shm;
    volatile __attribute__((address_space(3))) unsigned* flg = (volatile __attribute__((address_space(3))) unsigned*)(shm3 + LDS_FLG);
    const bf16* ksrc = Kh + (long)lane * PITCH + wid * 8;
    const bf16* vsrc = Vh + (long)(16 * (wid & 3) + (lane >> 2)) * PITCH + (wid >> 2) * 32 + (lane & 3) * 8;
    const unsigned kdst = lds0 + LDS_K + wid * 1024, vdst = lds0 + LDS_V + wid * 1024;
#define DMA_KV(t, slot) do { glds16(ksrc + (long)(t) * KVBLK * PITCH, (unsigned)__builtin_amdgcn_readfirstlane(kdst + (slot))); glds16(vsrc + (long)(t) * KVBLK * PITCH, (unsigned)__builtin_amdgcn_readfirstlane(vdst + (slot))); } while (0)
    const int vb0 = (int)(lds0 + LDS_V) + ((lane >> 4) & 1) * 32 + (lane & 3) * 8 + (4 * hi + ((lane & 15) >> 2)) * 64;
    bf16x8 qr[4];
#pragma unroll
    for (int d0 = 0; d0 < 4; ++d0) qr[d0] = *reinterpret_cast<const bf16x8*>(&Qw[(long)r32 * PITCH + d0 * 16 + hi * 8]);
    if (lane == 0) flg[wid] = 0u;
    const int ktop = 4 * qb + 3;
    DMA_KV(ktop, 0); DMA_KV(ktop - 1, SLOTB);
    f32x16 o[2]; o[0] = f32x16{}; o[1] = f32x16{}; const f32x16 zero16 = f32x16{};
    float carry = 0.f;
    const int ktd = 4 * qb + (wid >> 1);
    const int qpos = q0 + wid * 32 + r32;
    bool wdone = false;
    int sl_cur = 0, sl_n1 = SLOTB, sl_n2 = 2 * SLOTB;
    for (int kt = ktop; ; --kt) {
        if (kt > 0) { WAIT_BAR(2); } else { WAIT_BAR(0); }
        { const u32x4 f0 = *(const __attribute__((address_space(3))) u32x4*)(shm3 + LDS_FLG), f1 = *(const __attribute__((address_space(3))) u32x4*)(shm3 + LDS_FLG + 16);
          const unsigned all = f0.x & f0.y & f0.z & f0.w & f1.x & f1.y & f1.z & f1.w;
          if (__builtin_amdgcn_readfirstlane(all) != 0u) break; }
        if (kt >= 2) DMA_KV(kt - 2, sl_n2);
        if (!wdone && kt <= ktd) {
            f32x16 p0, p1;
            qkt(p0, p1, shm3 + LDS_K + sl_cur, qr, zero16, r32, hi);
            const bool diag = (kt == ktd);
            int qk = qpos - 4 * hi - 64 * kt; asm volatile("" : "+v"(qk));
            float lk[32], ls[32];
#pragma unroll
            for (int i = 0; i < 32; ++i) { const float z = (i < 16) ? p0[i] : p1[i - 16];
                const float e = __builtin_amdgcn_exp2f(-__builtin_fabsf(z)); const float l2 = __builtin_amdgcn_logf(1.0f + e);
                const float sp = __builtin_fmaxf(z, 0.f) + l2;
                float nk = -sp, lsv = z - sp;
                if (diag) { const bool valid = (8 * (i >> 2) + (i & 3)) < qk; nk = valid ? nk : 0.f; lsv = valid ? lsv : -INFINITY; }
                lk[i] = nk; ls[i] = lsv; }
            float gs[8], pg[8], S[8];
#pragma unroll
            for (int g = 0; g < 8; ++g) { gs[g] = (lk[4 * g] + lk[4 * g + 1]) + (lk[4 * g + 2] + lk[4 * g + 3]); pg[g] = swap32(gs[g], hi); }
            S[7] = 0.f;
#pragma unroll
            for (int g = 6; g >= 0; --g) S[g] = S[g + 1] + (gs[g + 1] + pg[g + 1]);
            const float tot = S[0] + (gs[0] + pg[0]);
#pragma unroll
            for (int g = 0; g < 8; ++g) { float t = carry + S[g] + (hi ? 0.f : pg[g]);
#pragma unroll
                for (int j = 3; j >= 0; --j) { const int i = 4 * g + j; const float a = __builtin_amdgcn_exp2f(ls[i] + t); t += lk[i]; if (i < 16) p0[i] = a; else p1[i - 16] = a; } }
            carry += tot;
            u32x4 pw0, pw1, pw2, pw3;
            pw0 = (u32x4){PKW(p0, 0), PKW(p0, 2), PKW(p0, 4), PKW(p0, 6)}; pw1 = (u32x4){PKW(p0, 8), PKW(p0, 10), PKW(p0, 12), PKW(p0, 14)};
            pw2 = (u32x4){PKW(p1, 0), PKW(p1, 2), PKW(p1, 4), PKW(p1, 6)}; pw3 = (u32x4){PKW(p1, 8), PKW(p1, 10), PKW(p1, 12), PKW(p1, 14)};
            SBAR();
            pv(o, vb0 + sl_cur, __builtin_bit_cast(bf16x8, pw0), __builtin_bit_cast(bf16x8, pw1), __builtin_bit_cast(bf16x8, pw2), __builtin_bit_cast(bf16x8, pw3));
            wdone = __all(carry < -36.0f);
            if (wdone && lane == 0) flg[wid] = 1u;
        }
        if (kt == 0) break;
        { const int t_ = sl_cur; sl_cur = sl_n1; sl_n1 = sl_n2; sl_n2 = t_; }
    }
    float ones[16];
#pragma unroll
    for (int r = 0; r < 16; ++r) ones[r] = 1.0f;
    store_o(o, ones, Y + (rowbase + q0 + wid * 32) * DM + h * 64, DM, shm, wid, lane, r32, hi);
    WAIT_BAR(0);
#undef DMA_KV
}

constexpr int M_BUF = 32768, M_OST = 3 * M_BUF, M_WS = M_OST + NW * 4096, M_KM = M_WS + NW * 64 * 4, M_LUT = M_KM + 2048, M_BYTES = M_LUT + 528;
static_assert(M_BYTES <= 147456, "MoBA LDS map (SCRATCH_BYTES)");
__device__ __forceinline__ float max3f(float a, float b, float c) { return __builtin_fmaxf(__builtin_fmaxf(a, b), c); }
typedef short v4i16_t __attribute__((ext_vector_type(4)));
__device__ __forceinline__ s16x4 vtr(lds_cptr p) { return __builtin_bit_cast(s16x4, __builtin_amdgcn_ds_read_tr16_b64_v4i16((__attribute__((address_space(3))) v4i16_t*)p)); }
__device__ __forceinline__ void moba_unit(int b, int h, int qb, const bf16* QKV, bf16* Y, const float* kpart, const float* rel_bias, char* shm) {
    int tid = threadIdx.x; asm volatile("" : "+v"(tid));
    const int lane = tid & 63, r32 = lane & 31, hi = lane >> 5; const int wid = __builtin_amdgcn_readfirstlane(tid >> 6);
    const long rowbase = (long)b * SEQ; const int q0 = qb * 256;
    const bf16* Qw = QKV + (rowbase + q0 + wid * 32) * PITCH + 1536 + h * 64;
    const bf16* Kh = QKV + rowbase * PITCH + 2048 + h * 64; const bf16* Vh = QKV + rowbase * PITCH + 2560 + h * 64;
    const unsigned lds0 = (unsigned)(uintptr_t)shm;
    const lds_cptr shm3 = (lds_cptr)shm;
    __attribute__((address_space(3))) float* wsf = (__attribute__((address_space(3))) float*)(shm3 + M_WS) + wid * 64;
    __attribute__((address_space(3))) float* kmean = (__attribute__((address_space(3))) float*)(shm3 + M_KM);
    __attribute__((address_space(3))) float* lut = (__attribute__((address_space(3))) float*)(shm3 + M_LUT);
    const bf16* ksrc = Kh + (long)lane * PITCH + wid * 8;
    const bf16* vsrc = Vh + (long)(16 * (wid & 3) + (lane >> 2)) * PITCH + (wid >> 2) * 32 + (lane & 3) * 8;
    const unsigned kdst = lds0 + wid * 1024, vdst = lds0 + 16384 + wid * 1024;
#define TILE2(S, i) ((S) < 2 ? 4 * qb + 2 * (S) + (i) : 2 * ((S) - 2) + (i))
#define DMA2(S, bufo) do { _Pragma("unroll") for (int i_ = 0; i_ < 2; ++i_) { const long to_ = (long)TILE2(S, i_) * KVBLK * PITCH; \
        glds16(ksrc + to_, (unsigned)__builtin_amdgcn_readfirstlane(kdst + (bufo) + i_ * 8192)); glds16(vsrc + to_, (unsigned)__builtin_amdgcn_readfirstlane(vdst + (bufo) + i_ * 8192)); } } while (0)
    { const int j = tid >> 6, d = tid & 63; const float* kp = kpart + (size_t)((b * 8 + j) * 2) * 512 + h * 64 + d; kmean[j * 64 + d] = (kp[0] + kp[512]) * (1.0f / 256.0f);
      if (tid < 128) { const int n = tid; int bk; if (n < 16) bk = n; else { bk = 16 + (int)(logf((float)n * (1.0f / 16.0f)) / 2.0794415416798357f * 16.0f); bk = bk > 31 ? 31 : bk; }
          const float b31_ = rel_bias[31 * NHEAD + h]; lut[n] = (rel_bias[bk * NHEAD + h] - b31_) * LOG2E; if (n == 0) lut[128] = b31_ * LOG2E; } }
    bf16x8 qr[4];
#pragma unroll
    for (int d0 = 0; d0 < 4; ++d0) qr[d0] = *reinterpret_cast<const bf16x8*>(&Qw[(long)r32 * PITCH + d0 * 16 + hi * 8]);
    const int NS = 2 + 2 * qb;
    DMA2(0, 0);
    float mhat = 0.f, l_reg = 0.f; f32x16 o[2]; o[0] = f32x16{}; o[1] = f32x16{};
    const int qpos = q0 + wid * 32 + r32; unsigned selmask = 0u; float bias31 = 0.f;
    f32x16 nbv = f32x16{};
    f32x16 pA0 = f32x16{}, pA1 = f32x16{};
    const lds_cptr kp0 = shm3 + hi * 1024 + r32 * 16;
    const lds_cptr vp0 = shm3 + 16384 + ((lane >> 4) & 1) * 32 + (lane & 3) * 8 + (4 * hi + ((lane & 15) >> 2)) * 64;
    int bo_cur = 0, bo_nxt = M_BUF, bo_prv = 2 * M_BUF;
    int vprev = 0;
#define MOBA_TILE(kt, ko, own, HASPREV, FIRST) do { \
        s16x4 vlo[8], vhi[8]; bf16x8 kf[8]; \
        _Pragma("unroll") for (int j_ = 0; j_ < 4; ++j_) { kf[2 * j_] = *(const __attribute__((address_space(3))) bf16x8*)(kp0 + (ko) + j_ * 2048); kf[2 * j_ + 1] = *(const __attribute__((address_space(3))) bf16x8*)(kp0 + (ko) + j_ * 2048 + 512); } \
        const int dmin_ = (q0 + wid * 32) - (64 * (kt) + 63); const bool far_ = dmin_ >= 113; \
        f32x16 C0 = __builtin_amdgcn_mfma_f32_32x32x16_bf16(kf[0], qr[0], nbv, 0, 0, 0), C1 = __builtin_amdgcn_mfma_f32_32x32x16_bf16(kf[1], qr[0], nbv, 0, 0, 0); \
        C0 = __builtin_amdgcn_mfma_f32_32x32x16_bf16(kf[2], qr[1], C0, 0, 0, 0); C1 = __builtin_amdgcn_mfma_f32_32x32x16_bf16(kf[3], qr[1], C1, 0, 0, 0); \
        C0 = __builtin_amdgcn_mfma_f32_32x32x16_bf16(kf[4], qr[2], C0, 0, 0, 0); C1 = __builtin_amdgcn_mfma_f32_32x32x16_bf16(kf[5], qr[2], C1, 0, 0, 0); \
        C0 = __builtin_amdgcn_mfma_f32_32x32x16_bf16(kf[6], qr[3], C0, 0, 0, 0); C1 = __builtin_amdgcn_mfma_f32_32x32x16_bf16(kf[7], qr[3], C1, 0, 0, 0); \
        if (HASPREV) { _Pragma("unroll") for (int i_ = 0; i_ < 8; ++i_) { vlo[i_] = vtr(vp0 + vprev + ((i_ >> 2) * 4096 + (i_ & 3) * 1024)); vhi[i_] = vtr(vp0 + vprev + ((i_ >> 2) * 4096 + (i_ & 3) * 1024 + 512)); } } \
        u32x4 pw0, pw1, pw2, pw3; \
        if (HASPREV) { float sa_ = 0.f, sb_ = 0.f; _Pragma("unroll") for (int r_ = 0; r_ < 16; ++r_) { sa_ += pA0[r_]; sb_ += pA1[r_]; } l_reg += sa_ + sb_; \
            pw0 = (u32x4){PKW(pA0, 0), PKW(pA0, 2), PKW(pA0, 4), PKW(pA0, 6)}; pw1 = (u32x4){PKW(pA0, 8), PKW(pA0, 10), PKW(pA0, 12), PKW(pA0, 14)}; \
            pw2 = (u32x4){PKW(pA1, 0), PKW(pA1, 2), PKW(pA1, 4), PKW(pA1, 6)}; pw3 = (u32x4){PKW(pA1, 8), PKW(pA1, 10), PKW(pA1, 12), PKW(pA1, 14)}; \
            asm volatile("" : "+v"(pw0), "+v"(pw1), "+v"(pw2), "+v"(pw3), "+v"(l_reg));     \
            __builtin_amdgcn_sched_group_barrier(0x100, 8, 0); __builtin_amdgcn_sched_group_barrier(0x002, 32, 0); \
            _Pragma("unroll") for (int g_ = 0; g_ < 8; ++g_) { __builtin_amdgcn_sched_group_barrier(0x008, 1, 0); __builtin_amdgcn_sched_group_barrier(0x002, 6, 0); __builtin_amdgcn_sched_group_barrier(0x100, 2, 0); } } \
        if (!far_) { int qk_ = qpos - 4 * hi - 64 * (kt); asm volatile("" : "+v"(qk_)); \
            _Pragma("unroll") for (int i_ = 0; i_ < 32; ++i_) { const int dist_ = qk_ - (8 * (i_ >> 2) + (i_ & 3)); const int dc_ = dist_ < 0 ? 0 : (dist_ > 127 ? 127 : dist_); \
                const float bb_ = lut[dc_]; float x_ = (i_ < 16) ? C0[i_ & 15] : C1[i_ & 15]; x_ = (dist_ < 0) ? -INFINITY : x_ + bb_; if (i_ < 16) C0[i_ & 15] = x_; else C1[i_ & 15] = x_; \
                if ((i_ & 7) == 7) asm volatile("" ::: "memory"); } } \
        float ra_ = max3f(C0[0], C0[1], C1[0]), rb_ = max3f(C0[2], C0[3], C1[1]); ra_ = max3f(ra_, C1[2], C1[3]); \
        _Pragma("unroll") for (int r_ = 4; r_ < 16; r_ += 4) { ra_ = max3f(ra_, C0[r_], C0[r_ + 1]); rb_ = max3f(rb_, C0[r_ + 2], C0[r_ + 3]); ra_ = max3f(ra_, C1[r_], C1[r_ + 1]); rb_ = max3f(rb_, C1[r_ + 2], C1[r_ + 3]); } \
        float rm_ = __builtin_fmaxf(ra_, rb_); rm_ = __builtin_fmaxf(rm_, swap32(rm_, hi)); \
        bool resc_ = false; \
        if (__builtin_expect((FIRST) || __any(rm_ > 8.0f), 0)) { const float dl_ = (FIRST) ? rm_ : __builtin_fmaxf(rm_, 0.f); mhat += dl_; \
            _Pragma("unroll") for (int r_ = 0; r_ < 16; ++r_) { asm volatile("v_sub_f32 %0, %0, %1" : "+v"(C0[r_]) : "v"(dl_)); asm volatile("v_sub_f32 %0, %0, %1" : "+v"(C1[r_]) : "v"(dl_)); } \
            _Pragma("unroll") for (int r_ = 0; r_ < 16; ++r_) nbv[r_] -= dl_;     \
            if (!(FIRST)) { const float f_ = __builtin_amdgcn_exp2f(-dl_); l_reg *= f_; if (hi == 0) wsf[r32] = f_; resc_ = true; } } \
        if (HASPREV) { asm volatile("" : "+v"(pw0), "+v"(pw1), "+v"(pw2), "+v"(pw3));     \
            o[0] = __builtin_amdgcn_mfma_f32_32x32x16_bf16(__builtin_bit_cast(bf16x8, pw0), (bf16x8){vlo[0][0], vlo[0][1], vlo[0][2], vlo[0][3], vhi[0][0], vhi[0][1], vhi[0][2], vhi[0][3]}, o[0], 0, 0, 0); \
            o[1] = __builtin_amdgcn_mfma_f32_32x32x16_bf16(__builtin_bit_cast(bf16x8, pw0), (bf16x8){vlo[4][0], vlo[4][1], vlo[4][2], vlo[4][3], vhi[4][0], vhi[4][1], vhi[4][2], vhi[4][3]}, o[1], 0, 0, 0); \
            o[0] = __builtin_amdgcn_mfma_f32_32x32x16_bf16(__builtin_bit_cast(bf16x8, pw1), (bf16x8){vlo[1][0], vlo[1][1], vlo[1][2], vlo[1][3], vhi[1][0], vhi[1][1], vhi[1][2], vhi[1][3]}, o[0], 0, 0, 0); \
            o[1] = __builtin_amdgcn_mfma_f32_32x32x16_bf16(__builtin_bit_cast(bf16x8, pw1), (bf16x8){vlo[5][0], vlo[5][1], vlo[5][2], vlo[5][3], vhi[5][0], vhi[5][1], vhi[5][2], vhi[5][3]}, o[1], 0, 0, 0); \
            o[0] = __builtin_amdgcn_mfma_f32_32x32x16_bf16(__builtin_bit_cast(bf16x8, pw2), (bf16x8){vlo[2][0], vlo[2][1], vlo[2][2], vlo[2][3], vhi[2][0], vhi[2][1], vhi[2][2], vhi[2][3]}, o[0], 0, 0, 0); \
            o[1] = __builtin_amdgcn_mfma_f32_32x32x16_bf16(__builtin_bit_cast(bf16x8, pw2), (bf16x8){vlo[6][0], vlo[6][1], vlo[6][2], vlo[6][3], vhi[6][0], vhi[6][1], vhi[6][2], vhi[6][3]}, o[1], 0, 0, 0); \
            o[0] = __builtin_amdgcn_mfma_f32_32x32x16_bf16(__builtin_bit_cast(bf16x8, pw3), (bf16x8){vlo[3][0], vlo[3][1], vlo[3][2], vlo[3][3], vhi[3][0], vhi[3][1], vhi[3][2], vhi[3][3]}, o[0], 0, 0, 0); \
            o[1] = __builtin_amdgcn_mfma_f32_32x32x16_bf16(__builtin_bit_cast(bf16x8, pw3), (bf16x8){vlo[7][0], vlo[7][1], vlo[7][2], vlo[7][3], vhi[7][0], vhi[7][1], vhi[7][2], vhi[7][3]}, o[1], 0, 0, 0); } \
        _Pragma("unroll") for (int r_ = 0; r_ < 16; ++r_) { pA0[r_] = __builtin_amdgcn_exp2f(C0[r_]); pA1[r_] = __builtin_amdgcn_exp2f(C1[r_]); } \
        if (HASPREV) { _Pragma("unroll") for (int g_ = 0; g_ < 8; ++g_) { __builtin_amdgcn_sched_group_barrier(0x008, 1, 0); __builtin_amdgcn_sched_group_barrier(0x400, 4, 0); } } \
        if (resc_) { asm volatile("s_waitcnt lgkmcnt(0)" ::: "memory"); \
            _Pragma("unroll") for (int r_ = 0; r_ < 16; ++r_) { const float fr_ = wsf[crow(r_, hi)]; o[0][r_] *= fr_; o[1][r_] *= fr_; } } \
    } while (0)
#pragma unroll 1
    for (int S = 0; S < NS; ++S) {
        WAIT_BAR(0);
        if (S + 1 < NS) DMA2(S + 1, bo_nxt);
        if (S == 0) {
            bias31 = lut[128];
            __attribute__((address_space(3))) float* gsh = (__attribute__((address_space(3))) float*)(shm3 + 2 * M_BUF) + wid * 1024;
#pragma unroll 1
            for (int j = 0; j < qb; ++j) { float a = 0.f;
#pragma unroll
                for (int d0 = 0; d0 < 4; ++d0) { const f32x4 k0 = *(const __attribute__((address_space(3))) f32x4*)(kmean + j * 64 + d0 * 16 + hi * 8), k1 = *(const __attribute__((address_space(3))) f32x4*)(kmean + j * 64 + d0 * 16 + hi * 8 + 4);
                    const bf16x8 q = qr[d0];
                    a += __uint_as_float((unsigned)(unsigned short)q[0] << 16) * k0[0] + __uint_as_float((unsigned)(unsigned short)q[1] << 16) * k0[1] + __uint_as_float((unsigned)(unsigned short)q[2] << 16) * k0[2] + __uint_as_float((unsigned)(unsigned short)q[3] << 16) * k0[3]
                       + __uint_as_float((unsigned)(unsigned short)q[4] << 16) * k1[0] + __uint_as_float((unsigned)(unsigned short)q[5] << 16) * k1[1] + __uint_as_float((unsigned)(unsigned short)q[6] << 16) * k1[2] + __uint_as_float((unsigned)(unsigned short)q[7] << 16) * k1[3]; }
                gsh[j * 64 + lane] = a + swap32(a, hi); }
            asm volatile("s_waitcnt lgkmcnt(0)" ::: "memory");
            float g[8];
#pragma unroll
            for (int j = 0; j < 8; ++j) { g[j] = -INFINITY; if (j < qb) g[j] = gsh[j * 64 + lane]; }
#pragma unroll
            for (int j = 0; j < 8; ++j) if (j < qb) { int rank = 0;
#pragma unroll
                for (int i = 0; i < 8; ++i) if (i != j && i < qb) rank += (g[i] > g[j] || (g[i] == g[j] && i < j)) ? 1 : 0;
                if (rank < 3) selmask |= 1u << j; }
            asm volatile("s_waitcnt lgkmcnt(0)" ::: "memory");
            { const int kt0 = TILE2(0, 0), kt1 = TILE2(0, 1);
#pragma unroll
              for (int r = 0; r < 16; ++r) nbv[r] = bias31 - mhat;
              MOBA_TILE(kt0, bo_cur, true, false, true); vprev = bo_cur;
              MOBA_TILE(kt1, bo_cur + 8192, true, true, false); vprev = bo_cur + 8192; }
        } else {
            const bool own = S < 2; const int kt0 = TILE2(S, 0), kt1 = TILE2(S, 1);
            { float nb = bias31 - mhat; if (!own) nb = ((selmask >> (kt0 >> 2)) & 1u) ? nb : -INFINITY;
#pragma unroll
              for (int r = 0; r < 16; ++r) nbv[r] = nb; }
            MOBA_TILE(kt0, bo_cur, own, true, false); vprev = bo_cur;
            MOBA_TILE(kt1, bo_cur + 8192, own, true, false); vprev = bo_cur + 8192;
        }
        { const int t_ = bo_prv; bo_prv = bo_cur; bo_cur = bo_nxt; bo_nxt = t_; }
    }
    int tid_e = threadIdx.x; asm volatile("" : "+v"(tid_e));
    const int lane_e = tid_e & 63, r32_e = lane_e & 31, hi_e = lane_e >> 5; const int wid_e = __builtin_amdgcn_readfirstlane(tid_e >> 6);
    __attribute__((address_space(3))) float* wsf_e = (__attribute__((address_space(3))) float*)(shm3 + M_WS) + wid_e * 64;
    { float sa = 0.f, sb = 0.f;
#pragma unroll
      for (int r = 0; r < 16; ++r) { sa += pA0[r]; sb += pA1[r]; }
      l_reg += sa + sb;
      u32x4 pw0, pw1, pw2, pw3;
      pw0 = (u32x4){PKW(pA0, 0), PKW(pA0, 2), PKW(pA0, 4), PKW(pA0, 6)}; pw1 = (u32x4){PKW(pA0, 8), PKW(pA0, 10), PKW(pA0, 12), PKW(pA0, 14)};
      pw2 = (u32x4){PKW(pA1, 0), PKW(pA1, 2), PKW(pA1, 4), PKW(pA1, 6)}; pw3 = (u32x4){PKW(pA1, 8), PKW(pA1, 10), PKW(pA1, 12), PKW(pA1, 14)};
      SBAR();
      pv(o, (int)((unsigned)(uintptr_t)shm + 16384) + vprev + ((lane_e >> 4) & 1) * 32 + (lane_e & 3) * 8 + (4 * hi_e + ((lane_e & 15) >> 2)) * 64, __builtin_bit_cast(bf16x8, pw0), __builtin_bit_cast(bf16x8, pw1), __builtin_bit_cast(bf16x8, pw2), __builtin_bit_cast(bf16x8, pw3)); }
    l_reg += swap32(l_reg, hi_e);
    if (hi_e == 0) wsf_e[32 + r32_e] = l_reg; asm volatile("s_waitcnt lgkmcnt(0)" ::: "memory");
    float rli[16];
#pragma unroll
    for (int r = 0; r < 16; ++r) rli[r] = __builtin_amdgcn_rcpf(wsf_e[32 + crow(r, hi_e)]);
    store_o(o, rli, Y + ((long)b * SEQ + qb * 256 + wid_e * 32) * DM + 512 + h * 64, DM, shm + (M_OST - LDS_OST), wid_e, lane_e, r32_e, hi_e);
    WAIT_BAR(0);
#undef MOBA_TILE
#undef DMA2
#undef TILE2
}
#undef PKW
#undef SBAR
#undef WAIT_BAR
}

constexpr size_t MiB = 1u << 20;
constexpr size_t WS_CTL = 0, CTL_ZERO_BYTES = 1 * MiB;
constexpr size_t WS_WIN = 2 * MiB;
constexpr size_t WS_WPROJ = 12 * MiB;
constexpr size_t WS_WOUT = 14 * MiB;
constexpr size_t WS_WGU = 16 * MiB;
constexpr size_t WS_WD = 144 * MiB;
constexpr size_t WS_XN = 208 * MiB;
constexpr size_t WS_QKV = 240 * MiB;
constexpr size_t WS_GATES = 336 * MiB;
constexpr size_t WS_Y = 400 * MiB;
constexpr size_t WS_MERGED = 432 * MiB;
constexpr size_t WS_H1 = 464 * MiB;
constexpr size_t WS_HN = 528 * MiB;
constexpr size_t WS_ACT = 560 * MiB;
constexpr size_t WS_YSLOT = 704 * MiB;
constexpr size_t WS_LIST = 848 * MiB;
constexpr size_t WS_TOPW = 850 * MiB;
constexpr size_t WS_KPART = 851 * MiB;
constexpr size_t WS_TOKENT = 852 * MiB;
constexpr size_t WS_END = 853 * MiB;
constexpr int CW_TMO = 0, CW_CODE = 1;
constexpr int CW_CNT = 8192;
constexpr int CW_BAR = 4096;

constexpr int RING_OFF = 0, RING_BYTES = 131072;
constexpr int SCRATCH_BYTES = 147456;
constexpr int LDSCTL_OFF = SCRATCH_BYTES;
constexpr int L_MISC = LDSCTL_OFF;
constexpr int L_CNT = LDSCTL_OFF + 128;
constexpr int L_TOFF = LDSCTL_OFF + 256;
constexpr int L_TILEE = LDSCTL_OFF + 512;
constexpr int L_HIST = LDSCTL_OFF + 2048;
constexpr int L_BASE = LDSCTL_OFF + 2176;
constexpr int L_TMP = LDSCTL_OFF + 2304;
constexpr int LDS_BYTES = LDSCTL_OFF + 8192;
constexpr int NWAVES = 8;

#define GAS __attribute__((address_space(1)))
#define LAS __attribute__((address_space(3)))
typedef unsigned short bf16;
typedef unsigned v4u __attribute__((ext_vector_type(4)));
typedef unsigned v2u __attribute__((ext_vector_type(2)));
typedef float f32x4 __attribute__((ext_vector_type(4)));
typedef GAS unsigned gu32;
#define RLX_AGENT __ATOMIC_RELAXED, __HIP_MEMORY_SCOPE_AGENT
#define LDS_WAIT() asm volatile("s_waitcnt lgkmcnt(0)" ::: "memory")
__device__ __forceinline__ unsigned f2bf(float f) { unsigned u = __builtin_bit_cast(unsigned, f); return (u + 0x7fffu + ((u >> 16) & 1u)) >> 16; }
__device__ __forceinline__ unsigned pk2(float lo, float hi) { return f2bf(lo) | (f2bf(hi) << 16); }

#define XB_TMO      128
#define XB_XCNT(j)  (256  + 64 * (j))
#define XB_XSUB(j)  (1280 + 64 * (j))
#define XB_XGEN(j)  (2304 + 64 * (j))
#define XB_TOP      3328
#define XB_TOPGEN   3392
#define XCD_BAR_WORDS 3456
#define XB_SPIN_CAP (1u << 18)
__device__ __forceinline__ unsigned xb_ld(unsigned* p)              { return __hip_atomic_load(p, __ATOMIC_RELAXED, __HIP_MEMORY_SCOPE_AGENT); }
__device__ __forceinline__ unsigned xb_add(unsigned* p, unsigned v) { return __hip_atomic_fetch_add(p, v, __ATOMIC_RELAXED, __HIP_MEMORY_SCOPE_AGENT); }
__device__ __forceinline__ unsigned xb_xcc_id() { return (unsigned)__builtin_amdgcn_s_getreg((3 << 11) | 20) & 0xFu; }
#define XB_SPIN(cond, bar) do { unsigned _sp = 0; while (cond) { __builtin_amdgcn_s_sleep(1); \
    if ((++_sp & 255u) == 0u) { if (xb_ld(&(bar)[XB_TMO])) break; if (_sp > XB_SPIN_CAP) { atomicAdd(&(bar)[XB_TMO], 1u); break; } } } } while (0)
struct XcdBarrier { unsigned* bar; unsigned x; volatile LAS unsigned* st; };
__device__ __forceinline__ XcdBarrier xcd_barrier_post(unsigned* bar, volatile LAS unsigned* st) {
    XcdBarrier b; b.bar = bar; b.x = xb_xcc_id(); b.st = st;
    if (threadIdx.x == 0) (void)xb_add(&bar[XB_XCNT(b.x)], 1u);
    return b;
}
__device__ __forceinline__ void xcd_barrier_complete(unsigned* bar, unsigned x, unsigned& nloc, unsigned& nx) {
    const unsigned G = gridDim.x * gridDim.y * gridDim.z;
    unsigned sum, cnt, mine, sp = 0u;
    for (;;) {
        sum = 0u; cnt = 0u; mine = 0u;
#pragma unroll
        for (unsigned j = 0; j < 16; ++j) { const unsigned c = xb_ld(&bar[XB_XCNT(j)]); sum += c; cnt += (c > 0u) ? 1u : 0u; mine = (j == x) ? c : mine; }
        if (sum == G) break;
        __builtin_amdgcn_s_sleep(1);
        if ((++sp & 255u) == 0u) { if (xb_ld(&bar[XB_TMO])) break; if (sp > XB_SPIN_CAP) { atomicAdd(&bar[XB_TMO], 1u); break; } }
    }
    nloc = mine > 0u ? mine : 1u; nx = cnt > 0u ? cnt : 1u;
}
__device__ __forceinline__ void xcd_barrier(const XcdBarrier& b) {
    asm volatile("s_waitcnt vmcnt(0)" ::: "memory");
    __syncthreads();
    if (threadIdx.x == 0) {
        unsigned* bar = b.bar;
        __builtin_amdgcn_s_waitcnt(0);
        unsigned nloc = b.st[0], nx = b.st[1];
        if (nloc == 0u) { xcd_barrier_complete(bar, b.x, nloc, nx); b.st[0] = nloc; b.st[1] = nx; }
        const unsigned old = xb_add(&bar[XB_XSUB(b.x)], 1u);
        const unsigned gen = old / nloc;
        if (old + 1u == (gen + 1u) * nloc) {
            __builtin_amdgcn_fence(__ATOMIC_RELEASE, "agent");
            asm volatile("s_waitcnt vmcnt(0)" ::: "memory");
            const unsigned og = xb_add(&bar[XB_TOP], 1u);
            const unsigned tg = og / nx;
            if (og + 1u == (tg + 1u) * nx) xb_add(&bar[XB_TOPGEN], 1u);
            else XB_SPIN(xb_ld(&bar[XB_TOPGEN]) == tg, bar);
            __builtin_amdgcn_fence(__ATOMIC_ACQUIRE, "agent");
            xb_add(&bar[XB_XGEN(b.x)], 1u);
            asm volatile("s_waitcnt vmcnt(0)" ::: "memory");
        } else {
            XB_SPIN(xb_ld(&bar[XB_XGEN(b.x)]) == gen, bar);
            __builtin_amdgcn_fence(__ATOMIC_ACQUIRE, "agent");
            asm volatile("s_waitcnt vmcnt(0)" ::: "memory");
        }
    }
    __syncthreads();
}

struct Frame {
    LAS unsigned char* lds; gu32* ctl; int tid, lane, wave, vcu, G;
    const float *x, *norm_mix_g, *w_in, *w_proj_sb, *w_proj_moba, *w_out, *rel_bias, *norm_ffn_g, *w_router, *b_router, *w_gate_up, *b_gate_up, *w_down, *b_down, *norm_final_g;
    float* out; unsigned char* ws;
};
__device__ __forceinline__ float wave_sum(float v) {
#pragma unroll
    for (int o = 1; o < 64; o <<= 1) v += __shfl_xor(v, o);
    return v;
}
template <bool FP8> struct P0Item { const float* src; unsigned char* dst; int ldw, ldtB; float scale; };
template <bool FP8>
__device__ __forceinline__ P0Item<FP8> p0_mk(const float* W, int ldw, int k0, int n0, unsigned char* WT, int ldtB, int dst_row0, int kdstB, int lane, float scale) {
    constexpr int KL = FP8 ? 16 : 8; const int lk = lane >> 3, ln = lane & 7;
    P0Item<FP8> it; it.src = W + (size_t)(k0 + KL * lk) * ldw + n0 + 4 * ln; it.dst = WT + (size_t)(dst_row0 + 4 * ln) * ldtB + kdstB + (size_t)(k0 + KL * lk) * (FP8 ? 1 : 2); it.ldw = ldw; it.ldtB = ldtB; it.scale = scale; return it;
}
template <bool FP8, int KL>
__device__ __forceinline__ void p0_load(const P0Item<FP8>& it, f32x4 (&v)[KL]) {
    const GAS f32x4* src = (const GAS f32x4*)it.src;
#pragma unroll
    for (int i = 0; i < KL; ++i) v[i] = __builtin_nontemporal_load(src + (size_t)i * (it.ldw / 4));
}
template <bool FP8, int KL>
__device__ __forceinline__ void p0_store(const P0Item<FP8>& it, const f32x4 (&v)[KL]) {
    const float scale = it.scale;
#pragma unroll
    for (int j = 0; j < 4; ++j) { v4u o;
        if constexpr (FP8) { o.x = pg8::pk4_fp8(v[0][j] * scale, v[1][j] * scale, v[2][j] * scale, v[3][j] * scale); o.y = pg8::pk4_fp8(v[4][j] * scale, v[5][j] * scale, v[6][j] * scale, v[7][j] * scale);
            o.z = pg8::pk4_fp8(v[8][j] * scale, v[9][j] * scale, v[10][j] * scale, v[11][j] * scale); o.w = pg8::pk4_fp8(v[12][j] * scale, v[13][j] * scale, v[14][j] * scale, v[15][j] * scale); }
        else { o.x = pg8::cvt_pk_bf16(v[0][j], v[1][j]); o.y = pg8::cvt_pk_bf16(v[2][j], v[3][j]); o.z = pg8::cvt_pk_bf16(v[4][j], v[5][j]); o.w = pg8::cvt_pk_bf16(v[6][j], v[7][j]); }
        *(GAS v4u*)(it.dst + (size_t)j * it.ldtB) = o; }
}
template <bool FP8>
__device__ __forceinline__ void p0_item(const float* W, int ldw, int k0, int n0, unsigned char* WT, int ldtB, int dst_row0, int kdstB, int lane, float scale) {
    constexpr int KL = FP8 ? 16 : 8;
    const P0Item<FP8> it = p0_mk<FP8>(W, ldw, k0, n0, WT, ldtB, dst_row0, kdstB, lane, scale);
    f32x4 v[KL]; p0_load<FP8, KL>(it, v); p0_store<FP8, KL>(it, v);
}
constexpr int EX_KI = MOE_FP8 ? 128 : 64;
constexpr int EX_GU_PER = (1024 / EX_KI) * 64, EX_D_PER = (1024 / EX_KI) * 32, EX_I_GU = 32 * EX_GU_PER, EX_I_D = 32 * EX_D_PER, EX_ITEMS = EX_I_GU + EX_I_D;
__device__ __forceinline__ P0Item<MOE_FP8> expert_item(Frame& F, int r) {
    unsigned char* WGU = F.ws + WS_WGU; unsigned char* WD = F.ws + WS_WD;
    if (r < EX_I_GU) { const int e = r / EX_GU_PER, q = r % EX_GU_PER, kb = q >> 6, nb = q & 63, n0 = 32 * nb;
        const int cc = n0 & 1023, drow = (cc >> 7) * 256 + (n0 >= 1024 ? 128 : 0) + (cc & 127);
        return p0_mk<MOE_FP8>(F.w_gate_up + (size_t)e * 1024 * 2048, 2048, EX_KI * kb, n0, WGU + (size_t)e * 2048 * 1024 * MOE_ES, 1024 * MOE_ES, drow, 0, F.lane, MOE_WSCALE); }
    r -= EX_I_GU; const int e = r / EX_D_PER, q = r % EX_D_PER, kb = q >> 5, nb = q & 31;
    return p0_mk<MOE_FP8>(F.w_down + (size_t)e * 1024 * 1024, 1024, EX_KI * kb, 32 * nb, WD + (size_t)e * 1024 * 1024 * MOE_ES, 1024 * MOE_ES, 32 * nb, 0, F.lane, MOE_WSCALE);
}
template <int NI>
__device__ __forceinline__ void conv_chunks(Frame& F, int& conv_k, const int n) {
    constexpr int KLE = MOE_FP8 ? 16 : 8; const int gw = F.vcu * NWAVES + F.wave, NGW = F.G * NWAVES;
    for (int c = 0; c < n && conv_k + NI <= 12; ++c, conv_k += NI) {
        P0Item<MOE_FP8> it[NI]; f32x4 v[NI][KLE];
#pragma unroll
        for (int q = 0; q < NI; ++q) { const int k = conv_k + q; const int i = k < 8 ? gw + k * NGW : EX_I_GU + gw + (k - 8) * NGW; it[q] = expert_item(F, i); p0_load<MOE_FP8, KLE>(it[q], v[q]); }
#pragma unroll
        for (int q = 0; q < NI; ++q) p0_store<MOE_FP8, KLE>(it[q], v[q]); }
}
template <int NI> struct ConvHookT { Frame* F; int* conv_k; unsigned long long counts;
    __device__ __forceinline__ void operator()(int site) const { const int n = site < 16 ? (int)((counts >> (4 * site)) & 15ull) : 0; if (n) conv_chunks<NI>(*F, *conv_k, n); } };
__device__ __forceinline__ void p0_prologue(Frame& F, const int which) {
    const int gw = F.vcu * NWAVES + F.wave, NGW = F.G * NWAVES;
    unsigned char* WIN = F.ws + WS_WIN; unsigned char* WPROJ = F.ws + WS_WPROJ; unsigned char* WOUT = F.ws + WS_WOUT;
    constexpr int I_IN = 16 * 160, I_PS = 8 * 32, I_PM = 8 * 32, I_OUT = 16 * 32, I_GU = EX_I_GU, I_D = EX_I_D;
    constexpr int NITEMS = I_IN + I_PS + I_PM + I_OUT + I_GU + I_D;
    if (which & 2) {
        constexpr int KLE = MOE_FP8 ? 16 : 8; constexpr int I_E = EX_ITEMS;
        int it = gw;
#pragma unroll 1
        for (; it + NGW < I_E; it += 2 * NGW) { const P0Item<MOE_FP8> a = expert_item(F, it), b = expert_item(F, it + NGW); f32x4 va[KLE], vb[KLE];
            p0_load<MOE_FP8, KLE>(a, va); p0_load<MOE_FP8, KLE>(b, vb); p0_store<MOE_FP8, KLE>(a, va); p0_store<MOE_FP8, KLE>(b, vb); }
        if (it < I_E) { const P0Item<MOE_FP8> a = expert_item(F, it); f32x4 va[KLE]; p0_load<MOE_FP8, KLE>(a, va); p0_store<MOE_FP8, KLE>(a, va); }
    }
    if (!(which & 1)) return;
    for (int it = I_GU + I_D + gw; it < NITEMS; it += NGW) {
        int r = it - I_GU - I_D;
        if (r < I_IN) { const int kb = r / 160, nb = r % 160; p0_item<false>(F.w_in, DIN, 64 * kb, 32 * nb, WIN, 2048, 32 * nb, 0, F.lane, 1.f); continue; } r -= I_IN;
        if (r < I_PS) { const int kb = r >> 5, nb = r & 31; p0_item<false>(F.w_proj_sb, 1024, 64 * kb, 32 * nb, WPROJ, 2048, 32 * nb, 0, F.lane, 1.f); continue; } r -= I_PS;
        if (r < I_PM) { const int kb = r >> 5, nb = r & 31; p0_item<false>(F.w_proj_moba, 1024, 64 * kb, 32 * nb, WPROJ, 2048, 32 * nb, 1024, F.lane, 1.f); continue; } r -= I_PM;
        { const int kb = r >> 5, nb = r & 31; p0_item<false>(F.w_out, 1024, 64 * kb, 32 * nb, WOUT, 2048, 32 * nb, 0, F.lane, 1.f); }
    }
    f32x4 g[4];
#pragma unroll
    for (int j = 0; j < 4; ++j) g[j] = ((const f32x4*)F.norm_mix_g)[F.lane + 64 * j];
    bf16* XN = (bf16*)(F.ws + WS_XN);
#pragma unroll 1
    for (int m = gw; m < T_TOK; m += 4 * NGW) {
        f32x4 v[4][4];
#pragma unroll
        for (int r = 0; r < 4; ++r) { const GAS f32x4* xr = (const GAS f32x4*)(F.x + (size_t)(m + r * NGW) * DM) + F.lane;
#pragma unroll
            for (int j = 0; j < 4; ++j) v[r][j] = (m + r * NGW < T_TOK) ? __builtin_nontemporal_load(xr + 64 * j) : (f32x4){0.f, 0.f, 0.f, 0.f}; }
#pragma unroll
        for (int r = 0; r < 4; ++r) { if (m + r * NGW < T_TOK) { float s = 0.f;
#pragma unroll
            for (int j = 0; j < 4; ++j) s += (v[r][j].x * v[r][j].x + v[r][j].y * v[r][j].y) + (v[r][j].z * v[r][j].z + v[r][j].w * v[r][j].w);
            const float rstd = 1.0f / sqrtf(wave_sum(s) * (1.0f / DM) + RMS_EPS);
            GAS v2u* o8 = (GAS v2u*)(XN + (size_t)(m + r * NGW) * DM) + F.lane;
#pragma unroll
            for (int j = 0; j < 4; ++j) { const f32x4 y = v[r][j] * rstd * g[j]; v2u w; w.x = pg8::cvt_pk_bf16(y.x, y.y); w.y = pg8::cvt_pk_bf16(y.z, y.w); o8[64 * j] = w; } } }
    }
}

__device__ __forceinline__ f32x4 h1_frag(const bf16* h1, size_t row, int lane, int j) {
    const v2u a = *((const GAS v2u*)(h1 + row * DM) + lane + 64 * j);
    return (f32x4){__uint_as_float(a.x << 16), __uint_as_float(a.x & 0xffff0000u), __uint_as_float(a.y << 16), __uint_as_float(a.y & 0xffff0000u)};
}
__device__ __forceinline__ void p5_router_mfma(Frame& F) {
    typedef short bf16x8_t __attribute__((ext_vector_type(8)));
    typedef float f32x16_t __attribute__((ext_vector_type(16)));
    LAS unsigned short* WH = (LAS unsigned short*)(F.lds + RING_OFF);
    LAS unsigned short* WL = (LAS unsigned short*)(F.lds + RING_OFF + 65536);
    LAS float* PL = (LAS float*)(F.lds + RING_OFF);
    LAS float* SSQ = (LAS float*)(F.lds + LDSCTL_OFF + 4096);
    LAS float* RSTD = (LAS float*)(F.lds + LDSCTL_OFF + 5120);
    LAS int* hist = (LAS int*)(F.lds + L_HIST); LAS int* basel = (LAS int*)(F.lds + L_BASE); LAS int* tmp = (LAS int*)(F.lds + L_TMP);
    int tid = threadIdx.x; asm volatile("" : "+v"(tid));
    const int lane = tid & 63; const int wave = __builtin_amdgcn_readfirstlane(tid >> 6);
    const bf16* H1 = (const bf16*)(F.ws + WS_H1); unsigned char* HN8 = F.ws + WS_HN; float* topw = (float*)(F.ws + WS_TOPW); int* list = (int*)(F.ws + WS_LIST);
#pragma unroll 1
    for (int rb = F.vcu; rb < T_TOK / 64; rb += F.G) {
        for (int kk = tid; kk < DM; kk += NWAVES * 64) { const float gk = F.norm_ffn_g[kk]; const int fb = (((kk >> 4) * 2 + ((kk >> 3) & 1)) * 32) * 8 + (kk & 7);
#pragma unroll
            for (int q = 0; q < 8; ++q) { const f32x4 v = *(const f32x4*)(F.w_router + (size_t)kk * 32 + 4 * q);
#pragma unroll
                for (int c = 0; c < 4; ++c) { const float w = v[c] * gk; const unsigned hi = f2bf(w); const float lo = w - __uint_as_float(hi << 16);
                    WH[fb + (4 * q + c) * 8] = (unsigned short)hi; WL[fb + (4 * q + c) * 8] = (unsigned short)f2bf(lo); } } }
        if (tid < 32) hist[tid] = 0;
        __syncthreads();
        { const int mb = wave & 1, kq = wave >> 1, r = lane & 31, kg = lane >> 5;
          const bf16* hrow = H1 + (size_t)(rb * 64 + 32 * mb + r) * DM + kq * 256 + 8 * kg;
          bf16x8_t a[16];
#pragma unroll
          for (int st = 0; st < 16; ++st) a[st] = *(const bf16x8_t*)(hrow + st * 16);
          f32x16_t acc = f32x16_t{}; float ssq = 0.f;
#pragma unroll
          for (int st = 0; st < 16; ++st) { const int fo = (((kq * 16 + st) * 2 + kg) * 32 + r) * 8;
              const bf16x8_t bh = *(const LAS bf16x8_t*)(WH + fo), bl = *(const LAS bf16x8_t*)(WL + fo);
              acc = __builtin_amdgcn_mfma_f32_32x32x16_bf16(a[st], bh, acc, 0, 0, 0); acc = __builtin_amdgcn_mfma_f32_32x32x16_bf16(a[st], bl, acc, 0, 0, 0);
#pragma unroll
              for (int j = 0; j < 8; ++j) { const float x = __uint_as_float((unsigned)(unsigned short)a[st][j] << 16); ssq += x * x; } }
          ssq += __shfl_xor(ssq, 32);
          __syncthreads();
#pragma unroll
          for (int reg = 0; reg < 16; ++reg) { const int row = 32 * mb + (reg & 3) + 8 * (reg >> 2) + 4 * kg; PL[(kq * 64 + row) * 32 + r] = acc[reg]; }
          if (kg == 0) SSQ[kq * 64 + 32 * mb + r] = ssq; }
        __syncthreads();
        if (wave == 0) { const int row = lane; const float rstd = 1.0f / sqrtf((SSQ[row] + SSQ[64 + row] + SSQ[128 + row] + SSQ[192 + row]) * (1.0f / DM) + RMS_EPS); RSTD[row] = rstd;
            float lg[32];
#pragma unroll
            for (int e4 = 0; e4 < 8; ++e4) { const f32x4 p0 = *(const LAS f32x4*)(PL + (0 * 64 + row) * 32 + 4 * e4), p1 = *(const LAS f32x4*)(PL + (1 * 64 + row) * 32 + 4 * e4), p2 = *(const LAS f32x4*)(PL + (2 * 64 + row) * 32 + 4 * e4), p3 = *(const LAS f32x4*)(PL + (3 * 64 + row) * 32 + 4 * e4);
                const f32x4 bb = *(const f32x4*)(F.b_router + 4 * e4); const f32x4 sm = ((p0 + p1) + (p2 + p3)) * rstd + bb;
                lg[4 * e4] = sm.x; lg[4 * e4 + 1] = sm.y; lg[4 * e4 + 2] = sm.z; lg[4 * e4 + 3] = sm.w; }
            float selv[4]; int seli[4];
#pragma unroll
            for (int k = 0; k < 4; ++k) { float best = lg[0]; int bi = 0;
#pragma unroll
                for (int e = 1; e < 32; ++e) { const bool t = lg[e] > best; best = t ? lg[e] : best; bi = t ? e : bi; }
                selv[k] = best; seli[k] = bi;
#pragma unroll
                for (int e = 0; e < 32; ++e) lg[e] = (e == bi) ? -INFINITY : lg[e]; }
            const float e1 = __expf(selv[1] - selv[0]), e2 = __expf(selv[2] - selv[0]), e3 = __expf(selv[3] - selv[0]); const float inv = 1.0f / (1.0f + e1 + e2 + e3);
            const float wk[4] = {inv, e1 * inv, e2 * inv, e3 * inv};
#pragma unroll
            for (int k = 0; k < 4; ++k) { const int slot = __hip_atomic_fetch_add(hist + seli[k], 1, __ATOMIC_RELAXED, __HIP_MEMORY_SCOPE_WORKGROUP); tmp[row * 4 + k] = seli[k] | (slot << 8); }
            *(f32x4*)(topw + (size_t)(rb * 64 + row) * 4) = (f32x4){wk[0], wk[1], wk[2], wk[3]}; }
        __syncthreads();
        { f32x4 gl[4];
#pragma unroll
          for (int j = 0; j < 4; ++j) gl[j] = ((const f32x4*)F.norm_ffn_g)[lane * 4 + j];
#pragma unroll 2
          for (int i = 0; i < 8; ++i) { const int row = wave * 8 + i; const size_t grow = (size_t)(rb * 64 + row); const float rs = RSTD[row];
              const v4u h0 = *((const GAS v4u*)(H1 + grow * DM) + lane * 2), h1v = *((const GAS v4u*)(H1 + grow * DM) + lane * 2 + 1);
              float x[16];
              x[0] = __uint_as_float(h0.x << 16); x[1] = __uint_as_float(h0.x & 0xffff0000u); x[2] = __uint_as_float(h0.y << 16); x[3] = __uint_as_float(h0.y & 0xffff0000u);
              x[4] = __uint_as_float(h0.z << 16); x[5] = __uint_as_float(h0.z & 0xffff0000u); x[6] = __uint_as_float(h0.w << 16); x[7] = __uint_as_float(h0.w & 0xffff0000u);
              x[8] = __uint_as_float(h1v.x << 16); x[9] = __uint_as_float(h1v.x & 0xffff0000u); x[10] = __uint_as_float(h1v.y << 16); x[11] = __uint_as_float(h1v.y & 0xffff0000u);
              x[12] = __uint_as_float(h1v.z << 16); x[13] = __uint_as_float(h1v.z & 0xffff0000u); x[14] = __uint_as_float(h1v.w << 16); x[15] = __uint_as_float(h1v.w & 0xffff0000u);
#pragma unroll
              for (int j = 0; j < 4; ++j) { x[4 * j] *= rs * gl[j].x; x[4 * j + 1] *= rs * gl[j].y; x[4 * j + 2] *= rs * gl[j].z; x[4 * j + 3] *= rs * gl[j].w; }
              if constexpr (MOE_FP8) { v4u o; o.x = pg8::pk4_fp8(x[0], x[1], x[2], x[3]); o.y = pg8::pk4_fp8(x[4], x[5], x[6], x[7]); o.z = pg8::pk4_fp8(x[8], x[9], x[10], x[11]); o.w = pg8::pk4_fp8(x[12], x[13], x[14], x[15]);
                  *((GAS v4u*)(HN8 + grow * DM) + lane) = o; }
              else { v4u o0, o1; o0.x = pg8::cvt_pk_bf16(x[0], x[1]); o0.y = pg8::cvt_pk_bf16(x[2], x[3]); o0.z = pg8::cvt_pk_bf16(x[4], x[5]); o0.w = pg8::cvt_pk_bf16(x[6], x[7]);
                  o1.x = pg8::cvt_pk_bf16(x[8], x[9]); o1.y = pg8::cvt_pk_bf16(x[10], x[11]); o1.z = pg8::cvt_pk_bf16(x[12], x[13]); o1.w = pg8::cvt_pk_bf16(x[14], x[15]);
                  *((GAS v4u*)(HN8 + grow * DM * 2) + lane * 2) = o0; *((GAS v4u*)(HN8 + grow * DM * 2) + lane * 2 + 1) = o1; } } }
        if (tid < 32) basel[tid] = (int)__hip_atomic_fetch_add((unsigned*)(F.ctl + CW_CNT + 64 * tid), (unsigned)hist[tid], RLX_AGENT);
        __syncthreads();
        if (tid < 256) { const int t = tmp[tid]; const int ex = t & 255, slot = t >> 8; const int id = (rb * 64 + (tid >> 2)) * 4 + (tid & 3); const int idx = basel[ex] + slot;
            list[(size_t)ex * LIST_CAP + idx] = id; ((int*)(F.ws + WS_TOKENT))[id] = ex | (idx << 8); }
        __syncthreads();
    }
}
__device__ __forceinline__ int moe_tables(Frame& F) {
    LAS int* cnt = (LAS int*)(F.lds + L_CNT); LAS int* toff = (LAS int*)(F.lds + L_TOFF); LAS int* tile_e = (LAS int*)(F.lds + L_TILEE);
    __syncthreads();
    if (F.tid < 64) {
        const int lane = F.lane; int c = (lane < 32) ? (int)__hip_atomic_load((unsigned*)(F.ctl + CW_CNT + 64 * (lane & 31)), RLX_AGENT) : 0; c = c > LIST_CAP ? LIST_CAP : c;
        const int ntl = (c + 255) >> 8; int incl = ntl;
#pragma unroll
        for (int o = 1; o < 32; o <<= 1) { const int t = __shfl_up(incl, o); if (lane >= o) incl += t; }
        const int off = incl - ntl;
        if (lane < 32) { cnt[lane] = c; toff[lane] = off; if (lane == 31) toff[32] = incl;
            for (int t = 0; t < ntl; ++t) if (off + t < MAX_TILES) tile_e[off + t] = lane; } }
    __syncthreads();
    int NT = toff[32]; return NT > MAX_TILES ? MAX_TILES : NT;
}
__device__ __forceinline__ void p8_final(Frame& F) {
    int tid_ = threadIdx.x; asm volatile("" : "+v"(tid_));
    const int gw = F.vcu * NWAVES + F.wave, NGW = F.G * NWAVES, lane = tid_ & 63;
    (void)moe_tables(F);
    LAS float* bdl = (LAS float*)(F.lds + RING_OFF); const LAS int* toff = (const LAS int*)(F.lds + L_TOFF);
    for (int i = F.tid; i < NEXP * DM / 4; i += NWAVES * 64) ((LAS f32x4*)bdl)[i] = ((const f32x4*)F.b_down)[i];
    __syncthreads();
    f32x4 g[4];
#pragma unroll
    for (int j = 0; j < 4; ++j) g[j] = ((const f32x4*)F.norm_final_g)[lane + 64 * j];
    const bf16* H1 = (const bf16*)(F.ws + WS_H1); const bf16* YS = (const bf16*)(F.ws + WS_YSLOT); const int* tokent = (const int*)(F.ws + WS_TOKENT); const float* topw = (const float*)(F.ws + WS_TOPW);
#pragma unroll 1
    for (int m0 = gw; m0 < T_TOK; m0 += 2 * NGW) {
        int4 ent[2]; f32x4 wk[2]; f32x4 v[2][4]; v2u y[2][4][4];
#pragma unroll
        for (int t = 0; t < 2; ++t) { const int m = m0 + t * NGW; ent[t] = *(const int4*)(tokent + (size_t)m * 4); wk[t] = *(const f32x4*)(topw + (size_t)m * 4); }
#pragma unroll
        for (int t = 0; t < 2; ++t) { const int m = m0 + t * NGW;
#pragma unroll
            for (int j = 0; j < 4; ++j) v[t][j] = h1_frag(H1, (size_t)m, lane, j);
#pragma unroll
            for (int k = 0; k < TOPK; ++k) { const int en = k == 0 ? ent[t].x : k == 1 ? ent[t].y : k == 2 ? ent[t].z : ent[t].w; const int e = en & 255, idx = en >> 8; const size_t row = (size_t)toff[e] * 256 + idx;
                const GAS v2u* yr = (const GAS v2u*)(YS + row * DM) + lane;
#pragma unroll
                for (int j = 0; j < 4; ++j) y[t][k][j] = yr[64 * j]; } }
#pragma unroll
        for (int t = 0; t < 2; ++t) { const int m = m0 + t * NGW;
#pragma unroll
            for (int k = 0; k < TOPK; ++k) { const int en = k == 0 ? ent[t].x : k == 1 ? ent[t].y : k == 2 ? ent[t].z : ent[t].w; const int e = en & 255; const float w = k == 0 ? wk[t].x : k == 1 ? wk[t].y : k == 2 ? wk[t].z : wk[t].w;
#pragma unroll
                for (int j = 0; j < 4; ++j) { const f32x4 bb = *(const LAS f32x4*)(bdl + e * DM + 4 * (lane + 64 * j)); const v2u q = y[t][k][j];
                    v[t][j].x += w * (__uint_as_float(q.x << 16) + bb.x); v[t][j].y += w * (__uint_as_float(q.x & 0xffff0000u) + bb.y); v[t][j].z += w * (__uint_as_float(q.y << 16) + bb.z); v[t][j].w += w * (__uint_as_float(q.y & 0xffff0000u) + bb.w); } }
            float s = 0.f;
#pragma unroll
            for (int j = 0; j < 4; ++j) s += (v[t][j].x * v[t][j].x + v[t][j].y * v[t][j].y) + (v[t][j].z * v[t][j].z + v[t][j].w * v[t][j].w);
            const float rstd = 1.0f / sqrtf(wave_sum(s) * (1.0f / DM) + RMS_EPS);
            GAS f32x4* o = (GAS f32x4*)(F.out + (size_t)m * DM) + lane;
#pragma unroll
            for (int j = 0; j < 4; ++j) o[64 * j] = v[t][j] * rstd * g[j]; }
    }
}

constexpr int N_PHASES = 9;
struct Args { const float* in[15]; float* out; unsigned char* ws; int ph_lo, ph_hi; };
__global__ void __launch_bounds__(NWAVES * 64, 2) fwd_kernel(Args args) {
    extern __shared__ __attribute__((aligned(16))) unsigned char lds[];
    Frame F;
    F.lds = (LAS unsigned char*)lds;
    F.tid = threadIdx.x; F.lane = F.tid & 63; F.wave = __builtin_amdgcn_readfirstlane(F.tid >> 6);
    F.G = gridDim.x; { const int bx = blockIdx.x; F.vcu = (F.G % 8 == 0) ? (bx % 8) * (F.G / 8) + bx / 8 : bx; }
    F.ws = args.ws; F.ctl = (gu32*)(args.ws + WS_CTL); F.out = args.out;
    F.x = args.in[0]; F.norm_mix_g = args.in[1]; F.w_in = args.in[2]; F.w_proj_sb = args.in[3]; F.w_proj_moba = args.in[4]; F.w_out = args.in[5]; F.rel_bias = args.in[6]; F.norm_ffn_g = args.in[7];
    F.w_router = args.in[8]; F.b_router = args.in[9]; F.w_gate_up = args.in[10]; F.b_gate_up = args.in[11]; F.w_down = args.in[12]; F.b_down = args.in[13]; F.norm_final_g = args.in[14];
    for (int u = F.tid; u < (LDS_BYTES - LDSCTL_OFF) / 4; u += NWAVES * 64) ((LAS unsigned*)(F.lds + LDSCTL_OFF))[u] = 0u;
    __syncthreads();
    XcdBarrier bar; bar.bar = (unsigned*)(F.ctl + CW_BAR); bar.x = 0; bar.st = nullptr;
    if (MK_N_LAUNCHES == 1) bar = xcd_barrier_post((unsigned*)(F.ctl + CW_BAR), (volatile LAS unsigned*)(F.lds + L_MISC) + 8);
#define GRID_BAR() do { if (MK_N_LAUNCHES == 1) xcd_barrier(bar); } while (0)
    const int lo = args.ph_lo, hi = args.ph_hi;
#ifndef PH_MASK
#define PH_MASK 0x1ff
#endif
#define IN(k) ((((PH_MASK) >> (k)) & 1) && lo <= (k) && (k) < hi)
#define BOTH(k) (IN(k) && IN((k) + 1))
    unsigned char* ws = args.ws;
    int conv_k = 0;
    const bool conv_il = CONV_INTERLEAVE && EXPERTS_LATE && F.G == 256 && MK_N_LAUNCHES == 1; const unsigned odd = (unsigned)F.vcu & 1u;

    if (IN(0)) { _Pragma("unroll") for (int rep = 0; rep < 1 + ((PROBE_REP >> 0) & 1); ++rep) { p0_prologue(F, EXPERTS_LATE ? 1 : 3); if (BOTH(0)) GRID_BAR(); } }

    if (IN(1)) { _Pragma("unroll") for (int rep = 0; rep < 1 + ((PROBE_REP >> 1) & 1); ++rep) {
        pg8::DenseOrder S{T_TOK / 256, DIN / 256, F.G, (int)blockIdx.x, (const char*)(ws + WS_XN), (const char*)(ws + WS_WIN), (size_t)256 * DM * 2, (size_t)256 * DM * 2};
        pg8::EpiInProj E{(bf16*)(ws + WS_QKV), (bf16*)(ws + WS_GATES), (float*)(ws + WS_KPART)};
        ConvHookT<3> H{&F, &conv_k, conv_il ? (odd ? 0x00100ull : 0x00001ull) : 0ull};
        pg8::gemm_phase<pg8::EpiInProj, pg8::DenseOrder, true, false, false, ConvHookT<3> >(F.lds + RING_OFF, S, E, DM * 2, DM * 2, DM * 2, H);
        if (BOTH(1)) GRID_BAR();
    } }

    if (IN(2)) { _Pragma("unroll") for (int rep = 0; rep < 1 + ((PROBE_REP >> 2) & 1); ++rep) {
        const att::bf16* QKV = (const att::bf16*)(ws + WS_QKV); att::bf16* Y = (att::bf16*)(ws + WS_Y);
        for (int v = F.vcu; v < 256; v += F.G) {
            const int bh = v >> 2, s = v & 3, b = bh >> 3, h = bh & 7;
            _Pragma("unroll") for (int r2 = 0; r2 < 1 + ((PROBE_REP >> 9) & 1); ++r2) {
            att::moba_unit(b, h, 7 - s, QKV, Y, (const float*)(ws + WS_KPART), F.rel_bias, (char*)lds + RING_OFF);
            att::moba_unit(b, h, s, QKV, Y, (const float*)(ws + WS_KPART), F.rel_bias, (char*)lds + RING_OFF); }
            _Pragma("unroll") for (int r2 = 0; r2 < 1 + ((PROBE_REP >> 10) & 1); ++r2) {
            att::sb_unit(b, h, 7 - s, QKV, Y, (char*)lds + RING_OFF);
            att::sb_unit(b, h, s, QKV, Y, (char*)lds + RING_OFF); }
        }
        if (BOTH(2)) GRID_BAR();
    } }

    if (IN(3)) { _Pragma("unroll") for (int rep = 0; rep < 1 + ((PROBE_REP >> 3) & 1); ++rep) {
        pg8::ProjOrder S{F.G, (int)blockIdx.x, (const char*)(ws + WS_Y), (const char*)(ws + WS_WPROJ)};
        pg8::EpiProjGate E{(const bf16*)(ws + WS_GATES), (bf16*)(ws + WS_MERGED)};
        ConvHookT<3> H{&F, &conv_k, conv_il ? (odd ? 0x010ull : 0x001ull) : 0ull};
        pg8::gemm_phase<pg8::EpiProjGate, pg8::ProjOrder, true, false, false, ConvHookT<3> >(F.lds + RING_OFF, S, E, 512 * 2, DM * 2, DM * 2, H);
        if (BOTH(3)) GRID_BAR();
    } }

    if (IN(4)) { _Pragma("unroll") for (int rep = 0; rep < 1 + ((PROBE_REP >> 4) & 1); ++rep) {
        pg8::DenseOrder S{T_TOK / 256, DM / 256, F.G, (int)blockIdx.x, (const char*)(ws + WS_MERGED), (const char*)(ws + WS_WOUT), (size_t)256 * DM * 2, (size_t)256 * DM * 2};
        pg8::EpiResF32 E{F.x, (bf16*)(ws + WS_H1)};
        ConvHookT<2> H{&F, &conv_k, conv_il ? (odd ? 0x10ull : 0x01ull) : 0ull};
        pg8::gemm_phase<pg8::EpiResF32, pg8::DenseOrder, true, false, false, ConvHookT<2> >(F.lds + RING_OFF, S, E, DM * 2, DM * 2, DM * 2, H);
        if (BOTH(4)) GRID_BAR();
    } }

    if (IN(5)) { p5_router_mfma(F); if (EXPERTS_LATE) { if (conv_il) { if (conv_k < 8) conv_chunks<1>(F, conv_k, 8 - conv_k); } else p0_prologue(F, 2); } if (BOTH(5)) GRID_BAR(); }

    if (IN(6)) { _Pragma("unroll") for (int rep = 0; rep < 1 + ((PROBE_REP >> 6) & 1); ++rep) {
        const int NT = moe_tables(F);
        pg8::MoeOrder S{NT, 8, F.G, (int)blockIdx.x, (const LAS int*)(F.lds + L_TILEE), (const LAS int*)(F.lds + L_TOFF), (const LAS int*)(F.lds + L_CNT),
                        (const char*)(ws + WS_HN), (const char*)(ws + WS_WGU), (size_t)256 * DM * MOE_ES, (size_t)256 * DM * MOE_ES, (size_t)2048 * DM * MOE_ES, (const int*)(ws + WS_LIST), DM * MOE_ES, true, 1 + ((PROBE_REP >> 11) & 1)};
        pg8::EpiSwiglu E{F.b_gate_up, (unsigned char*)(ws + WS_ACT)};
        ConvHookT<1> H{&F, &conv_k, conv_il ? (odd ? 0x101010100ull : 0x010101010ull) : 0ull};
        pg8::gemm_phase<pg8::EpiSwiglu, pg8::MoeOrder, true, true, MOE_FP8, ConvHookT<1> >(F.lds + RING_OFF, S, E, DM * MOE_ES, DM * MOE_ES, DM * MOE_ES, H);
        if (conv_il) conv_chunks<1>(F, conv_k, 12);
        if (BOTH(6)) GRID_BAR();
    } }

    if (IN(7)) { _Pragma("unroll") for (int rep = 0; rep < 1 + ((PROBE_REP >> 7) & 1); ++rep) {
        const int NT = moe_tables(F);
        pg8::MoeOrder S{NT, 4, F.G, (int)blockIdx.x, (const LAS int*)(F.lds + L_TILEE), (const LAS int*)(F.lds + L_TOFF), (const LAS int*)(F.lds + L_CNT),
                        (const char*)(ws + WS_ACT), (const char*)(ws + WS_WD), (size_t)256 * DM * MOE_ES, (size_t)256 * DM * MOE_ES, (size_t)1024 * DM * MOE_ES, (const int*)(ws + WS_LIST), DM * MOE_ES, false, 1 + ((PROBE_REP >> 12) & 1)};
        pg8::EpiDown E{(bf16*)(ws + WS_YSLOT)};
        pg8::gemm_phase<pg8::EpiDown, pg8::MoeOrder, true, false, MOE_FP8>(F.lds + RING_OFF, S, E, DM * MOE_ES, DM * MOE_ES, DM * MOE_ES);
        if (BOTH(7)) GRID_BAR();
    } }

    if (IN(8)) { for (int rep = 0; rep < 1 + ((PROBE_REP >> 8) & 1); ++rep) p8_final(F); }
#undef IN
#undef BOTH
#undef GRID_BAR
}

extern "C" void kernel_launch(void* const* d_in, const int* in_sizes, int n_in, void* d_out, int out_size, void* d_ws, size_t ws_size, hipStream_t stream) {
    static int grid = 0;
    if (grid == 0) {
        if (n_in != 15 || in_sizes[0] != T_TOK * DM || out_size != T_TOK * DM || ws_size < WS_END) { fprintf(stderr, "kernel_launch: unexpected shapes (n_in %d, in0 %d, out %d, ws %zu); nothing launched\n", n_in, n_in > 0 ? in_sizes[0] : -1, out_size, ws_size); grid = -1; return; }
        int dev = 0, cus = 0, per_cu = 0;
        if (hipGetDevice(&dev) != hipSuccess || hipDeviceGetAttribute(&cus, hipDeviceAttributeMultiprocessorCount, dev) != hipSuccess) { grid = -1; return; }
        if (hipFuncSetAttribute((const void*)fwd_kernel, hipFuncAttributeMaxDynamicSharedMemorySize, LDS_BYTES) != hipSuccess) { fprintf(stderr, "kernel_launch: hipFuncSetAttribute failed\n"); grid = -1; return; }
        if (hipOccupancyMaxActiveBlocksPerMultiprocessor(&per_cu, (const void*)fwd_kernel, NWAVES * 64, LDS_BYTES) != hipSuccess || per_cu < 1) { fprintf(stderr, "kernel_launch: occupancy query reports %d workgroups per CU\n", per_cu); }
        (void)hipGetLastError();
        grid = cus;
    }
    if (grid < 0) return;
    if (hipMemsetAsync((char*)d_ws + WS_CTL, 0, CTL_ZERO_BYTES, stream) != hipSuccess) return;
    Args a{};
    for (int i = 0; i < 15; ++i) a.in[i] = (const float*)d_in[i];
    a.out = (float*)d_out; a.ws = (unsigned char*)d_ws;
    if (MK_N_LAUNCHES == 1) { a.ph_lo = 0; a.ph_hi = N_PHASES; hipLaunchKernelGGL(fwd_kernel, dim3(grid), dim3(NWAVES * 64), LDS_BYTES, stream, a); }
    else { for (int p = 0; p < N_PHASES; ++p) { a.ph_lo = p; a.ph_hi = p + 1; hipLaunchKernelGGL(fwd_kernel, dim3(grid), dim3(NWAVES * 64), LDS_BYTES, stream, a); } }
}
```

```cpp
#include <hip/hip_runtime.h>
#include <cstdio>
#include <cstdint>
#include <cmath>

#ifndef PROBE_REP
#define PROBE_REP 0
#endif
#ifndef EXPERTS_LATE
#define EXPERTS_LATE 1
#endif
#ifndef CONV_INTERLEAVE
#define CONV_INTERLEAVE 1
#endif
#ifndef MOE_KROT
#define MOE_KROT 2
#endif
#ifndef MK_N_LAUNCHES
#define MK_N_LAUNCHES 1
#endif

constexpr int T_TOK = 16384, DM = 1024, DIN = 5120, NEXP = 32, TOPK = 4, SEQ = 2048, NBATCH = 8, NHEAD = 8;
constexpr int QKV_LD = 3072, GATE_LD = 2048;
#ifndef MOE_FP8_SW
#define MOE_FP8_SW 1
#endif
constexpr bool MOE_FP8 = MOE_FP8_SW != 0;
constexpr int MOE_ES = MOE_FP8 ? 1 : 2;
constexpr float MOE_WSCALE = MOE_FP8 ? 64.0f : 1.0f, MOE_WINV = MOE_FP8 ? (1.0f / 64.0f) : 1.0f;
constexpr float C2F = 0.125f * 1.4426950408889634f;
constexpr float LOG2E = 1.4426950408889634f;
constexpr float RMS_EPS = 1e-6f;
constexpr int LIST_CAP = 16384;
constexpr int MAX_TILES = 288;

namespace pg8 {
#define PG8_LAS __attribute__((address_space(3)))
typedef unsigned short bf16_t;
typedef short bf16x8 __attribute__((ext_vector_type(8)));
typedef float f32x4 __attribute__((ext_vector_type(4)));
typedef float f32x2 __attribute__((ext_vector_type(2)));
typedef unsigned u32x4 __attribute__((ext_vector_type(4)));
typedef unsigned u32x2 __attribute__((ext_vector_type(2)));
constexpr int BM = 256, BK = 64, HALF = 128, HTB = HALF * BK * 2, STAGE_BYTES = 8 * HTB, NXCD = 8, WGM = 8;

__host__ __device__ __forceinline__ int lds_byte(int r, int c) { const int st = (r >> 4) * 2 + (c >> 5), rr = r & 15, cc = c & 31, ob = rr * 64 + cc * 2; return st * 1024 + (ob ^ (((ob >> 9) & 1) << 5)); }
__host__ __device__ __forceinline__ void stage_rc(int b, int& R, int& C) { const int st = b / 1024, sb = b % 1024, swz = sb ^ (((sb >> 9) & 1) << 5); R = (st >> 1) * 16 + swz / 64; C = (st & 1) * 32 + (swz % 64) / 2; }
__host__ __device__ __forceinline__ int perm32(int rho) { const int n = rho >> 4, i = rho & 15; return 8 * (i >> 2) + 4 * n + (i & 3); }

typedef int i32x8 __attribute__((ext_vector_type(8)));
typedef int i32x4 __attribute__((ext_vector_type(4)));
__device__ __forceinline__ i32x8 pk32(bf16x8 lo, bf16x8 hi) { const i32x4 a = __builtin_bit_cast(i32x4, lo), b = __builtin_bit_cast(i32x4, hi); return (i32x8){a[0], a[1], a[2], a[3], b[0], b[1], b[2], b[3]}; }
struct Unit { int pm, pn, e, aux, rot; };

__device__ __forceinline__ bool static_tile(int i, int G, int c, int nM, int nN, int& pm, int& pn) {
    const int nwg = nM * nN; const long L = (long)i * G + c; if (L >= nwg) return false;
    int wgid = (int)L; { const int q = nwg / NXCD, r = nwg % NXCD, xcd = wgid % NXCD, off = wgid / NXCD; wgid = (xcd < r ? xcd * (q + 1) : r * (q + 1) + (xcd - r) * q) + off; }
    const int nig = WGM * nN, gid = wgid / nig, fm = gid * WGM, gsz = (nM - fm) < WGM ? (nM - fm) : WGM;
    pm = fm + ((wgid % nig) % gsz); pn = (wgid % nig) / gsz; return true;
}

typedef __bf16 bf16x2_t __attribute__((ext_vector_type(2)));
__device__ __forceinline__ unsigned cvt_pk_bf16(float lo, float hi) { f32x2 v = {lo, hi}; bf16x2_t b = __builtin_convertvector(v, bf16x2_t); return __builtin_bit_cast(unsigned, b); }
__device__ __forceinline__ unsigned pk4_fp8(float a, float b, float c, float d) { int p = __builtin_amdgcn_cvt_pk_fp8_f32(a, b, 0, false); p = __builtin_amdgcn_cvt_pk_fp8_f32(c, d, p, true); return (unsigned)p; }
__device__ __forceinline__ float bf_lo(unsigned w) { return __uint_as_float(w << 16); }
__device__ __forceinline__ float bf_hi(unsigned w) { return __uint_as_float(w & 0xffff0000u); }

struct NoHook { __device__ __forceinline__ void operator()(int) const {} };
template <class Epi, class Sched, bool ALIGN_EPI, bool GATHER, bool FP8 = false, class Hook = NoHook>
__device__ __forceinline__ void gemm_phase(PG8_LAS unsigned char* lds, const Sched& S, const Epi& E, const int KB, const int ldaB, const int ldbB, const Hook& H = Hook()) {
    const int tid = threadIdx.x, wid = __builtin_amdgcn_readfirstlane(tid >> 6), lane = tid & 63, wr = wid >> 2, wc = wid & 3, fr = lane & 15, fq = lane >> 4;
    const int nt = KB / (BK * 2);
    unsigned voA[2][2], voN[2][2], voffB[2]; int RA[2], CA[2];
#pragma unroll
    for (int i = 0; i < 2; ++i) { int R, C; stage_rc(tid * 16 + i * 8192, R, C); const int Rb = Epi::PERM ? ((R & ~31) + perm32(R & 31)) : R;
        RA[i] = R; CA[i] = C; voffB[i] = (unsigned)(Rb * ldbB + C * 2);
#pragma unroll
        for (int h = 0; h < 2; ++h) voA[h][i] = (unsigned)((h * HALF + R) * ldaB + C * 2); }
    const size_t kstep = (size_t)(BK * 2);
    const size_t hstepB = (size_t)HALF * ldbB;
    const unsigned ldsw = (unsigned)wid * 1024u;
    const int aoff = lds_byte(wr * 64 + fr, fq * 8), boff = lds_byte(wc * 32 + fr, fq * 8);
#define PG8_SA(b, h) (((b) * 2 + (h)) * HTB)
#define PG8_SB(b, h) ((4 + (b) * 2 + (h)) * HTB)
#define PG8_STAGE(bufoff, gbase, voff) do { _Pragma("unroll") for (int _i = 0; _i < 2; ++_i) \
        __builtin_amdgcn_global_load_lds((const unsigned*)((const char*)(gbase) + (voff)[_i]), (PG8_LAS unsigned*)(lds + (bufoff) + ldsw + _i * 8192), 16, 0, 0); } while (0)
#define PG8_LD8(dst, off) do { const i32x4 _lo = *(const PG8_LAS i32x4*)(lds + (off)); const i32x4 _hi = *(const PG8_LAS i32x4*)(lds + (off) + 1024); dst = __builtin_shufflevector(_lo, _hi, 0, 1, 2, 3, 4, 5, 6, 7); } while (0)
#define PG8_LDA(dst, b, h) do { _Pragma("unroll") for (int m = 0; m < 4; ++m) PG8_LD8(dst[m], PG8_SA(b, h) + aoff + m * 2048); } while (0)
#define PG8_LDB(dst, b, h) do { _Pragma("unroll") for (int n = 0; n < 2; ++n) PG8_LD8(dst[n], PG8_SB(b, h) + boff + n * 2048); } while (0)
#define PG8_LO(x) __builtin_bit_cast(bf16x8, __builtin_shufflevector(x, x, 0, 1, 2, 3))
#define PG8_HI(x) __builtin_bit_cast(bf16x8, __builtin_shufflevector(x, x, 4, 5, 6, 7))
#define PG8_MMA(ai, bj, At, Bt) do { __builtin_amdgcn_s_setprio(1); _Pragma("unroll") for (int m = 0; m < 4; ++m) _Pragma("unroll") for (int n = 0; n < 2; ++n) { \
        if constexpr (FP8) { asm volatile("v_mfma_f32_16x16x128_f8f6f4 %0, %1, %2, %0" : "+v"(acc[ai][bj][m][n]) : "v"(Bt[n]), "v"(At[m])); } \
        else { acc[ai][bj][m][n] = __builtin_amdgcn_mfma_f32_16x16x32_bf16(PG8_LO(Bt[n]), PG8_LO(At[m]), acc[ai][bj][m][n], 0, 0, 0); \
               acc[ai][bj][m][n] = __builtin_amdgcn_mfma_f32_16x16x32_bf16(PG8_HI(Bt[n]), PG8_HI(At[m]), acc[ai][bj][m][n], 0, 0, 0); } } __builtin_amdgcn_s_setprio(0); } while (0)
#define PG8_WAIT_V(n) asm volatile("s_waitcnt vmcnt(" #n ")" ::: "memory")
#define PG8_WAIT_L(n) asm volatile("s_waitcnt lgkmcnt(" #n ")" ::: "memory")
#define PG8_BAR __builtin_amdgcn_s_barrier()
#define PG8_SCHED __builtin_amdgcn_sched_barrier(0)
    Unit cur, nxt; int ui = 0;
    H(0);
    if (!S.next(0, cur)) return;
    if constexpr (GATHER) S.a_rows(cur, RA, CA, voA);
#pragma unroll
    for (int h = 0; h < 2; ++h)
#pragma unroll
        for (int i = 0; i < 2; ++i) voN[h][i] = voA[h][i];
    f32x4 acc[2][2][4][2];
#pragma unroll
    for (int a = 0; a < 2; ++a)
#pragma unroll
        for (int b = 0; b < 2; ++b)
#pragma unroll
            for (int m = 0; m < 4; ++m)
#pragma unroll
                for (int n = 0; n < 2; ++n) acc[a][b][m][n] = (f32x4){0.f, 0.f, 0.f, 0.f};
    i32x8 At[4], B0[2], B1[2];
    const char* cA = S.a_base(cur); const char* cB = S.b_base(cur);
    const int ntm = nt - 1;
    { const size_t o0 = (size_t)(cur.rot & ntm) * kstep;
    PG8_STAGE(PG8_SB(0, 0), cB + o0, voffB); PG8_STAGE(PG8_SB(0, 1), cB + hstepB + o0, voffB); PG8_STAGE(PG8_SA(0, 0), cA + o0, voA[0]); PG8_STAGE(PG8_SA(0, 1), cA + o0, voA[1]); }
    if (wr == 1) PG8_BAR;
    PG8_WAIT_V(2); PG8_BAR;
    { const size_t o1 = (size_t)((cur.rot + 1) & ntm) * kstep;
    PG8_STAGE(PG8_SB(1, 0), cB + o1, voffB); PG8_STAGE(PG8_SA(1, 0), cA + o1, voA[0]); PG8_STAGE(PG8_SB(1, 1), cB + hstepB + o1, voffB); }
    PG8_WAIT_V(6); PG8_BAR;
    for (;;) {
        const bool has_next = S.next(ui + 1, nxt);
        const char* nA = has_next ? S.a_base(nxt) : cA; const char* nB = has_next ? S.b_base(nxt) : cB;
        if constexpr (GATHER) { if (has_next) S.a_rows(nxt, RA, CA, voN); }
#pragma unroll 1
        for (int t = 0; t < nt; t += 2) {
            const bool last = (t == nt - 2);
            const int nrot = has_next ? nxt.rot : cur.rot;
            const char* a1 = cA + (size_t)((t + 1 + cur.rot) & ntm) * kstep;
            const size_t o2 = last ? (size_t)(nrot & ntm) * kstep : (size_t)((t + 2 + cur.rot) & ntm) * kstep;
            const char* a2 = (last ? nA : cA) + o2; const char* b2 = (last ? nB : cB) + o2;
            const char* a3 = a2 + kstep; const char* b3 = b2 + kstep;
            unsigned v2[2][2];
#pragma unroll
            for (int h = 0; h < 2; ++h)
#pragma unroll
                for (int i = 0; i < 2; ++i) v2[h][i] = voA[h][i];
            if constexpr (GATHER) { if (last) { asm volatile("" : "+v"(voN[0][0]), "+v"(voN[0][1]), "+v"(voN[1][0]), "+v"(voN[1][1]));
#pragma unroll
                for (int h = 0; h < 2; ++h)
#pragma unroll
                    for (int i = 0; i < 2; ++i) v2[h][i] = voN[h][i]; } }
            PG8_LDB(B0, 0, 0); PG8_LDB(B1, 0, 1); PG8_SCHED; PG8_LDA(At, 0, 0); PG8_STAGE(PG8_SA(1, 1), a1, voA[1]);
            PG8_WAIT_V(8); PG8_WAIT_L(0); PG8_BAR; PG8_MMA(0, 0, At, B0); PG8_MMA(0, 1, At, B1); PG8_BAR; PG8_SCHED;
            PG8_LDA(At, 0, 1); PG8_STAGE(PG8_SB(0, 0), b2, voffB); PG8_STAGE(PG8_SB(0, 1), b2 + hstepB, voffB); PG8_STAGE(PG8_SA(0, 0), a2, v2[0]);
            PG8_WAIT_V(8); PG8_WAIT_L(0); PG8_BAR; PG8_MMA(1, 0, At, B0); PG8_MMA(1, 1, At, B1); PG8_BAR; PG8_SCHED;
            PG8_LDB(B0, 1, 0); PG8_LDB(B1, 1, 1); PG8_SCHED; PG8_LDA(At, 1, 0); PG8_STAGE(PG8_SA(0, 1), a2, v2[1]);
            PG8_WAIT_V(8); PG8_WAIT_L(0); PG8_BAR; PG8_MMA(0, 0, At, B0); PG8_MMA(0, 1, At, B1); PG8_BAR; PG8_SCHED;
            PG8_LDA(At, 1, 1); PG8_STAGE(PG8_SB(1, 0), b3, voffB); PG8_STAGE(PG8_SB(1, 1), b3 + hstepB, voffB); PG8_STAGE(PG8_SA(1, 0), a3, v2[0]);
            PG8_WAIT_V(8); PG8_WAIT_L(0); PG8_BAR; PG8_MMA(1, 0, At, B0); PG8_MMA(1, 1, At, B1); PG8_BAR; PG8_SCHED;
        }
        if constexpr (ALIGN_EPI) { if (wr == 0) PG8_BAR; }
        if constexpr (FP8) {
            asm volatile("s_nop 15\n\ts_nop 15" : "+v"(acc[0][0][0][0]), "+v"(acc[0][0][0][1]), "+v"(acc[0][0][1][0]), "+v"(acc[0][0][1][1]), "+v"(acc[0][0][2][0]), "+v"(acc[0][0][2][1]), "+v"(acc[0][0][3][0]), "+v"(acc[0][0][3][1]),
                         "+v"(acc[0][1][0][0]), "+v"(acc[0][1][0][1]), "+v"(acc[0][1][1][0]), "+v"(acc[0][1][1][1]), "+v"(acc[0][1][2][0]), "+v"(acc[0][1][2][1]), "+v"(acc[0][1][3][0]), "+v"(acc[0][1][3][1]));
            asm volatile("" : "+v"(acc[1][0][0][0]), "+v"(acc[1][0][0][1]), "+v"(acc[1][0][1][0]), "+v"(acc[1][0][1][1]), "+v"(acc[1][0][2][0]), "+v"(acc[1][0][2][1]), "+v"(acc[1][0][3][0]), "+v"(acc[1][0][3][1]),
                         "+v"(acc[1][1][0][0]), "+v"(acc[1][1][0][1]), "+v"(acc[1][1][1][0]), "+v"(acc[1][1][1][1]), "+v"(acc[1][1][2][0]), "+v"(acc[1][1][2][1]), "+v"(acc[1][1][3][0]), "+v"(acc[1][1][3][1])); }
        E(acc, cur, wr, wc, fr, fq);
        asm volatile("" ::: "memory"); PG8_SCHED;
        H(ui + 1);
        asm volatile("" ::: "memory"); PG8_SCHED;
        if (!has_next) break;
#pragma unroll
        for (int a = 0; a < 2; ++a)
#pragma unroll
            for (int b = 0; b < 2; ++b)
#pragma unroll
                for (int m = 0; m < 4; ++m)
#pragma unroll
                    for (int n = 0; n < 2; ++n) acc[a][b][m][n] = (f32x4){0.f, 0.f, 0.f, 0.f};
        cur = nxt; cA = nA; cB = nB; ++ui;
#pragma unroll
        for (int h = 0; h < 2; ++h)
#pragma unroll
            for (int i = 0; i < 2; ++i) voA[h][i] = voN[h][i];
        if constexpr (ALIGN_EPI) { if (wr == 1) PG8_BAR; }
    }
    PG8_WAIT_V(0);
    if constexpr (!ALIGN_EPI) { if (wr == 0) PG8_BAR; }
    PG8_BAR;
#undef PG8_SA
#undef PG8_SB
#undef PG8_STAGE
#undef PG8_LDA
#undef PG8_LDB
#undef PG8_LD8
#undef PG8_LO
#undef PG8_HI
#undef PG8_MMA
#undef PG8_WAIT_V
#undef PG8_WAIT_L
#undef PG8_BAR
#undef PG8_SCHED
}

__device__ __forceinline__ float sigmoidf_fast(float x) { return __builtin_amdgcn_rcpf(1.0f + __builtin_amdgcn_exp2f(-LOG2E * x)); }

struct EpiInProj {
    static constexpr bool PERM = true;
    bf16_t* qkv; bf16_t* gates; float* kpart;
    __device__ __forceinline__ void operator()(const f32x4 (&acc)[2][2][4][2], const Unit& u, int wr, int wc, int fr, int fq) const {
        const int row0 = u.pm * BM + wr * 64 + fr; const int pn = u.pn;
        const int cw = wc * 32 + 8 * fq;
        if (pn < 12) {
            const float sc = (pn < 2 || pn == 6 || pn == 7) ? C2F : 1.0f;
            bf16_t* base = qkv + pn * BM + cw;
#pragma unroll
            for (int ai = 0; ai < 2; ++ai)
#pragma unroll
                for (int m = 0; m < 4; ++m) { bf16_t* rowp = base + (size_t)(row0 + ai * HALF + m * 16) * QKV_LD;
#pragma unroll
                    for (int bj = 0; bj < 2; ++bj) { const f32x4 v0 = acc[ai][bj][m][0] * sc, v1 = acc[ai][bj][m][1] * sc;
                        u32x4 w; w.x = cvt_pk_bf16(v0[0], v0[1]); w.y = cvt_pk_bf16(v0[2], v0[3]); w.z = cvt_pk_bf16(v1[0], v1[1]); w.w = cvt_pk_bf16(v1[2], v1[3]);
                        *(u32x4*)(rowp + bj * HALF) = w; } }
            if (pn == 8 || pn == 9) {
#pragma unroll
                for (int bj = 0; bj < 2; ++bj)
#pragma unroll
                    for (int n = 0; n < 2; ++n) { f32x4 s = (f32x4){0.f, 0.f, 0.f, 0.f};
#pragma unroll
                        for (int ai = 0; ai < 2; ++ai)
#pragma unroll
                            for (int m = 0; m < 4; ++m) s += acc[ai][bj][m][n];
#pragma unroll
                        for (int o = 1; o < 16; o <<= 1) { s[0] += __shfl_xor(s[0], o); s[1] += __shfl_xor(s[1], o); s[2] += __shfl_xor(s[2], o); s[3] += __shfl_xor(s[3], o); }
                        if (fr == 0) *(f32x4*)(kpart + (size_t)(u.pm * 2 + wr) * 512 + (pn - 8) * BM + bj * HALF + cw + 4 * n) = s; }
            }
        } else {
            bf16_t* base = gates + (pn - 12) * BM + cw;
#pragma unroll
            for (int ai = 0; ai < 2; ++ai)
#pragma unroll
                for (int m = 0; m < 4; ++m) { bf16_t* rowp = base + (size_t)(row0 + ai * HALF + m * 16) * GATE_LD;
#pragma unroll
                    for (int bj = 0; bj < 2; ++bj) { const f32x4 a0 = acc[ai][bj][m][0], a1 = acc[ai][bj][m][1];
                        u32x4 w; w.x = cvt_pk_bf16(sigmoidf_fast(a0[0]), sigmoidf_fast(a0[1])); w.y = cvt_pk_bf16(sigmoidf_fast(a0[2]), sigmoidf_fast(a0[3]));
                        w.z = cvt_pk_bf16(sigmoidf_fast(a1[0]), sigmoidf_fast(a1[1])); w.w = cvt_pk_bf16(sigmoidf_fast(a1[2]), sigmoidf_fast(a1[3]));
                        *(u32x4*)(rowp + bj * HALF) = w; } }
        }
    }
};

struct EpiProjGate {
    static constexpr bool PERM = true;
    const bf16_t* gates; bf16_t* merged;
    __device__ __forceinline__ void operator()(const f32x4 (&acc)[2][2][4][2], const Unit& u, int wr, int wc, int fr, int fq) const {
        const int row0 = u.pm * BM + wr * 64 + fr; const int col0 = u.pn * BM + wc * 32 + 8 * fq; const int br = u.e;
#pragma unroll
        for (int ai = 0; ai < 2; ++ai)
#pragma unroll
            for (int m = 0; m < 4; ++m) { const size_t row = (size_t)(row0 + ai * HALF + m * 16);
#pragma unroll
                for (int bj = 0; bj < 2; ++bj) {
                    const u32x4 g = *(const u32x4*)(gates + row * GATE_LD + br * DM + col0 + bj * HALF);
                    f32x4 v0 = acc[ai][bj][m][0], v1 = acc[ai][bj][m][1];
                    v0[0] *= bf_lo(g.x); v0[1] *= bf_hi(g.x); v0[2] *= bf_lo(g.y); v0[3] *= bf_hi(g.y);
                    v1[0] *= bf_lo(g.z); v1[1] *= bf_hi(g.z); v1[2] *= bf_lo(g.w); v1[3] *= bf_hi(g.w);
                    bf16_t* op = merged + row * DM + col0 + bj * HALF;
                    if (br == 1) { const u32x4 p = *(const u32x4*)op;
                        v0[0] += bf_lo(p.x); v0[1] += bf_hi(p.x); v0[2] += bf_lo(p.y); v0[3] += bf_hi(p.y);
                        v1[0] += bf_lo(p.z); v1[1] += bf_hi(p.z); v1[2] += bf_lo(p.w); v1[3] += bf_hi(p.w); }
                    u32x4 w; w.x = cvt_pk_bf16(v0[0], v0[1]); w.y = cvt_pk_bf16(v0[2], v0[3]); w.z = cvt_pk_bf16(v1[0], v1[1]); w.w = cvt_pk_bf16(v1[2], v1[3]);
                    *(u32x4*)op = w; } }
    }
};

struct EpiResF32 {
    static constexpr bool PERM = false;
    const float* x; bf16_t* h1;
    __device__ __forceinline__ void operator()(const f32x4 (&acc)[2][2][4][2], const Unit& u, int wr, int wc, int fr, int fq) const {
        const int row0 = u.pm * BM + wr * 64 + fr; const int col0 = u.pn * BM + wc * 32 + 4 * fq;
#pragma unroll
        for (int ai = 0; ai < 2; ++ai)
#pragma unroll
            for (int m = 0; m < 4; ++m) { const size_t off = (size_t)(row0 + ai * HALF + m * 16) * DM + col0;
#pragma unroll
                for (int bj = 0; bj < 2; ++bj)
#pragma unroll
                    for (int n = 0; n < 2; ++n) { const f32x4 b = *(const f32x4*)(x + off + bj * HALF + n * 16); const f32x4 r = b + acc[ai][bj][m][n];
                        u32x2 w; w.x = cvt_pk_bf16(r[0], r[1]); w.y = cvt_pk_bf16(r[2], r[3]); *(u32x2*)(h1 + off + bj * HALF + n * 16) = w; } }
    }
};

struct EpiSwiglu {
    static constexpr bool PERM = true;
    const float* bgu; unsigned char* act;
    __device__ __forceinline__ void operator()(const f32x4 (&acc)[2][2][4][2], const Unit& u, int wr, int wc, int fr, int fq) const {
        const int row0 = u.pm * BM + wr * 64 + fr; const int f0 = u.pn * HALF + wc * 32 + 8 * fq;
        const float* bp = bgu + (size_t)u.e * 2048 + f0;
        const f32x4 bg0 = *(const f32x4*)(bp), bg1 = *(const f32x4*)(bp + 4), bu0 = *(const f32x4*)(bp + 1024), bu1 = *(const f32x4*)(bp + 1028);
#pragma unroll
        for (int ai = 0; ai < 2; ++ai)
#pragma unroll
            for (int m = 0; m < 4; ++m) { float y[8];
#pragma unroll
                for (int n = 0; n < 2; ++n)
#pragma unroll
                    for (int j = 0; j < 4; j += 2) {
                        const f32x2 bg = n ? (f32x2){bg1[j], bg1[j + 1]} : (f32x2){bg0[j], bg0[j + 1]}, bu = (n ? (f32x2){bu1[j], bu1[j + 1]} : (f32x2){bu0[j], bu0[j + 1]}) + 1.0f;
                        f32x2 g = (f32x2){acc[ai][0][m][n][j], acc[ai][0][m][n][j + 1]} * MOE_WINV + bg; g.x = fminf(g.x, 7.0f); g.y = fminf(g.y, 7.0f);
                        f32x2 u1 = (f32x2){acc[ai][1][m][n][j], acc[ai][1][m][n][j + 1]} * MOE_WINV + bu; u1.x = fminf(fmaxf(u1.x, -6.0f), 8.0f); u1.y = fminf(fmaxf(u1.y, -6.0f), 8.0f);
                        const f32x2 t = g * (-1.702f * LOG2E); f32x2 d; d.x = __builtin_amdgcn_exp2f(t.x); d.y = __builtin_amdgcn_exp2f(t.y); d = d + 1.0f;
                        f32x2 r; r.x = __builtin_amdgcn_rcpf(d.x); r.y = __builtin_amdgcn_rcpf(d.y);
                        const f32x2 yy = (u1 * g) * r; y[n * 4 + j] = yy.x; y[n * 4 + j + 1] = yy.y; }
                unsigned char* op = act + ((size_t)(row0 + ai * HALF + m * 16) * DM + f0) * MOE_ES;
                if constexpr (MOE_FP8) { u32x2 w; w.x = pk4_fp8(y[0], y[1], y[2], y[3]); w.y = pk4_fp8(y[4], y[5], y[6], y[7]); *(u32x2*)op = w; }
                else { u32x4 w; w.x = cvt_pk_bf16(y[0], y[1]); w.y = cvt_pk_bf16(y[2], y[3]); w.z = cvt_pk_bf16(y[4], y[5]); w.w = cvt_pk_bf16(y[6], y[7]); *(u32x4*)op = w; } }
    }
};

struct EpiDown {
    static constexpr bool PERM = true;
    bf16_t* ys;
    __device__ __forceinline__ void operator()(const f32x4 (&acc)[2][2][4][2], const Unit& u, int wr, int wc, int fr, int fq) const {
        const int row0 = u.pm * BM + wr * 64 + fr; const int col0 = u.pn * BM + wc * 32 + 8 * fq;
#pragma unroll
        for (int ai = 0; ai < 2; ++ai)
#pragma unroll
            for (int m = 0; m < 4; ++m) { bf16_t* rowp = ys + (size_t)(row0 + ai * HALF + m * 16) * DM + col0;
#pragma unroll
                for (int bj = 0; bj < 2; ++bj) { const f32x4 v0 = acc[ai][bj][m][0] * MOE_WINV, v1 = acc[ai][bj][m][1] * MOE_WINV;
                    u32x4 o; o.x = cvt_pk_bf16(v0[0], v0[1]); o.y = cvt_pk_bf16(v0[2], v0[3]); o.z = cvt_pk_bf16(v1[0], v1[1]); o.w = cvt_pk_bf16(v1[2], v1[3]);
                    *(u32x4*)(rowp + bj * HALF) = o; } }
    }
};

struct DenseOrder {
    int nM, nN, G, c; const char* A; const char* Bt; size_t astep, bstep;
    __device__ __forceinline__ bool next(int i, Unit& u) const { u.e = 0; u.aux = 0; u.rot = 0; return static_tile(i, G, c, nM, nN, u.pm, u.pn); }
    __device__ __forceinline__ const char* a_base(const Unit& u) const { return A + (size_t)u.pm * astep; }
    __device__ __forceinline__ const char* b_base(const Unit& u) const { return Bt + (size_t)u.pn * bstep; }
    __device__ __forceinline__ void a_rows(const Unit&, const int (&)[2], const int (&)[2], unsigned (&)[2][2]) const {}
};
struct ProjOrder {
    int G, c; const char* Y; const char* Wp;
    __device__ __forceinline__ bool next(int i, Unit& u) const { u.e = i & 1; u.aux = 0; u.rot = 0; return static_tile(i >> 1, G, c, T_TOK / BM, DM / BM, u.pm, u.pn); }
    __device__ __forceinline__ const char* a_base(const Unit& u) const { return Y + ((size_t)u.pm * BM * DM + u.e * 512) * 2; }
    __device__ __forceinline__ const char* b_base(const Unit& u) const { return Wp + ((size_t)u.pn * BM * DM + u.e * 512) * 2; }
    __device__ __forceinline__ void a_rows(const Unit&, const int (&)[2], const int (&)[2], unsigned (&)[2][2]) const {}
};
struct MoeOrder {
    int NT, nN, G, c; const PG8_LAS int* tile_e; const PG8_LAS int* tileoff; const PG8_LAS int* cnt;
    const char* A; const char* Bt; size_t astep, bstep, bexp; const int* list; int lda; bool gather;
    int rep;
    __device__ __forceinline__ bool next(int i, Unit& u) const { const int per = (NT * nN + G - 1) / G; if (i >= per * rep) return false; if (!static_tile(i % per, G, c, NT, nN, u.pm, u.pn)) return false; u.e = tile_e[u.pm]; u.aux = u.pm - tileoff[u.e]; u.rot = MOE_KROT * ((u.pm + u.pn) & 1); return true; }
    __device__ __forceinline__ const char* a_base(const Unit& u) const { return gather ? A : A + (size_t)u.pm * astep; }
    __device__ __forceinline__ const char* b_base(const Unit& u) const { return Bt + (size_t)u.e * bexp + (size_t)u.pn * bstep; }
    __device__ __forceinline__ void a_rows(const Unit& u, const int (&RA)[2], const int (&CA)[2], unsigned (&vo)[2][2]) const {
        const int n = cnt[u.e] - u.aux * BM; const int* lp = list + (size_t)u.e * LIST_CAP + u.aux * BM;
#pragma unroll
        for (int h = 0; h < 2; ++h)
#pragma unroll
            for (int i = 0; i < 2; ++i) { const int r = h * HALF + RA[i]; const int id = (r < n) ? lp[r] : 0; vo[h][i] = (unsigned)((id >> 2) * lda + CA[i] * 2); }
    }
};
}

namespace att {
typedef unsigned short bf16;
using bf16x8 = __attribute__((ext_vector_type(8))) short;
using s16x4 = __attribute__((ext_vector_type(4))) short;
using f32x16 = __attribute__((ext_vector_type(16))) float;
using u32x4 = __attribute__((ext_vector_type(4))) unsigned;
using f32x4 = __attribute__((ext_vector_type(4))) float;
constexpr int NW = 8, KVBLK = 64, NSLOT = 3, SLOTB = 8192, PITCH = QKV_LD;
constexpr int LDS_K = 0, LDS_V = NSLOT * SLOTB, LDS_WS = 2 * NSLOT * SLOTB, LDS_OST = LDS_WS + NW * 64 * 4, LDS_KM = LDS_OST + NW * 4096, LDS_LUT = LDS_KM + 2048, LDS_FLG = LDS_LUT + 512, LDS_BYTES = LDS_FLG + 64;
__device__ __forceinline__ int crow(int r, int hi) { return (r & 3) + 8 * (r >> 2) + 4 * hi; }
#define SBAR() __builtin_amdgcn_sched_barrier(0)
__device__ __forceinline__ void glds16(const void* gsrc, unsigned lds_dst) { unsigned keep;
    asm volatile("s_mov_b32 %0, m0\n\ts_mov_b32 m0, %2\n\ts_nop 0\n\tglobal_load_lds_dwordx4 %1, off\n\ts_mov_b32 m0, %0" : "=&s"(keep) : "v"(gsrc), "s"(lds_dst) : "memory"); }
typedef float f32x2_t __attribute__((ext_vector_type(2))); typedef __bf16 bf16x2_t __attribute__((ext_vector_type(2)));
__device__ __forceinline__ unsigned cvtpk_s(float lo, float hi) { f32x2_t v = {lo, hi}; bf16x2_t b = __builtin_convertvector(v, bf16x2_t); return __builtin_bit_cast(unsigned, b); }
#define WAIT_BAR(N) asm volatile("s_waitcnt vmcnt(" #N ") lgkmcnt(0)\n\ts_barrier" ::: "memory")
typedef __attribute__((address_space(3))) const char* lds_cptr;

__device__ __forceinline__ void qkt(f32x16& p0, f32x16& p1, lds_cptr Kslot, const bf16x8* qr, const f32x16& c0, int r32, int hi) {
    lds_cptr kb = Kslot + hi * 1024 + r32 * 16;
#pragma unroll
    for (int d0 = 0; d0 < 4; ++d0) {
        const bf16x8 b0 = *(const __attribute__((address_space(3))) bf16x8*)(kb + d0 * 2048);
        const bf16x8 b1 = *(const __attribute__((address_space(3))) bf16x8*)(kb + d0 * 2048 + 512);
        if (d0 == 0) { p0 = __builtin_amdgcn_mfma_f32_32x32x16_bf16(b0, qr[0], c0, 0, 0, 0); p1 = __builtin_amdgcn_mfma_f32_32x32x16_bf16(b1, qr[0], c0, 0, 0, 0); }
        else { p0 = __builtin_amdgcn_mfma_f32_32x32x16_bf16(b0, qr[d0], p0, 0, 0, 0); p1 = __builtin_amdgcn_mfma_f32_32x32x16_bf16(b1, qr[d0], p1, 0, 0, 0); } }
}
__device__ __forceinline__ void pv(f32x16* o, int vb, bf16x8 pa0, bf16x8 pa1, bf16x8 pa2, bf16x8 pa3) {
#pragma unroll
    for (int d0 = 0; d0 < 2; ++d0) { s16x4 lo[4], hi[4];
#pragma unroll
        for (int ks = 0; ks < 4; ++ks) {
            asm volatile("ds_read_b64_tr_b16 %0,%1 offset:%c2" : "=&v"(lo[ks]) : "v"(vb), "i"(d0 * 4096 + ks * 1024) : "memory");
            asm volatile("ds_read_b64_tr_b16 %0,%1 offset:%c2" : "=&v"(hi[ks]) : "v"(vb), "i"(d0 * 4096 + ks * 1024 + 512) : "memory"); }
        asm volatile("s_waitcnt lgkmcnt(0)" ::: "memory"); SBAR();
#define PK(k) (bf16x8){lo[k][0], lo[k][1], lo[k][2], lo[k][3], hi[k][0], hi[k][1], hi[k][2], hi[k][3]}
        o[d0] = __builtin_amdgcn_mfma_f32_32x32x16_bf16(pa0, PK(0), o[d0], 0, 0, 0);
        o[d0] = __builtin_amdgcn_mfma_f32_32x32x16_bf16(pa1, PK(1), o[d0], 0, 0, 0);
        o[d0] = __builtin_amdgcn_mfma_f32_32x32x16_bf16(pa2, PK(2), o[d0], 0, 0, 0);
        o[d0] = __builtin_amdgcn_mfma_f32_32x32x16_bf16(pa3, PK(3), o[d0], 0, 0, 0);
#undef PK
    }
}
__device__ __forceinline__ float swap32(float v, int hi) {
    auto rr = __builtin_amdgcn_permlane32_swap(__float_as_uint(v), __float_as_uint(v), false, false);
    return __uint_as_float(hi ? rr[0] : rr[1]);
}
__device__ __forceinline__ void store_o(const f32x16* o, const float* rs, bf16* Ow, int ldo, char* shm, int wid, int lane, int r32, int hi) {
    bf16* stg = (bf16*)(shm + LDS_OST) + wid * 2048;
#pragma unroll
    for (int r = 0; r < 16; ++r) { const int orow = crow(r, hi);
#pragma unroll
        for (int d0 = 0; d0 < 2; ++d0) { const float v = o[d0][r] * rs[r]; const unsigned u = __float_as_uint(v); stg[orow * 64 + d0 * 32 + r32] = (bf16)((u + 0x7fffu + ((u >> 16) & 1u)) >> 16); } }
    asm volatile("s_waitcnt lgkmcnt(0)" ::: "memory");
#pragma unroll
    for (int i = 0; i < 4; ++i) { const int row = i * 8 + (lane >> 3), ch = lane & 7; const u32x4 v = *(const u32x4*)(stg + row * 64 + ch * 8); *(u32x4*)(Ow + (long)row * ldo + ch * 8) = v; }
}
#define PKW(P, B) cvtpk_s(P[B], P[B + 1])

__device__ __forceinline__ void sb_unit(int b, int h, int qb, const bf16* QKV, bf16* Y, char* shm) {
    int tid = threadIdx.x; asm volatile("" : "+v"(tid));
    const int lane = tid & 63, r32 = lane & 31, hi = lane >> 5; const int wid = __builtin_amdgcn_readfirstlane(tid >> 6);
    const long rowbase = (long)b * SEQ; const int q0 = qb * 256;
    const bf16* Qw = QKV + (rowbase + q0 + wid * 32) * PITCH + h * 64;
    const bf16* Kh = QKV + rowbase * PITCH + 512 + h * 64; const bf16* Vh = QKV + rowbase * PITCH + 1024 + h * 64;
    const unsigned lds0 = (unsigned)(uintptr_t)shm;
    const lds_cptr shm3 = (lds_cptr)shm;
    volatile __attribute__((address_space(3))) unsigned* flg = (volatile __attribute__((address_space(3))) unsigned*)(shm3 + LDS_FLG);
    const bf16* ksrc = Kh + (long)lane * PITCH + wid * 8;
    const bf16* vsrc = Vh + (long)(16 * (wid & 3) + (lane >> 2)) * PITCH + (wid >> 2) * 32 + (lane & 3) * 8;
    const unsigned kdst = lds0 + LDS_K + wid * 1024, vdst = lds0 + LDS_V + wid * 1024;
#define DMA_KV(t, slot) do { glds16(ksrc + (long)(t) * KVBLK * PITCH, (unsigned)__builtin_amdgcn_readfirstlane(kdst + (slot))); glds16(vsrc + (long)(t) * KVBLK * PITCH, (unsigned)__builtin_amdgcn_readfirstlane(vdst + (slot))); } while (0)
    const int vb0 = (int)(lds0 + LDS_V) + ((lane >> 4) & 1) * 32 + (lane & 3) * 8 + (4 * hi + ((lane & 15) >> 2)) * 64;
    bf16x8 qr[4];
#pragma unroll
    for (int d0 = 0; d0 < 4; ++d0) qr[d0] = *reinterpret_cast<const bf16x8*>(&Qw[(long)r32 * PITCH + d0 * 16 + hi * 8]);
    if (lane == 0) flg[wid] = 0u;
    const int ktop = 4 * qb + 3;
    DMA_KV(ktop, 0); DMA_KV(ktop - 1, SLOTB);
    f32x16 o[2]; o[0] = f32x16{}; o[1] = f32x16{}; const f32x16 zero16 = f32x16{};
    float carry = 0.f;
    const int ktd = 4 * qb + (wid >> 1);
    const int qpos = q0 + wid * 32 + r32;
    bool wdone = false;
    int sl_cur = 0, sl_n1 = SLOTB, sl_n2 = 2 * SLOTB;
    for (int kt = ktop; ; --kt) {
        if (kt > 0) { WAIT_BAR(2); } else { WAIT_BAR(0); }
        { const u32x4 f0 = *(const __attribute__((address_space(3))) u32x4*)(shm3 + LDS_FLG), f1 = *(const __attribute__((address_space(3))) u32x4*)(shm3 + LDS_FLG + 16);
          const unsigned all = f0.x & f0.y & f0.z & f0.w & f1.x & f1.y & f1.z & f1.w;
          if (__builtin_amdgcn_readfirstlane(all) != 0u) break; }
        if (kt >= 2) DMA_KV(kt - 2, sl_n2);
        if (!wdone && kt <= ktd) {
            f32x16 p0, p1;
            qkt(p0, p1, shm3 + LDS_K + sl_cur, qr, zero16, r32, hi);
            const bool diag = (kt == ktd);
            int qk = qpos - 4 * hi - 64 * kt; asm volatile("" : "+v"(qk));
            float lk[32], ls[32];
#pragma unroll
            for (int i = 0; i < 32; ++i) { const float z = (i < 16) ? p0[i] : p1[i - 16];
                const float e = __builtin_amdgcn_exp2f(-__builtin_fabsf(z)); const float l2 = __builtin_amdgcn_logf(1.0f + e);
                const float sp = __builtin_fmaxf(z, 0.f) + l2;
                float nk = -sp, lsv = z - sp;
                if (diag) { const bool valid = (8 * (i >> 2) + (i & 3)) < qk; nk = valid ? nk : 0.f; lsv = valid ? lsv : -INFINITY; }
                lk[i] = nk; ls[i] = lsv; }
            float gs[8], pg[8], S[8];
#pragma unroll
            for (int g = 0; g < 8; ++g) { gs[g] = (lk[4 * g] + lk[4 * g + 1]) + (lk[4 * g + 2] + lk[4 * g + 3]); pg[g] = swap32(gs[g], hi); }
            S[7] = 0.f;
#pragma unroll
            for (int g = 6; g >= 0; --g) S[g] = S[g + 1] + (gs[g + 1] + pg[g + 1]);
            const float tot = S[0] + (gs[0] + pg[0]);
#pragma unroll
            for (int g = 0; g < 8; ++g) { float t = carry + S[g] + (hi ? 0.f : pg[g]);
#pragma unroll
                for (int j = 3; j >= 0; --j) { const int i = 4 * g + j; const float a = __builtin_amdgcn_exp2f(ls[i] + t); t += lk[i]; if (i < 16) p0[i] = a; else p1[i - 16] = a; } }
            carry += tot;
            u32x4 pw0, pw1, pw2, pw3;
            pw0 = (u32x4){PKW(p0, 0), PKW(p0, 2), PKW(p0, 4), PKW(p0, 6)}; pw1 = (u32x4){PKW(p0, 8), PKW(p0, 10), PKW(p0, 12), PKW(p0, 14)};
            pw2 = (u32x4){PKW(p1, 0), PKW(p1, 2), PKW(p1, 4), PKW(p1, 6)}; pw3 = (u32x4){PKW(p1, 8), PKW(p1, 10), PKW(p1, 12), PKW(p1, 14)};
            SBAR();
            pv(o, vb0 + sl_cur, __builtin_bit_cast(bf16x8, pw0), __builtin_bit_cast(bf16x8, pw1), __builtin_bit_cast(bf16x8, pw2), __builtin_bit_cast(bf16x8, pw3));
            wdone = __all(carry < -36.0f);
            if (wdone && lane == 0) flg[wid] = 1u;
        }
        if (kt == 0) break;
        { const int t_ = sl_cur; sl_cur = sl_n1; sl_n1 = sl_n2; sl_n2 = t_; }
    }
    float ones[16];
#pragma unroll
    for (int r = 0; r < 16; ++r) ones[r] = 1.0f;
    store_o(o, ones, Y + (rowbase + q0 + wid * 32) * DM + h * 64, DM, shm, wid, lane, r32, hi);
    WAIT_BAR(0);
#undef DMA_KV
}

constexpr int M_BUF = 32768, M_OST = 3 * M_BUF, M_WS = M_OST + NW * 4096, M_KM = M_WS + NW * 64 * 4, M_LUT = M_KM + 2048, M_BYTES = M_LUT + 512;
static_assert(M_BYTES <= 147456, "MoBA LDS map (SCRATCH_BYTES)");
__device__ __forceinline__ float max3f(float a, float b, float c) { return __builtin_fmaxf(__builtin_fmaxf(a, b), c); }
typedef short v4i16_t __attribute__((ext_vector_type(4)));
__device__ __forceinline__ s16x4 vtr(lds_cptr p) { return __builtin_bit_cast(s16x4, __builtin_amdgcn_ds_read_tr16_b64_v4i16((__attribute__((address_space(3))) v4i16_t*)p)); }
__device__ __forceinline__ void moba_unit(int b, int h, int qb, const bf16* QKV, bf16* Y, const float* kpart, const float* rel_bias, char* shm) {
    int tid = threadIdx.x; asm volatile("" : "+v"(tid));
    const int lane = tid & 63, r32 = lane & 31, hi = lane >> 5; const int wid = __builtin_amdgcn_readfirstlane(tid >> 6);
    const long rowbase = (long)b * SEQ; const int q0 = qb * 256;
    const bf16* Qw = QKV + (rowbase + q0 + wid * 32) * PITCH + 1536 + h * 64;
    const bf16* Kh = QKV + rowbase * PITCH + 2048 + h * 64; const bf16* Vh = QKV + rowbase * PITCH + 2560 + h * 64;
    const unsigned lds0 = (unsigned)(uintptr_t)shm;
    const lds_cptr shm3 = (lds_cptr)shm;
    __attribute__((address_space(3))) float* wsf = (__attribute__((address_space(3))) float*)(shm3 + M_WS) + wid * 64;
    __attribute__((address_space(3))) float* kmean = (__attribute__((address_space(3))) float*)(shm3 + M_KM);
    __attribute__((address_space(3))) float* lut = (__attribute__((address_space(3))) float*)(shm3 + M_LUT);
    const bf16* ksrc = Kh + (long)lane * PITCH + wid * 8;
    const bf16* vsrc = Vh + (long)(16 * (wid & 3) + (lane >> 2)) * PITCH + (wid >> 2) * 32 + (lane & 3) * 8;
    const unsigned kdst = lds0 + wid * 1024, vdst = lds0 + 16384 + wid * 1024;
#define TILE2(S, i) ((S) < 2 ? 4 * qb + 2 * (S) + (i) : 2 * ((S) - 2) + (i))
#define DMA2(S, bufo) do { _Pragma("unroll") for (int i_ = 0; i_ < 2; ++i_) { const long to_ = (long)TILE2(S, i_) * KVBLK * PITCH; \
        glds16(ksrc + to_, (unsigned)__builtin_amdgcn_readfirstlane(kdst + (bufo) + i_ * 8192)); glds16(vsrc + to_, (unsigned)__builtin_amdgcn_readfirstlane(vdst + (bufo) + i_ * 8192)); } } while (0)
    { const int j = tid >> 6, d = tid & 63; const float* kp = kpart + (size_t)((b * 8 + j) * 2) * 512 + h * 64 + d; kmean[j * 64 + d] = (kp[0] + kp[512]) * (1.0f / 256.0f);
      if (tid < 128) { const int n = tid; int bk; if (n < 16) bk = n; else { bk = 16 + (int)(logf((float)n * (1.0f / 16.0f)) / 2.0794415416798357f * 16.0f); bk = bk > 31 ? 31 : bk; }
          lut[n] = rel_bias[bk * NHEAD + h] * LOG2E; } }
    bf16x8 qr[4];
#pragma unroll
    for (int d0 = 0; d0 < 4; ++d0) qr[d0] = *reinterpret_cast<const bf16x8*>(&Qw[(long)r32 * PITCH + d0 * 16 + hi * 8]);
    const int NS = 2 + 2 * qb;
    DMA2(0, 0);
    float mhat = 0.f, l_reg = 0.f; f32x16 o[2]; o[0] = f32x16{}; o[1] = f32x16{};
    const int qpos = q0 + wid * 32 + r32; unsigned selmask = 0u; float bias31 = 0.f;
    f32x16 pA0 = f32x16{}, pA1 = f32x16{};
    const lds_cptr kp0 = shm3 + hi * 1024 + r32 * 16;
    const lds_cptr vp0 = shm3 + 16384 + ((lane >> 4) & 1) * 32 + (lane & 3) * 8 + (4 * hi + ((lane & 15) >> 2)) * 64;
    int bo_cur = 0, bo_nxt = M_BUF, bo_prv = 2 * M_BUF;
    int vprev = 0;
#define MOBA_TILE(kt, ko, own, HASPREV, FIRST) do { \
        s16x4 vlo[8], vhi[8]; bf16x8 kf[8]; \
        _Pragma("unroll") for (int j_ = 0; j_ < 4; ++j_) { kf[2 * j_] = *(const __attribute__((address_space(3))) bf16x8*)(kp0 + (ko) + j_ * 2048); kf[2 * j_ + 1] = *(const __attribute__((address_space(3))) bf16x8*)(kp0 + (ko) + j_ * 2048 + 512); } \
        const int dmin_ = (q0 + wid * 32) - (64 * (kt) + 63); const bool far_ = dmin_ >= 113; \
        float nb_ = -mhat; if (!(own)) nb_ = ((selmask >> ((kt) >> 2)) & 1u) ? nb_ : -INFINITY; if (far_) nb_ += bias31; \
        f32x16 C0, C1; _Pragma("unroll") for (int r_ = 0; r_ < 16; ++r_) { C0[r_] = nb_; C1[r_] = nb_; } \
        C0 = __builtin_amdgcn_mfma_f32_32x32x16_bf16(kf[0], qr[0], C0, 0, 0, 0); C1 = __builtin_amdgcn_mfma_f32_32x32x16_bf16(kf[1], qr[0], C1, 0, 0, 0); \
        C0 = __builtin_amdgcn_mfma_f32_32x32x16_bf16(kf[2], qr[1], C0, 0, 0, 0); C1 = __builtin_amdgcn_mfma_f32_32x32x16_bf16(kf[3], qr[1], C1, 0, 0, 0); \
        C0 = __builtin_amdgcn_mfma_f32_32x32x16_bf16(kf[4], qr[2], C0, 0, 0, 0); C1 = __builtin_amdgcn_mfma_f32_32x32x16_bf16(kf[5], qr[2], C1, 0, 0, 0); \
        C0 = __builtin_amdgcn_mfma_f32_32x32x16_bf16(kf[6], qr[3], C0, 0, 0, 0); C1 = __builtin_amdgcn_mfma_f32_32x32x16_bf16(kf[7], qr[3], C1, 0, 0, 0); \
        if (HASPREV) { _Pragma("unroll") for (int i_ = 0; i_ < 8; ++i_) { vlo[i_] = vtr(vp0 + vprev + ((i_ >> 2) * 4096 + (i_ & 3) * 1024)); vhi[i_] = vtr(vp0 + vprev + ((i_ >> 2) * 4096 + (i_ & 3) * 1024 + 512)); } } \
        u32x4 pw0, pw1, pw2, pw3; \
        if (HASPREV) { float sa_ = 0.f, sb_ = 0.f; _Pragma("unroll") for (int r_ = 0; r_ < 16; ++r_) { sa_ += pA0[r_]; sb_ += pA1[r_]; } l_reg += sa_ + sb_; \
            pw0 = (u32x4){PKW(pA0, 0), PKW(pA0, 2), PKW(pA0, 4), PKW(pA0, 6)}; pw1 = (u32x4){PKW(pA0, 8), PKW(pA0, 10), PKW(pA0, 12), PKW(pA0, 14)}; \
            pw2 = (u32x4){PKW(pA1, 0), PKW(pA1, 2), PKW(pA1, 4), PKW(pA1, 6)}; pw3 = (u32x4){PKW(pA1, 8), PKW(pA1, 10), PKW(pA1, 12), PKW(pA1, 14)}; \
            asm volatile("" : "+v"(pw0), "+v"(pw1), "+v"(pw2), "+v"(pw3), "+v"(l_reg));     \
            __builtin_amdgcn_sched_group_barrier(0x100, 8, 0); __builtin_amdgcn_sched_group_barrier(0x002, 32, 0); \
            _Pragma("unroll") for (int g_ = 0; g_ < 8; ++g_) { __builtin_amdgcn_sched_group_barrier(0x008, 1, 0); __builtin_amdgcn_sched_group_barrier(0x002, 6, 0); __builtin_amdgcn_sched_group_barrier(0x100, 2, 0); } } \
        if (!far_) { int qk_ = qpos - 4 * hi - 64 * (kt); asm volatile("" : "+v"(qk_)); \
            _Pragma("unroll") for (int i_ = 0; i_ < 32; ++i_) { const int dist_ = qk_ - (8 * (i_ >> 2) + (i_ & 3)); const int dc_ = dist_ < 0 ? 0 : (dist_ > 127 ? 127 : dist_); \
                const float bb_ = lut[dc_]; float x_ = (i_ < 16) ? C0[i_ & 15] : C1[i_ & 15]; x_ = (dist_ < 0) ? -INFINITY : x_ + bb_; if (i_ < 16) C0[i_ & 15] = x_; else C1[i_ & 15] = x_; \
                if ((i_ & 7) == 7) asm volatile("" ::: "memory"); } } \
        float ra_ = max3f(C0[0], C0[1], C1[0]), rb_ = max3f(C0[2], C0[3], C1[1]); ra_ = max3f(ra_, C1[2], C1[3]); \
        _Pragma("unroll") for (int r_ = 4; r_ < 16; r_ += 4) { ra_ = max3f(ra_, C0[r_], C0[r_ + 1]); rb_ = max3f(rb_, C0[r_ + 2], C0[r_ + 3]); ra_ = max3f(ra_, C1[r_], C1[r_ + 1]); rb_ = max3f(rb_, C1[r_ + 2], C1[r_ + 3]); } \
        float rm_ = __builtin_fmaxf(ra_, rb_); rm_ = __builtin_fmaxf(rm_, swap32(rm_, hi)); \
        bool resc_ = false; \
        if (__builtin_expect((FIRST) || __any(rm_ > 8.0f), 0)) { const float dl_ = (FIRST) ? rm_ : __builtin_fmaxf(rm_, 0.f); mhat += dl_; \
            _Pragma("unroll") for (int r_ = 0; r_ < 16; ++r_) { asm volatile("v_sub_f32 %0, %0, %1" : "+v"(C0[r_]) : "v"(dl_)); asm volatile("v_sub_f32 %0, %0, %1" : "+v"(C1[r_]) : "v"(dl_)); } \
            if (!(FIRST)) { const float f_ = __builtin_amdgcn_exp2f(-dl_); l_reg *= f_; if (hi == 0) wsf[r32] = f_; resc_ = true; } } \
        if (HASPREV) { asm volatile("" : "+v"(pw0), "+v"(pw1), "+v"(pw2), "+v"(pw3));     \
            o[0] = __builtin_amdgcn_mfma_f32_32x32x16_bf16(__builtin_bit_cast(bf16x8, pw0), (bf16x8){vlo[0][0], vlo[0][1], vlo[0][2], vlo[0][3], vhi[0][0], vhi[0][1], vhi[0][2], vhi[0][3]}, o[0], 0, 0, 0); \
            o[1] = __builtin_amdgcn_mfma_f32_32x32x16_bf16(__builtin_bit_cast(bf16x8, pw0), (bf16x8){vlo[4][0], vlo[4][1], vlo[4][2], vlo[4][3], vhi[4][0], vhi[4][1], vhi[4][2], vhi[4][3]}, o[1], 0, 0, 0); \
            o[0] = __builtin_amdgcn_mfma_f32_32x32x16_bf16(__builtin_bit_cast(bf16x8, pw1), (bf16x8){vlo[1][0], vlo[1][1], vlo[1][2], vlo[1][3], vhi[1][0], vhi[1][1], vhi[1][2], vhi[1][3]}, o[0], 0, 0, 0); \
            o[1] = __builtin_amdgcn_mfma_f32_32x32x16_bf16(__builtin_bit_cast(bf16x8, pw1), (bf16x8){vlo[5][0], vlo[5][1], vlo[5][2], vlo[5][3], vhi[5][0], vhi[5][1], vhi[5][2], vhi[5][3]}, o[1], 0, 0, 0); \
            o[0] = __builtin_amdgcn_mfma_f32_32x32x16_bf16(__builtin_bit_cast(bf16x8, pw2), (bf16x8){vlo[2][0], vlo[2][1], vlo[2][2], vlo[2][3], vhi[2][0], vhi[2][1], vhi[2][2], vhi[2][3]}, o[0], 0, 0, 0); \
            o[1] = __builtin_amdgcn_mfma_f32_32x32x16_bf16(__builtin_bit_cast(bf16x8, pw2), (bf16x8){vlo[6][0], vlo[6][1], vlo[6][2], vlo[6][3], vhi[6][0], vhi[6][1], vhi[6][2], vhi[6][3]}, o[1], 0, 0, 0); \
            o[0] = __builtin_amdgcn_mfma_f32_32x32x16_bf16(__builtin_bit_cast(bf16x8, pw3), (bf16x8){vlo[3][0], vlo[3][1], vlo[3][2], vlo[3][3], vhi[3][0], vhi[3][1], vhi[3][2], vhi[3][3]}, o[0], 0, 0, 0); \
            o[1] = __builtin_amdgcn_mfma_f32_32x32x16_bf16(__builtin_bit_cast(bf16x8, pw3), (bf16x8){vlo[7][0], vlo[7][1], vlo[7][2], vlo[7][3], vhi[7][0], vhi[7][1], vhi[7][2], vhi[7][3]}, o[1], 0, 0, 0); } \
        _Pragma("unroll") for (int r_ = 0; r_ < 16; ++r_) { pA0[r_] = __builtin_amdgcn_exp2f(C0[r_]); pA1[r_] = __builtin_amdgcn_exp2f(C1[r_]); } \
        if (HASPREV) { _Pragma("unroll") for (int g_ = 0; g_ < 8; ++g_) { __builtin_amdgcn_sched_group_barrier(0x008, 1, 0); __builtin_amdgcn_sched_group_barrier(0x400, 4, 0); } } \
        if (resc_) { asm volatile("s_waitcnt lgkmcnt(0)" ::: "memory"); \
            _Pragma("unroll") for (int r_ = 0; r_ < 16; ++r_) { const float fr_ = wsf[crow(r_, hi)]; o[0][r_] *= fr_; o[1][r_] *= fr_; } } \
    } while (0)
#pragma unroll 1
    for (int S = 0; S < NS; ++S) {
        WAIT_BAR(0);
        if (S + 1 < NS) DMA2(S + 1, bo_nxt);
        if (S == 0) {
            bias31 = lut[127];
            __attribute__((address_space(3))) float* gsh = (__attribute__((address_space(3))) float*)(shm3 + 2 * M_BUF) + wid * 1024;
#pragma unroll 1
            for (int j = 0; j < qb; ++j) { float a = 0.f;
#pragma unroll
                for (int d0 = 0; d0 < 4; ++d0) { const f32x4 k0 = *(const __attribute__((address_space(3))) f32x4*)(kmean + j * 64 + d0 * 16 + hi * 8), k1 = *(const __attribute__((address_space(3))) f32x4*)(kmean + j * 64 + d0 * 16 + hi * 8 + 4);
                    const bf16x8 q = qr[d0];
                    a += __uint_as_float((unsigned)(unsigned short)q[0] << 16) * k0[0] + __uint_as_float((unsigned)(unsigned short)q[1] << 16) * k0[1] + __uint_as_float((unsigned)(unsigned short)q[2] << 16) * k0[2] + __uint_as_float((unsigned)(unsigned short)q[3] << 16) * k0[3]
                       + __uint_as_float((unsigned)(unsigned short)q[4] << 16) * k1[0] + __uint_as_float((unsigned)(unsigned short)q[5] << 16) * k1[1] + __uint_as_float((unsigned)(unsigned short)q[6] << 16) * k1[2] + __uint_as_float((unsigned)(unsigned short)q[7] << 16) * k1[3]; }
                gsh[j * 64 + lane] = a + swap32(a, hi); }
            asm volatile("s_waitcnt lgkmcnt(0)" ::: "memory");
            float g[8];
#pragma unroll
            for (int j = 0; j < 8; ++j) { g[j] = -INFINITY; if (j < qb) g[j] = gsh[j * 64 + lane]; }
#pragma unroll
            for (int j = 0; j < 8; ++j) if (j < qb) { int rank = 0;
#pragma unroll
                for (int i = 0; i < 8; ++i) if (i != j && i < qb) rank += (g[i] > g[j] || (g[i] == g[j] && i < j)) ? 1 : 0;
                if (rank < 3) selmask |= 1u << j; }
            asm volatile("s_waitcnt lgkmcnt(0)" ::: "memory");
            { const int kt0 = TILE2(0, 0), kt1 = TILE2(0, 1);
              MOBA_TILE(kt0, bo_cur, true, false, true); vprev = bo_cur;
              MOBA_TILE(kt1, bo_cur + 8192, true, true, false); vprev = bo_cur + 8192; }
        } else {
            const bool own = S < 2; const int kt0 = TILE2(S, 0), kt1 = TILE2(S, 1);
            MOBA_TILE(kt0, bo_cur, own, true, false); vprev = bo_cur;
            MOBA_TILE(kt1, bo_cur + 8192, own, true, false); vprev = bo_cur + 8192;
        }
        { const int t_ = bo_prv; bo_prv = bo_cur; bo_cur = bo_nxt; bo_nxt = t_; }
    }
    int tid_e = threadIdx.x; asm volatile("" : "+v"(tid_e));
    const int lane_e = tid_e & 63, r32_e = lane_e & 31, hi_e = lane_e >> 5; const int wid_e = __builtin_amdgcn_readfirstlane(tid_e >> 6);
    __attribute__((address_space(3))) float* wsf_e = (__attribute__((address_space(3))) float*)(shm3 + M_WS) + wid_e * 64;
    { float sa = 0.f, sb = 0.f;
#pragma unroll
      for (int r = 0; r < 16; ++r) { sa += pA0[r]; sb += pA1[r]; }
      l_reg += sa + sb;
      u32x4 pw0, pw1, pw2, pw3;
      pw0 = (u32x4){PKW(pA0, 0), PKW(pA0, 2), PKW(pA0, 4), PKW(pA0, 6)}; pw1 = (u32x4){PKW(pA0, 8), PKW(pA0, 10), PKW(pA0, 12), PKW(pA0, 14)};
      pw2 = (u32x4){PKW(pA1, 0), PKW(pA1, 2), PKW(pA1, 4), PKW(pA1, 6)}; pw3 = (u32x4){PKW(pA1, 8), PKW(pA1, 10), PKW(pA1, 12), PKW(pA1, 14)};
      SBAR();
      pv(o, (int)((unsigned)(uintptr_t)shm + 16384) + vprev + ((lane_e >> 4) & 1) * 32 + (lane_e & 3) * 8 + (4 * hi_e + ((lane_e & 15) >> 2)) * 64, __builtin_bit_cast(bf16x8, pw0), __builtin_bit_cast(bf16x8, pw1), __builtin_bit_cast(bf16x8, pw2), __builtin_bit_cast(bf16x8, pw3)); }
    l_reg += swap32(l_reg, hi_e);
    if (hi_e == 0) wsf_e[32 + r32_e] = l_reg; asm volatile("s_waitcnt lgkmcnt(0)" ::: "memory");
    float rli[16];
#pragma unroll
    for (int r = 0; r < 16; ++r) rli[r] = __builtin_amdgcn_rcpf(wsf_e[32 + crow(r, hi_e)]);
    store_o(o, rli, Y + ((long)b * SEQ + qb * 256 + wid_e * 32) * DM + 512 + h * 64, DM, shm + (M_OST - LDS_OST), wid_e, lane_e, r32_e, hi_e);
    WAIT_BAR(0);
#undef MOBA_TILE
#undef DMA2
#undef TILE2
}
#undef PKW
#undef SBAR
#undef WAIT_BAR
}

constexpr size_t MiB = 1u << 20;
constexpr size_t WS_CTL = 0, CTL_ZERO_BYTES = 1 * MiB;
constexpr size_t WS_WIN = 2 * MiB;
constexpr size_t WS_WPROJ = 12 * MiB;
constexpr size_t WS_WOUT = 14 * MiB;
constexpr size_t WS_WGU = 16 * MiB;
constexpr size_t WS_WD = 144 * MiB;
constexpr size_t WS_XN = 208 * MiB;
constexpr size_t WS_QKV = 240 * MiB;
constexpr size_t WS_GATES = 336 * MiB;
constexpr size_t WS_Y = 400 * MiB;
constexpr size_t WS_MERGED = 432 * MiB;
constexpr size_t WS_H1 = 464 * MiB;
constexpr size_t WS_HN = 528 * MiB;
constexpr size_t WS_ACT = 560 * MiB;
constexpr size_t WS_YSLOT = 704 * MiB;
constexpr size_t WS_LIST = 848 * MiB;
constexpr size_t WS_TOPW = 850 * MiB;
constexpr size_t WS_KPART = 851 * MiB;
constexpr size_t WS_TOKENT = 852 * MiB;
constexpr size_t WS_END = 853 * MiB;
constexpr int CW_TMO = 0, CW_CODE = 1;
constexpr int CW_CNT = 8192;
constexpr int CW_BAR = 4096;

constexpr int RING_OFF = 0, RING_BYTES = 131072;
constexpr int SCRATCH_BYTES = 147456;
constexpr int LDSCTL_OFF = SCRATCH_BYTES;
constexpr int L_MISC = LDSCTL_OFF;
constexpr int L_CNT = LDSCTL_OFF + 128;
constexpr int L_TOFF = LDSCTL_OFF + 256;
constexpr int L_TILEE = LDSCTL_OFF + 512;
constexpr int L_HIST = LDSCTL_OFF + 2048;
constexpr int L_BASE = LDSCTL_OFF + 2176;
constexpr int L_TMP = LDSCTL_OFF + 2304;
constexpr int LDS_BYTES = LDSCTL_OFF + 8192;
constexpr int NWAVES = 8;

#define GAS __attribute__((address_space(1)))
#define LAS __attribute__((address_space(3)))
typedef unsigned short bf16;
typedef unsigned v4u __attribute__((ext_vector_type(4)));
typedef unsigned v2u __attribute__((ext_vector_type(2)));
typedef float f32x4 __attribute__((ext_vector_type(4)));
typedef GAS unsigned gu32;
#define RLX_AGENT __ATOMIC_RELAXED, __HIP_MEMORY_SCOPE_AGENT
#define LDS_WAIT() asm volatile("s_waitcnt lgkmcnt(0)" ::: "memory")
__device__ __forceinline__ unsigned f2bf(float f) { unsigned u = __builtin_bit_cast(unsigned, f); return (u + 0x7fffu + ((u >> 16) & 1u)) >> 16; }
__device__ __forceinline__ unsigned pk2(float lo, float hi) { return f2bf(lo) | (f2bf(hi) << 16); }

#define XB_TMO      128
#define XB_XCNT(j)  (256  + 64 * (j))
#define XB_XSUB(j)  (1280 + 64 * (j))
#define XB_XGEN(j)  (2304 + 64 * (j))
#define XB_TOP      3328
#define XB_TOPGEN   3392
#define XCD_BAR_WORDS 3456
#define XB_SPIN_CAP (1u << 18)
__device__ __forceinline__ unsigned xb_ld(unsigned* p)              { return __hip_atomic_load(p, __ATOMIC_RELAXED, __HIP_MEMORY_SCOPE_AGENT); }
__device__ __forceinline__ unsigned xb_add(unsigned* p, unsigned v) { return __hip_atomic_fetch_add(p, v, __ATOMIC_RELAXED, __HIP_MEMORY_SCOPE_AGENT); }
__device__ __forceinline__ unsigned xb_xcc_id() { return (unsigned)__builtin_amdgcn_s_getreg((3 << 11) | 20) & 0xFu; }
#define XB_SPIN(cond, bar) do { unsigned _sp = 0; while (cond) { __builtin_amdgcn_s_sleep(1); \
    if ((++_sp & 255u) == 0u) { if (xb_ld(&(bar)[XB_TMO])) break; if (_sp > XB_SPIN_CAP) { atomicAdd(&(bar)[XB_TMO], 1u); break; } } } } while (0)
struct XcdBarrier { unsigned* bar; unsigned x; volatile LAS unsigned* st; };
__device__ __forceinline__ XcdBarrier xcd_barrier_post(unsigned* bar, volatile LAS unsigned* st) {
    XcdBarrier b; b.bar = bar; b.x = xb_xcc_id(); b.st = st;
    if (threadIdx.x == 0) (void)xb_add(&bar[XB_XCNT(b.x)], 1u);
    return b;
}
__device__ __forceinline__ void xcd_barrier_complete(unsigned* bar, unsigned x, unsigned& nloc, unsigned& nx) {
    const unsigned G = gridDim.x * gridDim.y * gridDim.z;
    unsigned sum, cnt, mine, sp = 0u;
    for (;;) {
        sum = 0u; cnt = 0u; mine = 0u;
#pragma unroll
        for (unsigned j = 0; j < 16; ++j) { const unsigned c = xb_ld(&bar[XB_XCNT(j)]); sum += c; cnt += (c > 0u) ? 1u : 0u; mine = (j == x) ? c : mine; }
        if (sum == G) break;
        __builtin_amdgcn_s_sleep(1);
        if ((++sp & 255u) == 0u) { if (xb_ld(&bar[XB_TMO])) break; if (sp > XB_SPIN_CAP) { atomicAdd(&bar[XB_TMO], 1u); break; } }
    }
    nloc = mine > 0u ? mine : 1u; nx = cnt > 0u ? cnt : 1u;
}
__device__ __forceinline__ void xcd_barrier(const XcdBarrier& b) {
    asm volatile("s_waitcnt vmcnt(0)" ::: "memory");
    __syncthreads();
    if (threadIdx.x == 0) {
        unsigned* bar = b.bar;
        __builtin_amdgcn_s_waitcnt(0);
        unsigned nloc = b.st[0], nx = b.st[1];
        if (nloc == 0u) { xcd_barrier_complete(bar, b.x, nloc, nx); b.st[0] = nloc; b.st[1] = nx; }
        const unsigned old = xb_add(&bar[XB_XSUB(b.x)], 1u);
        const unsigned gen = old / nloc;
        if (old + 1u == (gen + 1u) * nloc) {
            __builtin_amdgcn_fence(__ATOMIC_RELEASE, "agent");
            asm volatile("s_waitcnt vmcnt(0)" ::: "memory");
            const unsigned og = xb_add(&bar[XB_TOP], 1u);
            const unsigned tg = og / nx;
            if (og + 1u == (tg + 1u) * nx) xb_add(&bar[XB_TOPGEN], 1u);
            else XB_SPIN(xb_ld(&bar[XB_TOPGEN]) == tg, bar);
            __builtin_amdgcn_fence(__ATOMIC_ACQUIRE, "agent");
            xb_add(&bar[XB_XGEN(b.x)], 1u);
            asm volatile("s_waitcnt vmcnt(0)" ::: "memory");
        } else {
            XB_SPIN(xb_ld(&bar[XB_XGEN(b.x)]) == gen, bar);
            __builtin_amdgcn_fence(__ATOMIC_ACQUIRE, "agent");
            asm volatile("s_waitcnt vmcnt(0)" ::: "memory");
        }
    }
    __syncthreads();
}

struct Frame {
    LAS unsigned char* lds; gu32* ctl; int tid, lane, wave, vcu, G;
    const float *x, *norm_mix_g, *w_in, *w_proj_sb, *w_proj_moba, *w_out, *rel_bias, *norm_ffn_g, *w_router, *b_router, *w_gate_up, *b_gate_up, *w_down, *b_down, *norm_final_g;
    float* out; unsigned char* ws;
};
__device__ __forceinline__ float wave_sum(float v) {
#pragma unroll
    for (int o = 1; o < 64; o <<= 1) v += __shfl_xor(v, o);
    return v;
}
template <bool FP8> struct P0Item { const float* src; unsigned char* dst; int ldw, ldtB; float scale; };
template <bool FP8>
__device__ __forceinline__ P0Item<FP8> p0_mk(const float* W, int ldw, int k0, int n0, unsigned char* WT, int ldtB, int dst_row0, int kdstB, int lane, float scale) {
    constexpr int KL = FP8 ? 16 : 8; const int lk = lane >> 3, ln = lane & 7;
    P0Item<FP8> it; it.src = W + (size_t)(k0 + KL * lk) * ldw + n0 + 4 * ln; it.dst = WT + (size_t)(dst_row0 + 4 * ln) * ldtB + kdstB + (size_t)(k0 + KL * lk) * (FP8 ? 1 : 2); it.ldw = ldw; it.ldtB = ldtB; it.scale = scale; return it;
}
template <bool FP8, int KL>
__device__ __forceinline__ void p0_load(const P0Item<FP8>& it, f32x4 (&v)[KL]) {
    const GAS f32x4* src = (const GAS f32x4*)it.src;
#pragma unroll
    for (int i = 0; i < KL; ++i) v[i] = __builtin_nontemporal_load(src + (size_t)i * (it.ldw / 4));
}
template <bool FP8, int KL>
__device__ __forceinline__ void p0_store(const P0Item<FP8>& it, const f32x4 (&v)[KL]) {
    const float scale = it.scale;
#pragma unroll
    for (int j = 0; j < 4; ++j) { v4u o;
        if constexpr (FP8) { o.x = pg8::pk4_fp8(v[0][j] * scale, v[1][j] * scale, v[2][j] * scale, v[3][j] * scale); o.y = pg8::pk4_fp8(v[4][j] * scale, v[5][j] * scale, v[6][j] * scale, v[7][j] * scale);
            o.z = pg8::pk4_fp8(v[8][j] * scale, v[9][j] * scale, v[10][j] * scale, v[11][j] * scale); o.w = pg8::pk4_fp8(v[12][j] * scale, v[13][j] * scale, v[14][j] * scale, v[15][j] * scale); }
        else { o.x = pg8::cvt_pk_bf16(v[0][j], v[1][j]); o.y = pg8::cvt_pk_bf16(v[2][j], v[3][j]); o.z = pg8::cvt_pk_bf16(v[4][j], v[5][j]); o.w = pg8::cvt_pk_bf16(v[6][j], v[7][j]); }
        *(GAS v4u*)(it.dst + (size_t)j * it.ldtB) = o; }
}
template <bool FP8>
__device__ __forceinline__ void p0_item(const float* W, int ldw, int k0, int n0, unsigned char* WT, int ldtB, int dst_row0, int kdstB, int lane, float scale) {
    constexpr int KL = FP8 ? 16 : 8;
    const P0Item<FP8> it = p0_mk<FP8>(W, ldw, k0, n0, WT, ldtB, dst_row0, kdstB, lane, scale);
    f32x4 v[KL]; p0_load<FP8, KL>(it, v); p0_store<FP8, KL>(it, v);
}
constexpr int EX_KI = MOE_FP8 ? 128 : 64;
constexpr int EX_GU_PER = (1024 / EX_KI) * 64, EX_D_PER = (1024 / EX_KI) * 32, EX_I_GU = 32 * EX_GU_PER, EX_I_D = 32 * EX_D_PER, EX_ITEMS = EX_I_GU + EX_I_D;
__device__ __forceinline__ P0Item<MOE_FP8> expert_item(Frame& F, int r) {
    unsigned char* WGU = F.ws + WS_WGU; unsigned char* WD = F.ws + WS_WD;
    if (r < EX_I_GU) { const int e = r / EX_GU_PER, q = r % EX_GU_PER, kb = q >> 6, nb = q & 63, n0 = 32 * nb;
        const int cc = n0 & 1023, drow = (cc >> 7) * 256 + (n0 >= 1024 ? 128 : 0) + (cc & 127);
        return p0_mk<MOE_FP8>(F.w_gate_up + (size_t)e * 1024 * 2048, 2048, EX_KI * kb, n0, WGU + (size_t)e * 2048 * 1024 * MOE_ES, 1024 * MOE_ES, drow, 0, F.lane, MOE_WSCALE); }
    r -= EX_I_GU; const int e = r / EX_D_PER, q = r % EX_D_PER, kb = q >> 5, nb = q & 31;
    return p0_mk<MOE_FP8>(F.w_down + (size_t)e * 1024 * 1024, 1024, EX_KI * kb, 32 * nb, WD + (size_t)e * 1024 * 1024 * MOE_ES, 1024 * MOE_ES, 32 * nb, 0, F.lane, MOE_WSCALE);
}
template <int NI>
__device__ __forceinline__ void conv_chunks(Frame& F, int& conv_k, const int n) {
    constexpr int KLE = MOE_FP8 ? 16 : 8; const int gw = F.vcu * NWAVES + F.wave, NGW = F.G * NWAVES;
    for (int c = 0; c < n && conv_k + NI <= 12; ++c, conv_k += NI) {
        P0Item<MOE_FP8> it[NI]; f32x4 v[NI][KLE];
#pragma unroll
        for (int q = 0; q < NI; ++q) { const int k = conv_k + q; const int i = k < 8 ? gw + k * NGW : EX_I_GU + gw + (k - 8) * NGW; it[q] = expert_item(F, i); p0_load<MOE_FP8, KLE>(it[q], v[q]); }
#pragma unroll
        for (int q = 0; q < NI; ++q) p0_store<MOE_FP8, KLE>(it[q], v[q]); }
}
template <int NI> struct ConvHookT { Frame* F; int* conv_k; unsigned long long counts;
    __device__ __forceinline__ void operator()(int site) const { const int n = site < 16 ? (int)((counts >> (4 * site)) & 15ull) : 0; if (n) conv_chunks<NI>(*F, *conv_k, n); } };
__device__ __forceinline__ void p0_prologue(Frame& F, const int which) {
    const int gw = F.vcu * NWAVES + F.wave, NGW = F.G * NWAVES;
    unsigned char* WIN = F.ws + WS_WIN; unsigned char* WPROJ = F.ws + WS_WPROJ; unsigned char* WOUT = F.ws + WS_WOUT;
    constexpr int I_IN = 16 * 160, I_PS = 8 * 32, I_PM = 8 * 32, I_OUT = 16 * 32, I_GU = EX_I_GU, I_D = EX_I_D;
    constexpr int NITEMS = I_IN + I_PS + I_PM + I_OUT + I_GU + I_D;
    if (which & 2) {
        constexpr int KLE = MOE_FP8 ? 16 : 8; constexpr int I_E = EX_ITEMS;
        int it = gw;
#pragma unroll 1
        for (; it + NGW < I_E; it += 2 * NGW) { const P0Item<MOE_FP8> a = expert_item(F, it), b = expert_item(F, it + NGW); f32x4 va[KLE], vb[KLE];
            p0_load<MOE_FP8, KLE>(a, va); p0_load<MOE_FP8, KLE>(b, vb); p0_store<MOE_FP8, KLE>(a, va); p0_store<MOE_FP8, KLE>(b, vb); }
        if (it < I_E) { const P0Item<MOE_FP8> a = expert_item(F, it); f32x4 va[KLE]; p0_load<MOE_FP8, KLE>(a, va); p0_store<MOE_FP8, KLE>(a, va); }
    }
    if (!(which & 1)) return;
    for (int it = I_GU + I_D + gw; it < NITEMS; it += NGW) {
        int r = it - I_GU - I_D;
        if (r < I_IN) { const int kb = r / 160, nb = r % 160; p0_item<false>(F.w_in, DIN, 64 * kb, 32 * nb, WIN, 2048, 32 * nb, 0, F.lane, 1.f); continue; } r -= I_IN;
        if (r < I_PS) { const int kb = r >> 5, nb = r & 31; p0_item<false>(F.w_proj_sb, 1024, 64 * kb, 32 * nb, WPROJ, 2048, 32 * nb, 0, F.lane, 1.f); continue; } r -= I_PS;
        if (r < I_PM) { const int kb = r >> 5, nb = r & 31; p0_item<false>(F.w_proj_moba, 1024, 64 * kb, 32 * nb, WPROJ, 2048, 32 * nb, 1024, F.lane, 1.f); continue; } r -= I_PM;
        { const int kb = r >> 5, nb = r & 31; p0_item<false>(F.w_out, 1024, 64 * kb, 32 * nb, WOUT, 2048, 32 * nb, 0, F.lane, 1.f); }
    }
    f32x4 g[4];
#pragma unroll
    for (int j = 0; j < 4; ++j) g[j] = ((const f32x4*)F.norm_mix_g)[F.lane + 64 * j];
    bf16* XN = (bf16*)(F.ws + WS_XN);
#pragma unroll 1
    for (int m = gw; m < T_TOK; m += 4 * NGW) {
        f32x4 v[4][4];
#pragma unroll
        for (int r = 0; r < 4; ++r) { const GAS f32x4* xr = (const GAS f32x4*)(F.x + (size_t)(m + r * NGW) * DM) + F.lane;
#pragma unroll
            for (int j = 0; j < 4; ++j) v[r][j] = (m + r * NGW < T_TOK) ? __builtin_nontemporal_load(xr + 64 * j) : (f32x4){0.f, 0.f, 0.f, 0.f}; }
#pragma unroll
        for (int r = 0; r < 4; ++r) { if (m + r * NGW < T_TOK) { float s = 0.f;
#pragma unroll
            for (int j = 0; j < 4; ++j) s += (v[r][j].x * v[r][j].x + v[r][j].y * v[r][j].y) + (v[r][j].z * v[r][j].z + v[r][j].w * v[r][j].w);
            const float rstd = 1.0f / sqrtf(wave_sum(s) * (1.0f / DM) + RMS_EPS);
            GAS v2u* o8 = (GAS v2u*)(XN + (size_t)(m + r * NGW) * DM) + F.lane;
#pragma unroll
            for (int j = 0; j < 4; ++j) { const f32x4 y = v[r][j] * rstd * g[j]; v2u w; w.x = pg8::cvt_pk_bf16(y.x, y.y); w.y = pg8::cvt_pk_bf16(y.z, y.w); o8[64 * j] = w; } } }
    }
}

__device__ __forceinline__ f32x4 h1_frag(const bf16* h1, size_t row, int lane, int j) {
    const v2u a = *((const GAS v2u*)(h1 + row * DM) + lane + 64 * j);
    return (f32x4){__uint_as_float(a.x << 16), __uint_as_float(a.x & 0xffff0000u), __uint_as_float(a.y << 16), __uint_as_float(a.y & 0xffff0000u)};
}
__device__ __forceinline__ void p5_router_mfma(Frame& F) {
    typedef short bf16x8_t __attribute__((ext_vector_type(8)));
    typedef float f32x16_t __attribute__((ext_vector_type(16)));
    LAS unsigned short* WH = (LAS unsigned short*)(F.lds + RING_OFF);
    LAS unsigned short* WL = (LAS unsigned short*)(F.lds + RING_OFF + 65536);
    LAS float* PL = (LAS float*)(F.lds + RING_OFF);
    LAS float* SSQ = (LAS float*)(F.lds + LDSCTL_OFF + 4096);
    LAS float* RSTD = (LAS float*)(F.lds + LDSCTL_OFF + 5120);
    LAS int* hist = (LAS int*)(F.lds + L_HIST); LAS int* basel = (LAS int*)(F.lds + L_BASE); LAS int* tmp = (LAS int*)(F.lds + L_TMP);
    int tid = threadIdx.x; asm volatile("" : "+v"(tid));
    const int lane = tid & 63; const int wave = __builtin_amdgcn_readfirstlane(tid >> 6);
    const bf16* H1 = (const bf16*)(F.ws + WS_H1); unsigned char* HN8 = F.ws + WS_HN; float* topw = (float*)(F.ws + WS_TOPW); int* list = (int*)(F.ws + WS_LIST);
#pragma unroll 1
    for (int rb = F.vcu; rb < T_TOK / 64; rb += F.G) {
        for (int kk = tid; kk < DM; kk += NWAVES * 64) { const float gk = F.norm_ffn_g[kk]; const int fb = (((kk >> 4) * 2 + ((kk >> 3) & 1)) * 32) * 8 + (kk & 7);
#pragma unroll
            for (int q = 0; q < 8; ++q) { const f32x4 v = *(const f32x4*)(F.w_router + (size_t)kk * 32 + 4 * q);
#pragma unroll
                for (int c = 0; c < 4; ++c) { const float w = v[c] * gk; const unsigned hi = f2bf(w); const float lo = w - __uint_as_float(hi << 16);
                    WH[fb + (4 * q + c) * 8] = (unsigned short)hi; WL[fb + (4 * q + c) * 8] = (unsigned short)f2bf(lo); } } }
        if (tid < 32) hist[tid] = 0;
        __syncthreads();
        { const int mb = wave & 1, kq = wave >> 1, r = lane & 31, kg = lane >> 5;
          const bf16* hrow = H1 + (size_t)(rb * 64 + 32 * mb + r) * DM + kq * 256 + 8 * kg;
          bf16x8_t a[16];
#pragma unroll
          for (int st = 0; st < 16; ++st) a[st] = *(const bf16x8_t*)(hrow + st * 16);
          f32x16_t acc = f32x16_t{}; float ssq = 0.f;
#pragma unroll
          for (int st = 0; st < 16; ++st) { const int fo = (((kq * 16 + st) * 2 + kg) * 32 + r) * 8;
              const bf16x8_t bh = *(const LAS bf16x8_t*)(WH + fo), bl = *(const LAS bf16x8_t*)(WL + fo);
              acc = __builtin_amdgcn_mfma_f32_32x32x16_bf16(a[st], bh, acc, 0, 0, 0); acc = __builtin_amdgcn_mfma_f32_32x32x16_bf16(a[st], bl, acc, 0, 0, 0);
#pragma unroll
              for (int j = 0; j < 8; ++j) { const float x = __uint_as_float((unsigned)(unsigned short)a[st][j] << 16); ssq += x * x; } }
          ssq += __shfl_xor(ssq, 32);
          __syncthreads();
#pragma unroll
          for (int reg = 0; reg < 16; ++reg) { const int row = 32 * mb + (reg & 3) + 8 * (reg >> 2) + 4 * kg; PL[(kq * 64 + row) * 32 + r] = acc[reg]; }
          if (kg == 0) SSQ[kq * 64 + 32 * mb + r] = ssq; }
        __syncthreads();
        if (wave == 0) { const int row = lane; const float rstd = 1.0f / sqrtf((SSQ[row] + SSQ[64 + row] + SSQ[128 + row] + SSQ[192 + row]) * (1.0f / DM) + RMS_EPS); RSTD[row] = rstd;
            float lg[32];
#pragma unroll
            for (int e4 = 0; e4 < 8; ++e4) { const f32x4 p0 = *(const LAS f32x4*)(PL + (0 * 64 + row) * 32 + 4 * e4), p1 = *(const LAS f32x4*)(PL + (1 * 64 + row) * 32 + 4 * e4), p2 = *(const LAS f32x4*)(PL + (2 * 64 + row) * 32 + 4 * e4), p3 = *(const LAS f32x4*)(PL + (3 * 64 + row) * 32 + 4 * e4);
                const f32x4 bb = *(const f32x4*)(F.b_router + 4 * e4); const f32x4 sm = ((p0 + p1) + (p2 + p3)) * rstd + bb;
                lg[4 * e4] = sm.x; lg[4 * e4 + 1] = sm.y; lg[4 * e4 + 2] = sm.z; lg[4 * e4 + 3] = sm.w; }
            float selv[4]; int seli[4];
#pragma unroll
            for (int k = 0; k < 4; ++k) { float best = lg[0]; int bi = 0;
#pragma unroll
                for (int e = 1; e < 32; ++e) { const bool t = lg[e] > best; best = t ? lg[e] : best; bi = t ? e : bi; }
                selv[k] = best; seli[k] = bi;
#pragma unroll
                for (int e = 0; e < 32; ++e) lg[e] = (e == bi) ? -INFINITY : lg[e]; }
            const float e1 = __expf(selv[1] - selv[0]), e2 = __expf(selv[2] - selv[0]), e3 = __expf(selv[3] - selv[0]); const float inv = 1.0f / (1.0f + e1 + e2 + e3);
            const float wk[4] = {inv, e1 * inv, e2 * inv, e3 * inv};
#pragma unroll
            for (int k = 0; k < 4; ++k) { const int slot = __hip_atomic_fetch_add(hist + seli[k], 1, __ATOMIC_RELAXED, __HIP_MEMORY_SCOPE_WORKGROUP); tmp[row * 4 + k] = seli[k] | (slot << 8); }
            *(f32x4*)(topw + (size_t)(rb * 64 + row) * 4) = (f32x4){wk[0], wk[1], wk[2], wk[3]}; }
        __syncthreads();
        { f32x4 gl[4];
#pragma unroll
          for (int j = 0; j < 4; ++j) gl[j] = ((const f32x4*)F.norm_ffn_g)[lane * 4 + j];
#pragma unroll 2
          for (int i = 0; i < 8; ++i) { const int row = wave * 8 + i; const size_t grow = (size_t)(rb * 64 + row); const float rs = RSTD[row];
              const v4u h0 = *((const GAS v4u*)(H1 + grow * DM) + lane * 2), h1v = *((const GAS v4u*)(H1 + grow * DM) + lane * 2 + 1);
              float x[16];
              x[0] = __uint_as_float(h0.x << 16); x[1] = __uint_as_float(h0.x & 0xffff0000u); x[2] = __uint_as_float(h0.y << 16); x[3] = __uint_as_float(h0.y & 0xffff0000u);
              x[4] = __uint_as_float(h0.z << 16); x[5] = __uint_as_float(h0.z & 0xffff0000u); x[6] = __uint_as_float(h0.w << 16); x[7] = __uint_as_float(h0.w & 0xffff0000u);
              x[8] = __uint_as_float(h1v.x << 16); x[9] = __uint_as_float(h1v.x & 0xffff0000u); x[10] = __uint_as_float(h1v.y << 16); x[11] = __uint_as_float(h1v.y & 0xffff0000u);
              x[12] = __uint_as_float(h1v.z << 16); x[13] = __uint_as_float(h1v.z & 0xffff0000u); x[14] = __uint_as_float(h1v.w << 16); x[15] = __uint_as_float(h1v.w & 0xffff0000u);
#pragma unroll
              for (int j = 0; j < 4; ++j) { x[4 * j] *= rs * gl[j].x; x[4 * j + 1] *= rs * gl[j].y; x[4 * j + 2] *= rs * gl[j].z; x[4 * j + 3] *= rs * gl[j].w; }
              if constexpr (MOE_FP8) { v4u o; o.x = pg8::pk4_fp8(x[0], x[1], x[2], x[3]); o.y = pg8::pk4_fp8(x[4], x[5], x[6], x[7]); o.z = pg8::pk4_fp8(x[8], x[9], x[10], x[11]); o.w = pg8::pk4_fp8(x[12], x[13], x[14], x[15]);
                  *((GAS v4u*)(HN8 + grow * DM) + lane) = o; }
              else { v4u o0, o1; o0.x = pg8::cvt_pk_bf16(x[0], x[1]); o0.y = pg8::cvt_pk_bf16(x[2], x[3]); o0.z = pg8::cvt_pk_bf16(x[4], x[5]); o0.w = pg8::cvt_pk_bf16(x[6], x[7]);
                  o1.x = pg8::cvt_pk_bf16(x[8], x[9]); o1.y = pg8::cvt_pk_bf16(x[10], x[11]); o1.z = pg8::cvt_pk_bf16(x[12], x[13]); o1.w = pg8::cvt_pk_bf16(x[14], x[15]);
                  *((GAS v4u*)(HN8 + grow * DM * 2) + lane * 2) = o0; *((GAS v4u*)(HN8 + grow * DM * 2) + lane * 2 + 1) = o1; } } }
        if (tid < 32) basel[tid] = (int)__hip_atomic_fetch_add((unsigned*)(F.ctl + CW_CNT + 64 * tid), (unsigned)hist[tid], RLX_AGENT);
        __syncthreads();
        if (tid < 256) { const int t = tmp[tid]; const int ex = t & 255, slot = t >> 8; const int id = (rb * 64 + (tid >> 2)) * 4 + (tid & 3); const int idx = basel[ex] + slot;
            list[(size_t)ex * LIST_CAP + idx] = id; ((int*)(F.ws + WS_TOKENT))[id] = ex | (idx << 8); }
        __syncthreads();
    }
}
__device__ __forceinline__ int moe_tables(Frame& F) {
    LAS int* cnt = (LAS int*)(F.lds + L_CNT); LAS int* toff = (LAS int*)(F.lds + L_TOFF); LAS int* tile_e = (LAS int*)(F.lds + L_TILEE);
    __syncthreads();
    if (F.tid < 64) {
        const int lane = F.lane; int c = (lane < 32) ? (int)__hip_atomic_load((unsigned*)(F.ctl + CW_CNT + 64 * (lane & 31)), RLX_AGENT) : 0; c = c > LIST_CAP ? LIST_CAP : c;
        const int ntl = (c + 255) >> 8; int incl = ntl;
#pragma unroll
        for (int o = 1; o < 32; o <<= 1) { const int t = __shfl_up(incl, o); if (lane >= o) incl += t; }
        const int off = incl - ntl;
        if (lane < 32) { cnt[lane] = c; toff[lane] = off; if (lane == 31) toff[32] = incl;
            for (int t = 0; t < ntl; ++t) if (off + t < MAX_TILES) tile_e[off + t] = lane; } }
    __syncthreads();
    int NT = toff[32]; return NT > MAX_TILES ? MAX_TILES : NT;
}
__device__ __forceinline__ void p8_final(Frame& F) {
    int tid_ = threadIdx.x; asm volatile("" : "+v"(tid_));
    const int gw = F.vcu * NWAVES + F.wave, NGW = F.G * NWAVES, lane = tid_ & 63;
    (void)moe_tables(F);
    LAS float* bdl = (LAS float*)(F.lds + RING_OFF); const LAS int* toff = (const LAS int*)(F.lds + L_TOFF);
    for (int i = F.tid; i < NEXP * DM / 4; i += NWAVES * 64) ((LAS f32x4*)bdl)[i] = ((const f32x4*)F.b_down)[i];
    __syncthreads();
    f32x4 g[4];
#pragma unroll
    for (int j = 0; j < 4; ++j) g[j] = ((const f32x4*)F.norm_final_g)[lane + 64 * j];
    const bf16* H1 = (const bf16*)(F.ws + WS_H1); const bf16* YS = (const bf16*)(F.ws + WS_YSLOT); const int* tokent = (const int*)(F.ws + WS_TOKENT); const float* topw = (const float*)(F.ws + WS_TOPW);
#pragma unroll 1
    for (int m0 = gw; m0 < T_TOK; m0 += 2 * NGW) {
        int4 ent[2]; f32x4 wk[2]; f32x4 v[2][4]; v2u y[2][4][4];
#pragma unroll
        for (int t = 0; t < 2; ++t) { const int m = m0 + t * NGW; ent[t] = *(const int4*)(tokent + (size_t)m * 4); wk[t] = *(const f32x4*)(topw + (size_t)m * 4); }
#pragma unroll
        for (int t = 0; t < 2; ++t) { const int m = m0 + t * NGW;
#pragma unroll
            for (int j = 0; j < 4; ++j) v[t][j] = h1_frag(H1, (size_t)m, lane, j);
#pragma unroll
            for (int k = 0; k < TOPK; ++k) { const int en = k == 0 ? ent[t].x : k == 1 ? ent[t].y : k == 2 ? ent[t].z : ent[t].w; const int e = en & 255, idx = en >> 8; const size_t row = (size_t)toff[e] * 256 + idx;
                const GAS v2u* yr = (const GAS v2u*)(YS + row * DM) + lane;
#pragma unroll
                for (int j = 0; j < 4; ++j) y[t][k][j] = yr[64 * j]; } }
#pragma unroll
        for (int t = 0; t < 2; ++t) { const int m = m0 + t * NGW;
#pragma unroll
            for (int k = 0; k < TOPK; ++k) { const int en = k == 0 ? ent[t].x : k == 1 ? ent[t].y : k == 2 ? ent[t].z : ent[t].w; const int e = en & 255; const float w = k == 0 ? wk[t].x : k == 1 ? wk[t].y : k == 2 ? wk[t].z : wk[t].w;
#pragma unroll
                for (int j = 0; j < 4; ++j) { const f32x4 bb = *(const LAS f32x4*)(bdl + e * DM + 4 * (lane + 64 * j)); const v2u q = y[t][k][j];
                    v[t][j].x += w * (__uint_as_float(q.x << 16) + bb.x); v[t][j].y += w * (__uint_as_float(q.x & 0xffff0000u) + bb.y); v[t][j].z += w * (__uint_as_float(q.y << 16) + bb.z); v[t][j].w += w * (__uint_as_float(q.y & 0xffff0000u) + bb.w); } }
            float s = 0.f;
#pragma unroll
            for (int j = 0; j < 4; ++j) s += (v[t][j].x * v[t][j].x + v[t][j].y * v[t][j].y) + (v[t][j].z * v[t][j].z + v[t][j].w * v[t][j].w);
            const float rstd = 1.0f / sqrtf(wave_sum(s) * (1.0f / DM) + RMS_EPS);
            GAS f32x4* o = (GAS f32x4*)(F.out + (size_t)m * DM) + lane;
#pragma unroll
            for (int j = 0; j < 4; ++j) o[64 * j] = v[t][j] * rstd * g[j]; }
    }
}

constexpr int N_PHASES = 9;
struct Args { const float* in[15]; float* out; unsigned char* ws; int ph_lo, ph_hi; };
__global__ void __launch_bounds__(NWAVES * 64, 2) fwd_kernel(Args args) {
    extern __shared__ __attribute__((aligned(16))) unsigned char lds[];
    Frame F;
    F.lds = (LAS unsigned char*)lds;
    F.tid = threadIdx.x; F.lane = F.tid & 63; F.wave = __builtin_amdgcn_readfirstlane(F.tid >> 6);
    F.G = gridDim.x; { const int bx = blockIdx.x; F.vcu = (F.G % 8 == 0) ? (bx % 8) * (F.G / 8) + bx / 8 : bx; }
    F.ws = args.ws; F.ctl = (gu32*)(args.ws + WS_CTL); F.out = args.out;
    F.x = args.in[0]; F.norm_mix_g = args.in[1]; F.w_in = args.in[2]; F.w_proj_sb = args.in[3]; F.w_proj_moba = args.in[4]; F.w_out = args.in[5]; F.rel_bias = args.in[6]; F.norm_ffn_g = args.in[7];
    F.w_router = args.in[8]; F.b_router = args.in[9]; F.w_gate_up = args.in[10]; F.b_gate_up = args.in[11]; F.w_down = args.in[12]; F.b_down = args.in[13]; F.norm_final_g = args.in[14];
    for (int u = F.tid; u < (LDS_BYTES - LDSCTL_OFF) / 4; u += NWAVES * 64) ((LAS unsigned*)(F.lds + LDSCTL_OFF))[u] = 0u;
    __syncthreads();
    XcdBarrier bar; bar.bar = (unsigned*)(F.ctl + CW_BAR); bar.x = 0; bar.st = nullptr;
    if (MK_N_LAUNCHES == 1) bar = xcd_barrier_post((unsigned*)(F.ctl + CW_BAR), (volatile LAS unsigned*)(F.lds + L_MISC) + 8);
#define GRID_BAR() do { if (MK_N_LAUNCHES == 1) xcd_barrier(bar); } while (0)
    const int lo = args.ph_lo, hi = args.ph_hi;
#ifndef PH_MASK
#define PH_MASK 0x1ff
#endif
#define IN(k) ((((PH_MASK) >> (k)) & 1) && lo <= (k) && (k) < hi)
#define BOTH(k) (IN(k) && IN((k) + 1))
    unsigned char* ws = args.ws;
    int conv_k = 0;
    const bool conv_il = CONV_INTERLEAVE && EXPERTS_LATE && F.G == 256 && MK_N_LAUNCHES == 1; const unsigned odd = (unsigned)F.vcu & 1u;

    if (IN(0)) { _Pragma("unroll") for (int rep = 0; rep < 1 + ((PROBE_REP >> 0) & 1); ++rep) { p0_prologue(F, EXPERTS_LATE ? 1 : 3); if (BOTH(0)) GRID_BAR(); } }

    if (IN(1)) { _Pragma("unroll") for (int rep = 0; rep < 1 + ((PROBE_REP >> 1) & 1); ++rep) {
        pg8::DenseOrder S{T_TOK / 256, DIN / 256, F.G, (int)blockIdx.x, (const char*)(ws + WS_XN), (const char*)(ws + WS_WIN), (size_t)256 * DM * 2, (size_t)256 * DM * 2};
        pg8::EpiInProj E{(bf16*)(ws + WS_QKV), (bf16*)(ws + WS_GATES), (float*)(ws + WS_KPART)};
        ConvHookT<3> H{&F, &conv_k, conv_il ? (odd ? 0x00100ull : 0x00001ull) : 0ull};
        pg8::gemm_phase<pg8::EpiInProj, pg8::DenseOrder, true, false, false, ConvHookT<3> >(F.lds + RING_OFF, S, E, DM * 2, DM * 2, DM * 2, H);
        if (BOTH(1)) GRID_BAR();
    } }

    if (IN(2)) { _Pragma("unroll") for (int rep = 0; rep < 1 + ((PROBE_REP >> 2) & 1); ++rep) {
        const att::bf16* QKV = (const att::bf16*)(ws + WS_QKV); att::bf16* Y = (att::bf16*)(ws + WS_Y);
        for (int v = F.vcu; v < 256; v += F.G) {
            const int bh = v >> 2, s = v & 3, b = bh >> 3, h = bh & 7;
            _Pragma("unroll") for (int r2 = 0; r2 < 1 + ((PROBE_REP >> 9) & 1); ++r2) {
            att::moba_unit(b, h, 7 - s, QKV, Y, (const float*)(ws + WS_KPART), F.rel_bias, (char*)lds + RING_OFF);
            att::moba_unit(b, h, s, QKV, Y, (const float*)(ws + WS_KPART), F.rel_bias, (char*)lds + RING_OFF); }
            _Pragma("unroll") for (int r2 = 0; r2 < 1 + ((PROBE_REP >> 10) & 1); ++r2) {
            att::sb_unit(b, h, 7 - s, QKV, Y, (char*)lds + RING_OFF);
            att::sb_unit(b, h, s, QKV, Y, (char*)lds + RING_OFF); }
        }
        if (BOTH(2)) GRID_BAR();
    } }

    if (IN(3)) { _Pragma("unroll") for (int rep = 0; rep < 1 + ((PROBE_REP >> 3) & 1); ++rep) {
        pg8::ProjOrder S{F.G, (int)blockIdx.x, (const char*)(ws + WS_Y), (const char*)(ws + WS_WPROJ)};
        pg8::EpiProjGate E{(const bf16*)(ws + WS_GATES), (bf16*)(ws + WS_MERGED)};
        ConvHookT<3> H{&F, &conv_k, conv_il ? (odd ? 0x010ull : 0x001ull) : 0ull};
        pg8::gemm_phase<pg8::EpiProjGate, pg8::ProjOrder, true, false, false, ConvHookT<3> >(F.lds + RING_OFF, S, E, 512 * 2, DM * 2, DM * 2, H);
        if (BOTH(3)) GRID_BAR();
    } }

    if (IN(4)) { _Pragma("unroll") for (int rep = 0; rep < 1 + ((PROBE_REP >> 4) & 1); ++rep) {
        pg8::DenseOrder S{T_TOK / 256, DM / 256, F.G, (int)blockIdx.x, (const char*)(ws + WS_MERGED), (const char*)(ws + WS_WOUT), (size_t)256 * DM * 2, (size_t)256 * DM * 2};
        pg8::EpiResF32 E{F.x, (bf16*)(ws + WS_H1)};
        ConvHookT<2> H{&F, &conv_k, conv_il ? (odd ? 0x10ull : 0x01ull) : 0ull};
        pg8::gemm_phase<pg8::EpiResF32, pg8::DenseOrder, true, false, false, ConvHookT<2> >(F.lds + RING_OFF, S, E, DM * 2, DM * 2, DM * 2, H);
        if (BOTH(4)) GRID_BAR();
    } }

    if (IN(5)) { p5_router_mfma(F); if (EXPERTS_LATE) { if (conv_il) { if (conv_k < 8) conv_chunks<1>(F, conv_k, 8 - conv_k); } else p0_prologue(F, 2); } if (BOTH(5)) GRID_BAR(); }

    if (IN(6)) { _Pragma("unroll") for (int rep = 0; rep < 1 + ((PROBE_REP >> 6) & 1); ++rep) {
        const int NT = moe_tables(F);
        pg8::MoeOrder S{NT, 8, F.G, (int)blockIdx.x, (const LAS int*)(F.lds + L_TILEE), (const LAS int*)(F.lds + L_TOFF), (const LAS int*)(F.lds + L_CNT),
                        (const char*)(ws + WS_HN), (const char*)(ws + WS_WGU), (size_t)256 * DM * MOE_ES, (size_t)256 * DM * MOE_ES, (size_t)2048 * DM * MOE_ES, (const int*)(ws + WS_LIST), DM * MOE_ES, true, 1 + ((PROBE_REP >> 11) & 1)};
        pg8::EpiSwiglu E{F.b_gate_up, (unsigned char*)(ws + WS_ACT)};
        ConvHookT<1> H{&F, &conv_k, conv_il ? (odd ? 0x101010100ull : 0x010101010ull) : 0ull};
        pg8::gemm_phase<pg8::EpiSwiglu, pg8::MoeOrder, true, true, MOE_FP8, ConvHookT<1> >(F.lds + RING_OFF, S, E, DM * MOE_ES, DM * MOE_ES, DM * MOE_ES, H);
        if (conv_il) conv_chunks<1>(F, conv_k, 12);
        if (BOTH(6)) GRID_BAR();
    } }

    if (IN(7)) { _Pragma("unroll") for (int rep = 0; rep < 1 + ((PROBE_REP >> 7) & 1); ++rep) {
        const int NT = moe_tables(F);
        pg8::MoeOrder S{NT, 4, F.G, (int)blockIdx.x, (const LAS int*)(F.lds + L_TILEE), (const LAS int*)(F.lds + L_TOFF), (const LAS int*)(F.lds + L_CNT),
                        (const char*)(ws + WS_ACT), (const char*)(ws + WS_WD), (size_t)256 * DM * MOE_ES, (size_t)256 * DM * MOE_ES, (size_t)1024 * DM * MOE_ES, (const int*)(ws + WS_LIST), DM * MOE_ES, false, 1 + ((PROBE_REP >> 12) & 1)};
        pg8::EpiDown E{(bf16*)(ws + WS_YSLOT)};
        pg8::gemm_phase<pg8::EpiDown, pg8::MoeOrder, true, false, MOE_FP8>(F.lds + RING_OFF, S, E, DM * MOE_ES, DM * MOE_ES, DM * MOE_ES);
        if (BOTH(7)) GRID_BAR();
    } }

    if (IN(8)) { for (int rep = 0; rep < 1 + ((PROBE_REP >> 8) & 1); ++rep) p8_final(F); }
#undef IN
#undef BOTH
#undef GRID_BAR
}

extern "C" void kernel_launch(void* const* d_in, const int* in_sizes, int n_in, void* d_out, int out_size, void* d_ws, size_t ws_size, hipStream_t stream) {
    static int grid = 0;
    if (grid == 0) {
        if (n_in != 15 || in_sizes[0] != T_TOK * DM || out_size != T_TOK * DM || ws_size < WS_END) { fprintf(stderr, "kernel_launch: unexpected shapes (n_in %d, in0 %d, out %d, ws %zu); nothing launched\n", n_in, n_in > 0 ? in_sizes[0] : -1, out_size, ws_size); grid = -1; return; }
        int dev = 0, cus = 0, per_cu = 0;
        if (hipGetDevice(&dev) != hipSuccess || hipDeviceGetAttribute(&cus, hipDeviceAttributeMultiprocessorCount, dev) != hipSuccess) { grid = -1; return; }
        if (hipFuncSetAttribute((const void*)fwd_kernel, hipFuncAttributeMaxDynamicSharedMemorySize, LDS_BYTES) != hipSuccess) { fprintf(stderr, "kernel_launch: hipFuncSetAttribute failed\n"); grid = -1; return; }
        if (hipOccupancyMaxActiveBlocksPerMultiprocessor(&per_cu, (const void*)fwd_kernel, NWAVES * 64, LDS_BYTES) != hipSuccess || per_cu < 1) { fprintf(stderr, "kernel_launch: occupancy query reports %d workgroups per CU\n", per_cu); }
        (void)hipGetLastError();
        grid = cus;
    }
    if (grid < 0) return;
    if (hipMemsetAsync((char*)d_ws + WS_CTL, 0, CTL_ZERO_BYTES, stream) != hipSuccess) return;
    Args a{};
    for (int i = 0; i < 15; ++i) a.in[i] = (const float*)d_in[i];
    a.out = (float*)d_out; a.ws = (unsigned char*)d_ws;
    if (MK_N_LAUNCHES == 1) { a.ph_lo = 0; a.ph_hi = N_PHASES; hipLaunchKernelGGL(fwd_kernel, dim3(grid), dim3(NWAVES * 64), LDS_BYTES, stream, a); }
    else { for (int p = 0; p < N_PHASES; ++p) { a.ph_lo = p; a.ph_hi = p + 1; hipLaunchKernelGGL(fwd_kernel, dim3(grid), dim3(NWAVES * 64), LDS_BYTES, stream, a); } }
}
```

```cpp
#include <hip/hip_runtime.h>
#include <cstdio>
#include <cstdint>
#include <cmath>

#ifndef PROBE_REP
#define PROBE_REP 0
#endif
#ifndef EXPERTS_LATE
#define EXPERTS_LATE 1
#endif
#ifndef CONV_INTERLEAVE
#define CONV_INTERLEAVE 1
#endif
#ifndef MOE_KROT
#define MOE_KROT 2
#endif
#ifndef MK_N_LAUNCHES
#define MK_N_LAUNCHES 1
#endif

constexpr int T_TOK = 16384, DM = 1024, DIN = 5120, NEXP = 32, TOPK = 4, SEQ = 2048, NBATCH = 8, NHEAD = 8;
constexpr int QKV_LD = 3072, GATE_LD = 2048;
#ifndef MOE_FP8_SW
#define MOE_FP8_SW 1
#endif
constexpr bool MOE_FP8 = MOE_FP8_SW != 0;
constexpr int MOE_ES = MOE_FP8 ? 1 : 2;
constexpr float MOE_WSCALE = MOE_FP8 ? 64.0f : 1.0f, MOE_WINV = MOE_FP8 ? (1.0f / 64.0f) : 1.0f;
constexpr float C2F = 0.125f * 1.4426950408889634f;
constexpr float LOG2E = 1.4426950408889634f;
constexpr float RMS_EPS = 1e-6f;
constexpr int LIST_CAP = 16384;
constexpr int MAX_TILES = 288;

namespace pg8 {
#define PG8_LAS __attribute__((address_space(3)))
typedef unsigned short bf16_t;
typedef short bf16x8 __attribute__((ext_vector_type(8)));
typedef float f32x4 __attribute__((ext_vector_type(4)));
typedef float f32x2 __attribute__((ext_vector_type(2)));
typedef unsigned u32x4 __attribute__((ext_vector_type(4)));
typedef unsigned u32x2 __attribute__((ext_vector_type(2)));
constexpr int BM = 256, BK = 64, HALF = 128, HTB = HALF * BK * 2, STAGE_BYTES = 8 * HTB, NXCD = 8, WGM = 8;
constexpr int EBUF_OFF = STAGE_BYTES + 1024;
constexpr int IDBUF_OFF = STAGE_BYTES;

__host__ __device__ __forceinline__ int lds_byte(int r, int c) { const int st = (r >> 4) * 2 + (c >> 5), rr = r & 15, cc = c & 31, ob = rr * 64 + cc * 2; return st * 1024 + (ob ^ (((ob >> 9) & 1) << 5)); }
__host__ __device__ __forceinline__ void stage_rc(int b, int& R, int& C) { const int st = b / 1024, sb = b % 1024, swz = sb ^ (((sb >> 9) & 1) << 5); R = (st >> 1) * 16 + swz / 64; C = (st & 1) * 32 + (swz % 64) / 2; }
__host__ __device__ __forceinline__ int perm32(int rho) { const int n = rho >> 4, i = rho & 15; return 8 * (i >> 2) + 4 * n + (i & 3); }

typedef int i32x8 __attribute__((ext_vector_type(8)));
typedef int i32x4 __attribute__((ext_vector_type(4)));
__device__ __forceinline__ i32x8 pk32(bf16x8 lo, bf16x8 hi) { const i32x4 a = __builtin_bit_cast(i32x4, lo), b = __builtin_bit_cast(i32x4, hi); return (i32x8){a[0], a[1], a[2], a[3], b[0], b[1], b[2], b[3]}; }
struct Unit { int pm, pn, e, aux, rot; };

__device__ __forceinline__ bool static_tile(int i, int G, int c, int nM, int nN, int& pm, int& pn) {
    const int nwg = nM * nN; const long L = (long)i * G + c; if (L >= nwg) return false;
    int wgid = (int)L; { const int q = nwg / NXCD, r = nwg % NXCD, xcd = wgid % NXCD, off = wgid / NXCD; wgid = (xcd < r ? xcd * (q + 1) : r * (q + 1) + (xcd - r) * q) + off; }
    const int nig = WGM * nN, gid = wgid / nig, fm = gid * WGM, gsz = (nM - fm) < WGM ? (nM - fm) : WGM;
    pm = fm + ((wgid % nig) % gsz); pn = (wgid % nig) / gsz; return true;
}

typedef __bf16 bf16x2_t __attribute__((ext_vector_type(2)));
__device__ __forceinline__ unsigned cvt_pk_bf16(float lo, float hi) { f32x2 v = {lo, hi}; bf16x2_t b = __builtin_convertvector(v, bf16x2_t); return __builtin_bit_cast(unsigned, b); }
__device__ __forceinline__ unsigned pk4_fp8(float a, float b, float c, float d) { int p = __builtin_amdgcn_cvt_pk_fp8_f32(a, b, 0, false); p = __builtin_amdgcn_cvt_pk_fp8_f32(c, d, p, true); return (unsigned)p; }
__device__ __forceinline__ float bf_lo(unsigned w) { return __uint_as_float(w << 16); }
__device__ __forceinline__ float bf_hi(unsigned w) { return __uint_as_float(w & 0xffff0000u); }

struct NoHook { __device__ __forceinline__ void operator()(int) const {} };
template <class Epi, class Sched, bool ALIGN_EPI, bool GATHER, bool FP8 = false, class Hook = NoHook>
__device__ __forceinline__ void gemm_phase(PG8_LAS unsigned char* lds, const Sched& S, const Epi& E, const int KB, const int ldaB, const int ldbB, const Hook& H = Hook()) {
    const int tid = threadIdx.x, wid = __builtin_amdgcn_readfirstlane(tid >> 6), lane = tid & 63, wr = wid >> 2, wc = wid & 3, fr = lane & 15, fq = lane >> 4;
    const int nt = KB / (BK * 2);
    unsigned voA[2][2], voN[2][2], voffB[2]; int RA[2], CA[2];
#pragma unroll
    for (int i = 0; i < 2; ++i) { int R, C; stage_rc(tid * 16 + i * 8192, R, C); const int Rb = Epi::PERM ? ((R & ~31) + perm32(R & 31)) : R;
        RA[i] = R; CA[i] = C; voffB[i] = (unsigned)(Rb * ldbB + C * 2);
#pragma unroll
        for (int h = 0; h < 2; ++h) voA[h][i] = (unsigned)((h * HALF + R) * ldaB + C * 2); }
    const size_t kstep = (size_t)(BK * 2);
    const size_t hstepB = (size_t)HALF * ldbB;
    const unsigned ldsw = (unsigned)wid * 1024u;
    const int aoff = lds_byte(wr * 64 + fr, fq * 8), boff = lds_byte(wc * 32 + fr, fq * 8);
#define PG8_SA(b, h) (((b) * 2 + (h)) * HTB)
#define PG8_SB(b, h) ((4 + (b) * 2 + (h)) * HTB)
#define PG8_STAGE(bufoff, gbase, voff) do { _Pragma("unroll") for (int _i = 0; _i < 2; ++_i) \
        __builtin_amdgcn_global_load_lds((const unsigned*)((const char*)(gbase) + (voff)[_i]), (PG8_LAS unsigned*)(lds + (bufoff) + ldsw + _i * 8192), 16, 0, 0); } while (0)
#define PG8_LD8(dst, off) do { const i32x4 _lo = *(const PG8_LAS i32x4*)(lds + (off)); const i32x4 _hi = *(const PG8_LAS i32x4*)(lds + (off) + 1024); dst = __builtin_shufflevector(_lo, _hi, 0, 1, 2, 3, 4, 5, 6, 7); } while (0)
#define PG8_LDA(dst, b, h) do { _Pragma("unroll") for (int m = 0; m < 4; ++m) PG8_LD8(dst[m], PG8_SA(b, h) + aoff + m * 2048); } while (0)
#define PG8_LDB(dst, b, h) do { _Pragma("unroll") for (int n = 0; n < 2; ++n) PG8_LD8(dst[n], PG8_SB(b, h) + boff + n * 2048); } while (0)
#define PG8_LO(x) __builtin_bit_cast(bf16x8, __builtin_shufflevector(x, x, 0, 1, 2, 3))
#define PG8_HI(x) __builtin_bit_cast(bf16x8, __builtin_shufflevector(x, x, 4, 5, 6, 7))
#define PG8_MMA(ai, bj, At, Bt) do { __builtin_amdgcn_s_setprio(1); _Pragma("unroll") for (int m = 0; m < 4; ++m) _Pragma("unroll") for (int n = 0; n < 2; ++n) { \
        if constexpr (FP8) { asm volatile("v_mfma_f32_16x16x128_f8f6f4 %0, %1, %2, %0" : "+v"(acc[ai][bj][m][n]) : "v"(Bt[n]), "v"(At[m])); } \
        else { acc[ai][bj][m][n] = __builtin_amdgcn_mfma_f32_16x16x32_bf16(PG8_LO(Bt[n]), PG8_LO(At[m]), acc[ai][bj][m][n], 0, 0, 0); \
               acc[ai][bj][m][n] = __builtin_amdgcn_mfma_f32_16x16x32_bf16(PG8_HI(Bt[n]), PG8_HI(At[m]), acc[ai][bj][m][n], 0, 0, 0); } } __builtin_amdgcn_s_setprio(0); } while (0)
#define PG8_WAIT_V(n) asm volatile("s_waitcnt vmcnt(" #n ")" ::: "memory")
#define PG8_WAIT_L(n) asm volatile("s_waitcnt lgkmcnt(" #n ")" ::: "memory")
#define PG8_BAR __builtin_amdgcn_s_barrier()
#define PG8_SCHED __builtin_amdgcn_sched_barrier(0)
    Unit cur, nxt; int ui = 0;
    H(0);
    if (!S.next(0, cur)) return;
    E.prefetch(cur, lds + EBUF_OFF, wid, lane);
    if constexpr (GATHER) { S.a_rows(cur, RA, CA, voA);
#pragma unroll
        for (int h = 0; h < 2; ++h)
#pragma unroll
            for (int i = 0; i < 2; ++i) voA[h][i] = S.a_off(voA[h][i], CA[i]); }
#pragma unroll
    for (int h = 0; h < 2; ++h)
#pragma unroll
        for (int i = 0; i < 2; ++i) voN[h][i] = voA[h][i];
    f32x4 acc[2][2][4][2];
#pragma unroll
    for (int a = 0; a < 2; ++a)
#pragma unroll
        for (int b = 0; b < 2; ++b)
#pragma unroll
            for (int m = 0; m < 4; ++m)
#pragma unroll
                for (int n = 0; n < 2; ++n) acc[a][b][m][n] = (f32x4){0.f, 0.f, 0.f, 0.f};
    i32x8 At[4], B0[2], B1[2];
    const char* cA = S.a_base(cur); const char* cB = S.b_base(cur);
    const int ntm = nt - 1;
    { const size_t o0 = (size_t)(cur.rot & ntm) * kstep;
    PG8_STAGE(PG8_SB(0, 0), cB + o0, voffB); PG8_STAGE(PG8_SB(0, 1), cB + hstepB + o0, voffB); PG8_STAGE(PG8_SA(0, 0), cA + o0, voA[0]); PG8_STAGE(PG8_SA(0, 1), cA + o0, voA[1]); }
    if (wr == 1) PG8_BAR;
    PG8_WAIT_V(2); PG8_BAR;
    { const size_t o1 = (size_t)((cur.rot + 1) & ntm) * kstep;
    PG8_STAGE(PG8_SB(1, 0), cB + o1, voffB); PG8_STAGE(PG8_SA(1, 0), cA + o1, voA[0]); PG8_STAGE(PG8_SB(1, 1), cB + hstepB + o1, voffB); }
    PG8_WAIT_V(6); PG8_BAR;
    for (;;) {
        const bool has_next = S.next(ui + 1, nxt);
        const char* nA = has_next ? S.a_base(nxt) : cA; const char* nB = has_next ? S.b_base(nxt) : cB;
        if (has_next) E.prefetch(nxt, lds + EBUF_OFF + ((ui + 1) & 1) * 1024, wid, lane);
        if constexpr (GATHER) { if (has_next) S.a_ids_dma(nxt, lds + IDBUF_OFF, wid, lane); }
#pragma unroll 1
        for (int t = 0; t < nt; t += 2) {
            const bool last = (t == nt - 2);
            const int nrot = has_next ? nxt.rot : cur.rot;
            const char* a1 = cA + (size_t)((t + 1 + cur.rot) & ntm) * kstep;
            const size_t o2 = last ? (size_t)(nrot & ntm) * kstep : (size_t)((t + 2 + cur.rot) & ntm) * kstep;
            const char* a2 = (last ? nA : cA) + o2; const char* b2 = (last ? nB : cB) + o2;
            const char* a3 = a2 + kstep; const char* b3 = b2 + kstep;
            unsigned v2[2][2];
#pragma unroll
            for (int h = 0; h < 2; ++h)
#pragma unroll
                for (int i = 0; i < 2; ++i) v2[h][i] = voA[h][i];
            if constexpr (GATHER) { if (last) {
                if (has_next) {
#pragma unroll
                    for (int h = 0; h < 2; ++h)
#pragma unroll
                        for (int i = 0; i < 2; ++i) voN[h][i] = S.a_off(*(const PG8_LAS unsigned*)(lds + IDBUF_OFF + 4 * (h * HALF + RA[i])), CA[i]); }
#pragma unroll
                for (int h = 0; h < 2; ++h)
#pragma unroll
                    for (int i = 0; i < 2; ++i) v2[h][i] = voN[h][i]; } }
            PG8_LDB(B0, 0, 0); PG8_LDB(B1, 0, 1); PG8_SCHED; PG8_LDA(At, 0, 0); PG8_STAGE(PG8_SA(1, 1), a1, voA[1]);
            PG8_WAIT_V(8); PG8_WAIT_L(0); PG8_BAR; PG8_MMA(0, 0, At, B0); PG8_MMA(0, 1, At, B1); PG8_BAR; PG8_SCHED;
            PG8_LDA(At, 0, 1); PG8_STAGE(PG8_SB(0, 0), b2, voffB); PG8_STAGE(PG8_SB(0, 1), b2 + hstepB, voffB); PG8_STAGE(PG8_SA(0, 0), a2, v2[0]);
            PG8_WAIT_V(8); PG8_WAIT_L(0); PG8_BAR; PG8_MMA(1, 0, At, B0); PG8_MMA(1, 1, At, B1); PG8_BAR; PG8_SCHED;
            PG8_LDB(B0, 1, 0); PG8_LDB(B1, 1, 1); PG8_SCHED; PG8_LDA(At, 1, 0); PG8_STAGE(PG8_SA(0, 1), a2, v2[1]);
            PG8_WAIT_V(8); PG8_WAIT_L(0); PG8_BAR; PG8_MMA(0, 0, At, B0); PG8_MMA(0, 1, At, B1); PG8_BAR; PG8_SCHED;
            PG8_LDA(At, 1, 1); PG8_STAGE(PG8_SB(1, 0), b3, voffB); PG8_STAGE(PG8_SB(1, 1), b3 + hstepB, voffB); PG8_STAGE(PG8_SA(1, 0), a3, v2[0]);
            PG8_WAIT_V(8); PG8_WAIT_L(0); PG8_BAR; PG8_MMA(1, 0, At, B0); PG8_MMA(1, 1, At, B1); PG8_BAR; PG8_SCHED;
        }
        if constexpr (ALIGN_EPI) { if (wr == 0) PG8_BAR; }
        if constexpr (FP8) {
            asm volatile("s_nop 15\n\ts_nop 15" : "+v"(acc[0][0][0][0]), "+v"(acc[0][0][0][1]), "+v"(acc[0][0][1][0]), "+v"(acc[0][0][1][1]), "+v"(acc[0][0][2][0]), "+v"(acc[0][0][2][1]), "+v"(acc[0][0][3][0]), "+v"(acc[0][0][3][1]),
                         "+v"(acc[0][1][0][0]), "+v"(acc[0][1][0][1]), "+v"(acc[0][1][1][0]), "+v"(acc[0][1][1][1]), "+v"(acc[0][1][2][0]), "+v"(acc[0][1][2][1]), "+v"(acc[0][1][3][0]), "+v"(acc[0][1][3][1]));
            asm volatile("" : "+v"(acc[1][0][0][0]), "+v"(acc[1][0][0][1]), "+v"(acc[1][0][1][0]), "+v"(acc[1][0][1][1]), "+v"(acc[1][0][2][0]), "+v"(acc[1][0][2][1]), "+v"(acc[1][0][3][0]), "+v"(acc[1][0][3][1]),
                         "+v"(acc[1][1][0][0]), "+v"(acc[1][1][0][1]), "+v"(acc[1][1][1][0]), "+v"(acc[1][1][1][1]), "+v"(acc[1][1][2][0]), "+v"(acc[1][1][2][1]), "+v"(acc[1][1][3][0]), "+v"(acc[1][1][3][1])); }
        E(acc, cur, wr, wc, fr, fq, lds + EBUF_OFF + (ui & 1) * 1024);
        asm volatile("" ::: "memory"); PG8_SCHED;
        H(ui + 1);
        asm volatile("" ::: "memory"); PG8_SCHED;
        if (!has_next) break;
#pragma unroll
        for (int a = 0; a < 2; ++a)
#pragma unroll
            for (int b = 0; b < 2; ++b)
#pragma unroll
                for (int m = 0; m < 4; ++m)
#pragma unroll
                    for (int n = 0; n < 2; ++n) acc[a][b][m][n] = (f32x4){0.f, 0.f, 0.f, 0.f};
        cur = nxt; cA = nA; cB = nB; ++ui;
#pragma unroll
        for (int h = 0; h < 2; ++h)
#pragma unroll
            for (int i = 0; i < 2; ++i) voA[h][i] = voN[h][i];
        if constexpr (ALIGN_EPI) { if (wr == 1) PG8_BAR; }
    }
    PG8_WAIT_V(0);
    if constexpr (!ALIGN_EPI) { if (wr == 0) PG8_BAR; }
    PG8_BAR;
#undef PG8_SA
#undef PG8_SB
#undef PG8_STAGE
#undef PG8_LDA
#undef PG8_LDB
#undef PG8_LD8
#undef PG8_LO
#undef PG8_HI
#undef PG8_MMA
#undef PG8_WAIT_V
#undef PG8_WAIT_L
#undef PG8_BAR
#undef PG8_SCHED
}

__device__ __forceinline__ float sigmoidf_fast(float x) { return __builtin_amdgcn_rcpf(1.0f + __builtin_amdgcn_exp2f(-LOG2E * x)); }

struct EpiInProj {
    static constexpr bool PERM = true;
    bf16_t* qkv; bf16_t* gates; float* kpart;
    __device__ __forceinline__ void prefetch(const Unit&, PG8_LAS unsigned char*, int, int) const {}
    __device__ __forceinline__ void operator()(const f32x4 (&acc)[2][2][4][2], const Unit& u, int wr, int wc, int fr, int fq, const PG8_LAS unsigned char* ebuf) const {
        const int row0 = u.pm * BM + wr * 64 + fr; const int pn = u.pn;
        const int cw = wc * 32 + 8 * fq;
        if (pn < 12) {
            const float sc = (pn < 2 || pn == 6 || pn == 7) ? C2F : 1.0f;
            bf16_t* base = qkv + pn * BM + cw;
#pragma unroll
            for (int ai = 0; ai < 2; ++ai)
#pragma unroll
                for (int m = 0; m < 4; ++m) { bf16_t* rowp = base + (size_t)(row0 + ai * HALF + m * 16) * QKV_LD;
#pragma unroll
                    for (int bj = 0; bj < 2; ++bj) { const f32x4 v0 = acc[ai][bj][m][0] * sc, v1 = acc[ai][bj][m][1] * sc;
                        u32x4 w; w.x = cvt_pk_bf16(v0[0], v0[1]); w.y = cvt_pk_bf16(v0[2], v0[3]); w.z = cvt_pk_bf16(v1[0], v1[1]); w.w = cvt_pk_bf16(v1[2], v1[3]);
                        *(u32x4*)(rowp + bj * HALF) = w; } }
            if (pn == 8 || pn == 9) {
#pragma unroll
                for (int bj = 0; bj < 2; ++bj)
#pragma unroll
                    for (int n = 0; n < 2; ++n) { f32x4 s = (f32x4){0.f, 0.f, 0.f, 0.f};
#pragma unroll
                        for (int ai = 0; ai < 2; ++ai)
#pragma unroll
                            for (int m = 0; m < 4; ++m) s += acc[ai][bj][m][n];
#pragma unroll
                        for (int o = 1; o < 16; o <<= 1) { s[0] += __shfl_xor(s[0], o); s[1] += __shfl_xor(s[1], o); s[2] += __shfl_xor(s[2], o); s[3] += __shfl_xor(s[3], o); }
                        if (fr == 0) *(f32x4*)(kpart + (size_t)(u.pm * 2 + wr) * 512 + (pn - 8) * BM + bj * HALF + cw + 4 * n) = s; }
            }
        } else {
            bf16_t* base = gates + (pn - 12) * BM + cw;
#pragma unroll
            for (int ai = 0; ai < 2; ++ai)
#pragma unroll
                for (int m = 0; m < 4; ++m) { bf16_t* rowp = base + (size_t)(row0 + ai * HALF + m * 16) * GATE_LD;
#pragma unroll
                    for (int bj = 0; bj < 2; ++bj) { const f32x4 a0 = acc[ai][bj][m][0], a1 = acc[ai][bj][m][1];
                        u32x4 w; w.x = cvt_pk_bf16(sigmoidf_fast(a0[0]), sigmoidf_fast(a0[1])); w.y = cvt_pk_bf16(sigmoidf_fast(a0[2]), sigmoidf_fast(a0[3]));
                        w.z = cvt_pk_bf16(sigmoidf_fast(a1[0]), sigmoidf_fast(a1[1])); w.w = cvt_pk_bf16(sigmoidf_fast(a1[2]), sigmoidf_fast(a1[3]));
                        *(u32x4*)(rowp + bj * HALF) = w; } }
        }
    }
};

struct EpiProjGate {
    static constexpr bool PERM = true;
    const bf16_t* gates; bf16_t* merged;
    __device__ __forceinline__ void prefetch(const Unit&, PG8_LAS unsigned char*, int, int) const {}
    __device__ __forceinline__ void operator()(const f32x4 (&acc)[2][2][4][2], const Unit& u, int wr, int wc, int fr, int fq, const PG8_LAS unsigned char* ebuf) const {
        const int row0 = u.pm * BM + wr * 64 + fr; const int col0 = u.pn * BM + wc * 32 + 8 * fq; const int br = u.e;
#pragma unroll
        for (int ai = 0; ai < 2; ++ai)
#pragma unroll
            for (int m = 0; m < 4; ++m) { const size_t row = (size_t)(row0 + ai * HALF + m * 16);
#pragma unroll
                for (int bj = 0; bj < 2; ++bj) {
                    const u32x4 g = *(const u32x4*)(gates + row * GATE_LD + br * DM + col0 + bj * HALF);
                    f32x4 v0 = acc[ai][bj][m][0], v1 = acc[ai][bj][m][1];
                    v0[0] *= bf_lo(g.x); v0[1] *= bf_hi(g.x); v0[2] *= bf_lo(g.y); v0[3] *= bf_hi(g.y);
                    v1[0] *= bf_lo(g.z); v1[1] *= bf_hi(g.z); v1[2] *= bf_lo(g.w); v1[3] *= bf_hi(g.w);
                    bf16_t* op = merged + row * DM + col0 + bj * HALF;
                    if (br == 1) { const u32x4 p = *(const u32x4*)op;
                        v0[0] += bf_lo(p.x); v0[1] += bf_hi(p.x); v0[2] += bf_lo(p.y); v0[3] += bf_hi(p.y);
                        v1[0] += bf_lo(p.z); v1[1] += bf_hi(p.z); v1[2] += bf_lo(p.w); v1[3] += bf_hi(p.w); }
                    u32x4 w; w.x = cvt_pk_bf16(v0[0], v0[1]); w.y = cvt_pk_bf16(v0[2], v0[3]); w.z = cvt_pk_bf16(v1[0], v1[1]); w.w = cvt_pk_bf16(v1[2], v1[3]);
                    *(u32x4*)op = w; } }
    }
};

struct EpiResF32 {
    static constexpr bool PERM = false;
    const float* x; bf16_t* h1;
    __device__ __forceinline__ void prefetch(const Unit&, PG8_LAS unsigned char*, int, int) const {}
    __device__ __forceinline__ void operator()(const f32x4 (&acc)[2][2][4][2], const Unit& u, int wr, int wc, int fr, int fq, const PG8_LAS unsigned char* ebuf) const {
        const int row0 = u.pm * BM + wr * 64 + fr; const int col0 = u.pn * BM + wc * 32 + 4 * fq;
#pragma unroll
        for (int ai = 0; ai < 2; ++ai)
#pragma unroll
            for (int m = 0; m < 4; ++m) { const size_t off = (size_t)(row0 + ai * HALF + m * 16) * DM + col0;
#pragma unroll
                for (int bj = 0; bj < 2; ++bj)
#pragma unroll
                    for (int n = 0; n < 2; ++n) { const f32x4 b = *(const f32x4*)(x + off + bj * HALF + n * 16); const f32x4 r = b + acc[ai][bj][m][n];
                        u32x2 w; w.x = cvt_pk_bf16(r[0], r[1]); w.y = cvt_pk_bf16(r[2], r[3]); *(u32x2*)(h1 + off + bj * HALF + n * 16) = w; } }
    }
};

struct EpiSwiglu {
    static constexpr bool PERM = true;
    const float* bgu; unsigned char* act;
    __device__ __forceinline__ void prefetch(const Unit& u, PG8_LAS unsigned char* ebuf, int wid, int lane) const {
        if (wid == 4) { const float* src = bgu + (size_t)u.e * 2048 + u.pn * HALF + (lane < 32 ? 4 * lane : 1024 + 4 * (lane - 32));
            __builtin_amdgcn_global_load_lds((const unsigned*)src, (PG8_LAS unsigned*)ebuf, 16, 0, 0); }
    }
    __device__ __forceinline__ void operator()(const f32x4 (&acc)[2][2][4][2], const Unit& u, int wr, int wc, int fr, int fq, const PG8_LAS unsigned char* ebuf) const {
        const int row0 = u.pm * BM + wr * 64 + fr; const int f0 = u.pn * HALF + wc * 32 + 8 * fq;
        const PG8_LAS float* bp = (const PG8_LAS float*)ebuf + wc * 32 + 8 * fq;
        const f32x4 bg0 = *(const PG8_LAS f32x4*)(bp), bg1 = *(const PG8_LAS f32x4*)(bp + 4), bu0 = *(const PG8_LAS f32x4*)(bp + 128), bu1 = *(const PG8_LAS f32x4*)(bp + 132);
#pragma unroll
        for (int ai = 0; ai < 2; ++ai)
#pragma unroll
            for (int m = 0; m < 4; ++m) { float y[8];
#pragma unroll
                for (int n = 0; n < 2; ++n)
#pragma unroll
                    for (int j = 0; j < 4; j += 2) {
                        const f32x2 bg = n ? (f32x2){bg1[j], bg1[j + 1]} : (f32x2){bg0[j], bg0[j + 1]}, bu = (n ? (f32x2){bu1[j], bu1[j + 1]} : (f32x2){bu0[j], bu0[j + 1]}) + 1.0f;
                        f32x2 g = (f32x2){acc[ai][0][m][n][j], acc[ai][0][m][n][j + 1]} * MOE_WINV + bg; g.x = fminf(g.x, 7.0f); g.y = fminf(g.y, 7.0f);
                        f32x2 u1 = (f32x2){acc[ai][1][m][n][j], acc[ai][1][m][n][j + 1]} * MOE_WINV + bu; u1.x = fminf(fmaxf(u1.x, -6.0f), 8.0f); u1.y = fminf(fmaxf(u1.y, -6.0f), 8.0f);
                        const f32x2 t = g * (-1.702f * LOG2E); f32x2 d; d.x = __builtin_amdgcn_exp2f(t.x); d.y = __builtin_amdgcn_exp2f(t.y); d = d + 1.0f;
                        f32x2 r; r.x = __builtin_amdgcn_rcpf(d.x); r.y = __builtin_amdgcn_rcpf(d.y);
                        const f32x2 yy = (u1 * g) * r; y[n * 4 + j] = yy.x; y[n * 4 + j + 1] = yy.y; }
                unsigned char* op = act + ((size_t)(row0 + ai * HALF + m * 16) * DM + f0) * MOE_ES;
                if constexpr (MOE_FP8) { u32x2 w; w.x = pk4_fp8(y[0], y[1], y[2], y[3]); w.y = pk4_fp8(y[4], y[5], y[6], y[7]); *(u32x2*)op = w; }
                else { u32x4 w; w.x = cvt_pk_bf16(y[0], y[1]); w.y = cvt_pk_bf16(y[2], y[3]); w.z = cvt_pk_bf16(y[4], y[5]); w.w = cvt_pk_bf16(y[6], y[7]); *(u32x4*)op = w; } }
    }
};

struct EpiDown {
    static constexpr bool PERM = true;
    bf16_t* ys;
    __device__ __forceinline__ void prefetch(const Unit&, PG8_LAS unsigned char*, int, int) const {}
    __device__ __forceinline__ void operator()(const f32x4 (&acc)[2][2][4][2], const Unit& u, int wr, int wc, int fr, int fq, const PG8_LAS unsigned char* ebuf) const {
        const int row0 = u.pm * BM + wr * 64 + fr; const int col0 = u.pn * BM + wc * 32 + 8 * fq;
#pragma unroll
        for (int ai = 0; ai < 2; ++ai)
#pragma unroll
            for (int m = 0; m < 4; ++m) { bf16_t* rowp = ys + (size_t)(row0 + ai * HALF + m * 16) * DM + col0;
#pragma unroll
                for (int bj = 0; bj < 2; ++bj) { const f32x4 v0 = acc[ai][bj][m][0] * MOE_WINV, v1 = acc[ai][bj][m][1] * MOE_WINV;
                    u32x4 o; o.x = cvt_pk_bf16(v0[0], v0[1]); o.y = cvt_pk_bf16(v0[2], v0[3]); o.z = cvt_pk_bf16(v1[0], v1[1]); o.w = cvt_pk_bf16(v1[2], v1[3]);
                    *(u32x4*)(rowp + bj * HALF) = o; } }
    }
};

struct DenseOrder {
    int nM, nN, G, c; const char* A; const char* Bt; size_t astep, bstep;
    __device__ __forceinline__ bool next(int i, Unit& u) const { u.e = 0; u.aux = 0; u.rot = 0; return static_tile(i, G, c, nM, nN, u.pm, u.pn); }
    __device__ __forceinline__ const char* a_base(const Unit& u) const { return A + (size_t)u.pm * astep; }
    __device__ __forceinline__ const char* b_base(const Unit& u) const { return Bt + (size_t)u.pn * bstep; }
    __device__ __forceinline__ void a_rows(const Unit&, const int (&)[2], const int (&)[2], unsigned (&)[2][2]) const {}
    __device__ __forceinline__ unsigned a_off(unsigned raw, int) const { return raw; }
    __device__ __forceinline__ void a_ids_dma(const Unit&, PG8_LAS unsigned char*, int, int) const {}
};
struct ProjOrder {
    int G, c; const char* Y; const char* Wp;
    __device__ __forceinline__ bool next(int i, Unit& u) const { u.e = i & 1; u.aux = 0; u.rot = 0; return static_tile(i >> 1, G, c, T_TOK / BM, DM / BM, u.pm, u.pn); }
    __device__ __forceinline__ const char* a_base(const Unit& u) const { return Y + ((size_t)u.pm * BM * DM + u.e * 512) * 2; }
    __device__ __forceinline__ const char* b_base(const Unit& u) const { return Wp + ((size_t)u.pn * BM * DM + u.e * 512) * 2; }
    __device__ __forceinline__ void a_rows(const Unit&, const int (&)[2], const int (&)[2], unsigned (&)[2][2]) const {}
    __device__ __forceinline__ unsigned a_off(unsigned raw, int) const { return raw; }
    __device__ __forceinline__ void a_ids_dma(const Unit&, PG8_LAS unsigned char*, int, int) const {}
};
struct MoeOrder {
    int NT, nN, G, c; const PG8_LAS int* tile_e; const PG8_LAS int* tileoff; const PG8_LAS int* cnt;
    const char* A; const char* Bt; size_t astep, bstep, bexp; const int* list; int lda; bool gather;
    int rep;
    __device__ __forceinline__ bool next(int i, Unit& u) const { const int per = (NT * nN + G - 1) / G; if (i >= per * rep) return false; if (!static_tile(i % per, G, c, NT, nN, u.pm, u.pn)) return false; u.e = tile_e[u.pm]; u.aux = u.pm - tileoff[u.e]; u.rot = MOE_KROT * ((u.pm + u.pn) & 1); return true; }
    __device__ __forceinline__ const char* a_base(const Unit& u) const { return gather ? A : A + (size_t)u.pm * astep; }
    __device__ __forceinline__ const char* b_base(const Unit& u) const { return Bt + (size_t)u.e * bexp + (size_t)u.pn * bstep; }
    __device__ __forceinline__ void a_rows(const Unit& u, const int (&RA)[2], const int (&CA)[2], unsigned (&vo)[2][2]) const {
        const int n = cnt[u.e] - u.aux * BM; const int* lp = list + (size_t)u.e * LIST_CAP + u.aux * BM;
#pragma unroll
        for (int h = 0; h < 2; ++h)
#pragma unroll
            for (int i = 0; i < 2; ++i) { const int r = h * HALF + RA[i]; vo[h][i] = (unsigned)lp[r < n ? r : n - 1]; }
    }
    __device__ __forceinline__ void a_ids_dma(const Unit& u, PG8_LAS unsigned char* idbuf, int wid, int lane) const {
        if (wid < 4) { const int n = cnt[u.e] - u.aux * BM; const int r = wid * 64 + lane; const int* src = list + (size_t)u.e * LIST_CAP + u.aux * BM + (r < n ? r : n - 1);
            __builtin_amdgcn_global_load_lds((const unsigned*)src, (PG8_LAS unsigned*)(idbuf + wid * 256), 4, 0, 0); }
    }
    __device__ __forceinline__ unsigned a_off(unsigned raw, int ca) const { return (unsigned)(((int)raw >> 2) * lda + ca * 2); }
};
}

namespace att {
typedef unsigned short bf16;
using bf16x8 = __attribute__((ext_vector_type(8))) short;
using s16x4 = __attribute__((ext_vector_type(4))) short;
using f32x16 = __attribute__((ext_vector_type(16))) float;
using u32x4 = __attribute__((ext_vector_type(4))) unsigned;
using f32x4 = __attribute__((ext_vector_type(4))) float;
constexpr int NW = 8, KVBLK = 64, NSLOT = 3, SLOTB = 8192, PITCH = QKV_LD;
constexpr int LDS_K = 0, LDS_V = NSLOT * SLOTB, LDS_WS = 2 * NSLOT * SLOTB, LDS_OST = LDS_WS + NW * 64 * 4, LDS_KM = LDS_OST + NW * 4096, LDS_LUT = LDS_KM + 2048, LDS_FLG = LDS_LUT + 512, LDS_BYTES = LDS_FLG + 64;
__device__ __forceinline__ int crow(int r, int hi) { return (r & 3) + 8 * (r >> 2) + 4 * hi; }
#define SBAR() __builtin_amdgcn_sched_barrier(0)
__device__ __forceinline__ void glds16(const void* gsrc, unsigned lds_dst) { unsigned keep;
    asm volatile("s_mov_b32 %0, m0\n\ts_mov_b32 m0, %2\n\ts_nop 0\n\tglobal_load_lds_dwordx4 %1, off\n\ts_mov_b32 m0, %0" : "=&s"(keep) : "v"(gsrc), "s"(lds_dst) : "memory"); }
typedef float f32x2_t __attribute__((ext_vector_type(2))); typedef __bf16 bf16x2_t __attribute__((ext_vector_type(2)));
__device__ __forceinline__ unsigned cvtpk_s(float lo, float hi) { f32x2_t v = {lo, hi}; bf16x2_t b = __builtin_convertvector(v, bf16x2_t); return __builtin_bit_cast(unsigned, b); }
#define WAIT_BAR(N) asm volatile("s_waitcnt vmcnt(" #N ") lgkmcnt(0)\n\ts_barrier" ::: "memory")
typedef __attribute__((address_space(3))) const char* lds_cptr;

__device__ __forceinline__ void qkt(f32x16& p0, f32x16& p1, lds_cptr Kslot, const bf16x8* qr, const f32x16& c0, int r32, int hi) {
    lds_cptr kb = Kslot + hi * 1024 + r32 * 16;
#pragma unroll
    for (int d0 = 0; d0 < 4; ++d0) {
        const bf16x8 b0 = *(const __attribute__((address_space(3))) bf16x8*)(kb + d0 * 2048);
        const bf16x8 b1 = *(const __attribute__((address_space(3))) bf16x8*)(kb + d0 * 2048 + 512);
        if (d0 == 0) { p0 = __builtin_amdgcn_mfma_f32_32x32x16_bf16(b0, qr[0], c0, 0, 0, 0); p1 = __builtin_amdgcn_mfma_f32_32x32x16_bf16(b1, qr[0], c0, 0, 0, 0); }
        else { p0 = __builtin_amdgcn_mfma_f32_32x32x16_bf16(b0, qr[d0], p0, 0, 0, 0); p1 = __builtin_amdgcn_mfma_f32_32x32x16_bf16(b1, qr[d0], p1, 0, 0, 0); } }
}
__device__ __forceinline__ void pv(f32x16* o, int vb, bf16x8 pa0, bf16x8 pa1, bf16x8 pa2, bf16x8 pa3) {
#pragma unroll
    for (int d0 = 0; d0 < 2; ++d0) { s16x4 lo[4], hi[4];
#pragma unroll
        for (int ks = 0; ks < 4; ++ks) {
            asm volatile("ds_read_b64_tr_b16 %0,%1 offset:%c2" : "=&v"(lo[ks]) : "v"(vb), "i"(d0 * 4096 + ks * 1024) : "memory");
            asm volatile("ds_read_b64_tr_b16 %0,%1 offset:%c2" : "=&v"(hi[ks]) : "v"(vb), "i"(d0 * 4096 + ks * 1024 + 512) : "memory"); }
        asm volatile("s_waitcnt lgkmcnt(0)" ::: "memory"); SBAR();
#define PK(k) (bf16x8){lo[k][0], lo[k][1], lo[k][2], lo[k][3], hi[k][0], hi[k][1], hi[k][2], hi[k][3]}
        o[d0] = __builtin_amdgcn_mfma_f32_32x32x16_bf16(pa0, PK(0), o[d0], 0, 0, 0);
        o[d0] = __builtin_amdgcn_mfma_f32_32x32x16_bf16(pa1, PK(1), o[d0], 0, 0, 0);
        o[d0] = __builtin_amdgcn_mfma_f32_32x32x16_bf16(pa2, PK(2), o[d0], 0, 0, 0);
        o[d0] = __builtin_amdgcn_mfma_f32_32x32x16_bf16(pa3, PK(3), o[d0], 0, 0, 0);
#undef PK
    }
}
__device__ __forceinline__ float swap32(float v, int hi) {
    auto rr = __builtin_amdgcn_permlane32_swap(__float_as_uint(v), __float_as_uint(v), false, false);
    return __uint_as_float(hi ? rr[0] : rr[1]);
}
__device__ __forceinline__ void store_o(const f32x16* o, const float* rs, bf16* Ow, int ldo, char* shm, int wid, int lane, int r32, int hi) {
    bf16* stg = (bf16*)(shm + LDS_OST) + wid * 2048;
#pragma unroll
    for (int r = 0; r < 16; ++r) { const int orow = crow(r, hi);
#pragma unroll
        for (int d0 = 0; d0 < 2; ++d0) { const float v = o[d0][r] * rs[r]; const unsigned u = __float_as_uint(v); stg[orow * 64 + d0 * 32 + r32] = (bf16)((u + 0x7fffu + ((u >> 16) & 1u)) >> 16); } }
    asm volatile("s_waitcnt lgkmcnt(0)" ::: "memory");
#pragma unroll
    for (int i = 0; i < 4; ++i) { const int row = i * 8 + (lane >> 3), ch = lane & 7; const u32x4 v = *(const u32x4*)(stg + row * 64 + ch * 8); *(u32x4*)(Ow + (long)row * ldo + ch * 8) = v; }
}
#define PKW(P, B) cvtpk_s(P[B], P[B + 1])

__device__ __forceinline__ void sb_unit(int b, int h, int qb, const bf16* QKV, bf16* Y, char* shm) {
    int tid = threadIdx.x; asm volatile("" : "+v"(tid));
    const int lane = tid & 63, r32 = lane & 31, hi = lane >> 5; const int wid = __builtin_amdgcn_readfirstlane(tid >> 6);
    const long rowbase = (long)b * SEQ; const int q0 = qb * 256;
    const bf16* Qw = QKV + (rowbase + q0 + wid * 32) * PITCH + h * 64;
    const bf16* Kh = QKV + rowbase * PITCH + 512 + h * 64; const bf16* Vh = QKV + rowbase * PITCH + 1024 + h * 64;
    const unsigned lds0 = (unsigned)(uintptr_t)shm;
    const lds_cptr shm3 = (lds_cptr)shm;
    volatile __attribute__((address_space(3))) unsigned* flg = (volatile __attribute__((address_space(3))) unsigned*)(shm3 + LDS_FLG);
    const bf16* ksrc = Kh + (long)lane * PITCH + wid * 8;
    const bf16* vsrc = Vh + (long)(16 * (wid & 3) + (lane >> 2)) * PITCH + (wid >> 2) * 32 + (lane & 3) * 8;
    const unsigned kdst = lds0 + LDS_K + wid * 1024, vdst = lds0 + LDS_V + wid * 1024;
#define DMA_KV(t, slot) do { glds16(ksrc + (long)(t) * KVBLK * PITCH, (unsigned)__builtin_amdgcn_readfirstlane(kdst + (slot))); glds16(vsrc + (long)(t) * KVBLK * PITCH, (unsigned)__builtin_amdgcn_readfirstlane(vdst + (slot))); } while (0)
    const int vb0 = (int)(lds0 + LDS_V) + ((lane >> 4) & 1) * 32 + (lane & 3) * 8 + (4 * hi + ((lane & 15) >> 2)) * 64;
    bf16x8 qr[4];
#pragma unroll
    for (int d0 = 0; d0 < 4; ++d0) qr[d0] = *reinterpret_cast<const bf16x8*>(&Qw[(long)r32 * PITCH + d0 * 16 + hi * 8]);
    if (lane == 0) flg[wid] = 0u;
    const int ktop = 4 * qb + 3;
    DMA_KV(ktop, 0); DMA_KV(ktop - 1, SLOTB);
    f32x16 o[2]; o[0] = f32x16{}; o[1] = f32x16{}; const f32x16 zero16 = f32x16{};
    float carry = 0.f;
    const int ktd = 4 * qb + (wid >> 1);
    const int qpos = q0 + wid * 32 + r32;
    bool wdone = false;
    int sl_cur = 0, sl_n1 = SLOTB, sl_n2 = 2 * SLOTB;
    for (int kt = ktop; ; --kt) {
        if (kt > 0) { WAIT_BAR(2); } else { WAIT_BAR(0); }
        { const u32x4 f0 = *(const __attribute__((address_space(3))) u32x4*)(shm3 + LDS_FLG), f1 = *(const __attribute__((address_space(3))) u32x4*)(shm3 + LDS_FLG + 16);
          const unsigned all = f0.x & f0.y & f0.z & f0.w & f1.x & f1.y & f1.z & f1.w;
          if (__builtin_amdgcn_readfirstlane(all) != 0u) break; }
        if (kt >= 2) DMA_KV(kt - 2, sl_n2);
        if (!wdone && kt <= ktd) {
            f32x16 p0, p1;
            qkt(p0, p1, shm3 + LDS_K + sl_cur, qr, zero16, r32, hi);
            const bool diag = (kt == ktd);
            int qk = qpos - 4 * hi - 64 * kt; asm volatile("" : "+v"(qk));
            float lk[32], ls[32];
#pragma unroll
            for (int i = 0; i < 32; ++i) { const float z = (i < 16) ? p0[i] : p1[i - 16];
                const float e = __builtin_amdgcn_exp2f(-__builtin_fabsf(z)); const float l2 = __builtin_amdgcn_logf(1.0f + e);
                const float sp = __builtin_fmaxf(z, 0.f) + l2;
                float nk = -sp, lsv = z - sp;
                if (diag) { const bool valid = (8 * (i >> 2) + (i & 3)) < qk; nk = valid ? nk : 0.f; lsv = valid ? lsv : -INFINITY; }
                lk[i] = nk; ls[i] = lsv; }
            float gs[8], pg[8], S[8];
#pragma unroll
            for (int g = 0; g < 8; ++g) { gs[g] = (lk[4 * g] + lk[4 * g + 1]) + (lk[4 * g + 2] + lk[4 * g + 3]); pg[g] = swap32(gs[g], hi); }
            S[7] = 0.f;
#pragma unroll
            for (int g = 6; g >= 0; --g) S[g] = S[g + 1] + (gs[g + 1] + pg[g + 1]);
            const float tot = S[0] + (gs[0] + pg[0]);
#pragma unroll
            for (int g = 0; g < 8; ++g) { float t = carry + S[g] + (hi ? 0.f : pg[g]);
#pragma unroll
                for (int j = 3; j >= 0; --j) { const int i = 4 * g + j; const float a = __builtin_amdgcn_exp2f(ls[i] + t); t += lk[i]; if (i < 16) p0[i] = a; else p1[i - 16] = a; } }
            carry += tot;
            u32x4 pw0, pw1, pw2, pw3;
            pw0 = (u32x4){PKW(p0, 0), PKW(p0, 2), PKW(p0, 4), PKW(p0, 6)}; pw1 = (u32x4){PKW(p0, 8), PKW(p0, 10), PKW(p0, 12), PKW(p0, 14)};
            pw2 = (u32x4){PKW(p1, 0), PKW(p1, 2), PKW(p1, 4), PKW(p1, 6)}; pw3 = (u32x4){PKW(p1, 8), PKW(p1, 10), PKW(p1, 12), PKW(p1, 14)};
            SBAR();
            pv(o, vb0 + sl_cur, __builtin_bit_cast(bf16x8, pw0), __builtin_bit_cast(bf16x8, pw1), __builtin_bit_cast(bf16x8, pw2), __builtin_bit_cast(bf16x8, pw3));
            wdone = __all(carry < -36.0f);
            if (wdone && lane == 0) flg[wid] = 1u;
        }
        if (kt == 0) break;
        { const int t_ = sl_cur; sl_cur = sl_n1; sl_n1 = sl_n2; sl_n2 = t_; }
    }
    float ones[16];
#pragma unroll
    for (int r = 0; r < 16; ++r) ones[r] = 1.0f;
    store_o(o, ones, Y + (rowbase + q0 + wid * 32) * DM + h * 64, DM, shm, wid, lane, r32, hi);
    WAIT_BAR(0);
#undef DMA_KV
}

constexpr int M_BUF = 32768, M_OST = 3 * M_BUF, M_WS = M_OST + NW * 4096, M_KM = M_WS + NW * 64 * 4, M_LUT = M_KM + 2048, M_BYTES = M_LUT + 512;
static_assert(M_BYTES <= 147456, "MoBA LDS map (SCRATCH_BYTES)");
__device__ __forceinline__ float max3f(float a, float b, float c) { return __builtin_fmaxf(__builtin_fmaxf(a, b), c); }
typedef short v4i16_t __attribute__((ext_vector_type(4)));
__device__ __forceinline__ s16x4 vtr(lds_cptr p) { return __builtin_bit_cast(s16x4, __builtin_amdgcn_ds_read_tr16_b64_v4i16((__attribute__((address_space(3))) v4i16_t*)p)); }
__device__ __forceinline__ void moba_unit(int b, int h, int qb, const bf16* QKV, bf16* Y, const float* kpart, const float* rel_bias, char* shm) {
    int tid = threadIdx.x; asm volatile("" : "+v"(tid));
    const int lane = tid & 63, r32 = lane & 31, hi = lane >> 5; const int wid = __builtin_amdgcn_readfirstlane(tid >> 6);
    const long rowbase = (long)b * SEQ; const int q0 = qb * 256;
    const bf16* Qw = QKV + (rowbase + q0 + wid * 32) * PITCH + 1536 + h * 64;
    const bf16* Kh = QKV + rowbase * PITCH + 2048 + h * 64; const bf16* Vh = QKV + rowbase * PITCH + 2560 + h * 64;
    const unsigned lds0 = (unsigned)(uintptr_t)shm;
    const lds_cptr shm3 = (lds_cptr)shm;
    __attribute__((address_space(3))) float* wsf = (__attribute__((address_space(3))) float*)(shm3 + M_WS) + wid * 64;
    __attribute__((address_space(3))) float* kmean = (__attribute__((address_space(3))) float*)(shm3 + M_KM);
    __attribute__((address_space(3))) float* lut = (__attribute__((address_space(3))) float*)(shm3 + M_LUT);
    const bf16* ksrc = Kh + (long)lane * PITCH + wid * 8;
    const bf16* vsrc = Vh + (long)(16 * (wid & 3) + (lane >> 2)) * PITCH + (wid >> 2) * 32 + (lane & 3) * 8;
    const unsigned kdst = lds0 + wid * 1024, vdst = lds0 + 16384 + wid * 1024;
#define TILE2(S, i) ((S) < 2 ? 4 * qb + 2 * (S) + (i) : 2 * ((S) - 2) + (i))
#define DMA2(S, bufo) do { _Pragma("unroll") for (int i_ = 0; i_ < 2; ++i_) { const long to_ = (long)TILE2(S, i_) * KVBLK * PITCH; \
        glds16(ksrc + to_, (unsigned)__builtin_amdgcn_readfirstlane(kdst + (bufo) + i_ * 8192)); glds16(vsrc + to_, (unsigned)__builtin_amdgcn_readfirstlane(vdst + (bufo) + i_ * 8192)); } } while (0)
    { const int j = tid >> 6, d = tid & 63; const float* kp = kpart + (size_t)((b * 8 + j) * 2) * 512 + h * 64 + d; kmean[j * 64 + d] = (kp[0] + kp[512]) * (1.0f / 256.0f);
      if (tid < 128) { const int n = tid; int bk; if (n < 16) bk = n; else { bk = 16 + (int)(logf((float)n * (1.0f / 16.0f)) / 2.0794415416798357f * 16.0f); bk = bk > 31 ? 31 : bk; }
          lut[n] = rel_bias[bk * NHEAD + h] * LOG2E; } }
    bf16x8 qr[4];
#pragma unroll
    for (int d0 = 0; d0 < 4; ++d0) qr[d0] = *reinterpret_cast<const bf16x8*>(&Qw[(long)r32 * PITCH + d0 * 16 + hi * 8]);
    const int NS = 2 + 2 * qb;
    DMA2(0, 0);
    float mhat = 0.f, l_reg = 0.f; f32x16 o[2]; o[0] = f32x16{}; o[1] = f32x16{};
    const int qpos = q0 + wid * 32 + r32; unsigned selmask = 0u; float bias31 = 0.f;
    f32x16 pA0 = f32x16{}, pA1 = f32x16{};
    const lds_cptr kp0 = shm3 + hi * 1024 + r32 * 16;
    const lds_cptr vp0 = shm3 + 16384 + ((lane >> 4) & 1) * 32 + (lane & 3) * 8 + (4 * hi + ((lane & 15) >> 2)) * 64;
    int bo_cur = 0, bo_nxt = M_BUF, bo_prv = 2 * M_BUF;
    int vprev = 0;
#define MOBA_TILE(kt, ko, own, HASPREV, FIRST) do { \
        s16x4 vlo[8], vhi[8]; bf16x8 kf[8]; \
        _Pragma("unroll") for (int j_ = 0; j_ < 4; ++j_) { kf[2 * j_] = *(const __attribute__((address_space(3))) bf16x8*)(kp0 + (ko) + j_ * 2048); kf[2 * j_ + 1] = *(const __attribute__((address_space(3))) bf16x8*)(kp0 + (ko) + j_ * 2048 + 512); } \
        const int dmin_ = (q0 + wid * 32) - (64 * (kt) + 63); const bool far_ = dmin_ >= 113; \
        float nb_ = -mhat; if (!(own)) nb_ = ((selmask >> ((kt) >> 2)) & 1u) ? nb_ : -INFINITY; if (far_) nb_ += bias31; \
        f32x16 C0, C1; _Pragma("unroll") for (int r_ = 0; r_ < 16; ++r_) { C0[r_] = nb_; C1[r_] = nb_; } \
        C0 = __builtin_amdgcn_mfma_f32_32x32x16_bf16(kf[0], qr[0], C0, 0, 0, 0); C1 = __builtin_amdgcn_mfma_f32_32x32x16_bf16(kf[1], qr[0], C1, 0, 0, 0); \
        C0 = __builtin_amdgcn_mfma_f32_32x32x16_bf16(kf[2], qr[1], C0, 0, 0, 0); C1 = __builtin_amdgcn_mfma_f32_32x32x16_bf16(kf[3], qr[1], C1, 0, 0, 0); \
        C0 = __builtin_amdgcn_mfma_f32_32x32x16_bf16(kf[4], qr[2], C0, 0, 0, 0); C1 = __builtin_amdgcn_mfma_f32_32x32x16_bf16(kf[5], qr[2], C1, 0, 0, 0); \
        C0 = __builtin_amdgcn_mfma_f32_32x32x16_bf16(kf[6], qr[3], C0, 0, 0, 0); C1 = __builtin_amdgcn_mfma_f32_32x32x16_bf16(kf[7], qr[3], C1, 0, 0, 0); \
        if (HASPREV) { _Pragma("unroll") for (int i_ = 0; i_ < 8; ++i_) { vlo[i_] = vtr(vp0 + vprev + ((i_ >> 2) * 4096 + (i_ & 3) * 1024)); vhi[i_] = vtr(vp0 + vprev + ((i_ >> 2) * 4096 + (i_ & 3) * 1024 + 512)); } } \
        u32x4 pw0, pw1, pw2, pw3; \
        if (HASPREV) { float sa_ = 0.f, sb_ = 0.f; _Pragma("unroll") for (int r_ = 0; r_ < 16; ++r_) { sa_ += pA0[r_]; sb_ += pA1[r_]; } l_reg += sa_ + sb_; \
            pw0 = (u32x4){PKW(pA0, 0), PKW(pA0, 2), PKW(pA0, 4), PKW(pA0, 6)}; pw1 = (u32x4){PKW(pA0, 8), PKW(pA0, 10), PKW(pA0, 12), PKW(pA0, 14)}; \
            pw2 = (u32x4){PKW(pA1, 0), PKW(pA1, 2), PKW(pA1, 4), PKW(pA1, 6)}; pw3 = (u32x4){PKW(pA1, 8), PKW(pA1, 10), PKW(pA1, 12), PKW(pA1, 14)}; \
            asm volatile("" : "+v"(pw0), "+v"(pw1), "+v"(pw2), "+v"(pw3), "+v"(l_reg));     \
            __builtin_amdgcn_sched_group_barrier(0x100, 8, 0); __builtin_amdgcn_sched_group_barrier(0x002, 32, 0); \
            _Pragma("unroll") for (int g_ = 0; g_ < 8; ++g_) { __builtin_amdgcn_sched_group_barrier(0x008, 1, 0); __builtin_amdgcn_sched_group_barrier(0x002, 6, 0); __builtin_amdgcn_sched_group_barrier(0x100, 2, 0); } } \
        if (!far_) { int qk_ = qpos - 4 * hi - 64 * (kt); asm volatile("" : "+v"(qk_)); \
            _Pragma("unroll") for (int i_ = 0; i_ < 32; ++i_) { const int dist_ = qk_ - (8 * (i_ >> 2) + (i_ & 3)); const int dc_ = dist_ < 0 ? 0 : (dist_ > 127 ? 127 : dist_); \
                const float bb_ = lut[dc_]; float x_ = (i_ < 16) ? C0[i_ & 15] : C1[i_ & 15]; x_ = (dist_ < 0) ? -INFINITY : x_ + bb_; if (i_ < 16) C0[i_ & 15] = x_; else C1[i_ & 15] = x_; \
                if ((i_ & 7) == 7) asm volatile("" ::: "memory"); } } \
        float ra_ = max3f(C0[0], C0[1], C1[0]), rb_ = max3f(C0[2], C0[3], C1[1]); ra_ = max3f(ra_, C1[2], C1[3]); \
        _Pragma("unroll") for (int r_ = 4; r_ < 16; r_ += 4) { ra_ = max3f(ra_, C0[r_], C0[r_ + 1]); rb_ = max3f(rb_, C0[r_ + 2], C0[r_ + 3]); ra_ = max3f(ra_, C1[r_], C1[r_ + 1]); rb_ = max3f(rb_, C1[r_ + 2], C1[r_ + 3]); } \
        float rm_ = __builtin_fmaxf(ra_, rb_); rm_ = __builtin_fmaxf(rm_, swap32(rm_, hi)); \
        bool resc_ = false; \
        if (__builtin_expect((FIRST) || __any(rm_ > 8.0f), 0)) { const float dl_ = (FIRST) ? rm_ : __builtin_fmaxf(rm_, 0.f); mhat += dl_; \
            _Pragma("unroll") for (int r_ = 0; r_ < 16; ++r_) { asm volatile("v_sub_f32 %0, %0, %1" : "+v"(C0[r_]) : "v"(dl_)); asm volatile("v_sub_f32 %0, %0, %1" : "+v"(C1[r_]) : "v"(dl_)); } \
            if (!(FIRST)) { const float f_ = __builtin_amdgcn_exp2f(-dl_); l_reg *= f_; if (hi == 0) wsf[r32] = f_; resc_ = true; } } \
        if (HASPREV) { asm volatile("" : "+v"(pw0), "+v"(pw1), "+v"(pw2), "+v"(pw3));     \
            o[0] = __builtin_amdgcn_mfma_f32_32x32x16_bf16(__builtin_bit_cast(bf16x8, pw0), (bf16x8){vlo[0][0], vlo[0][1], vlo[0][2], vlo[0][3], vhi[0][0], vhi[0][1], vhi[0][2], vhi[0][3]}, o[0], 0, 0, 0); \
            o[1] = __builtin_amdgcn_mfma_f32_32x32x16_bf16(__builtin_bit_cast(bf16x8, pw0), (bf16x8){vlo[4][0], vlo[4][1], vlo[4][2], vlo[4][3], vhi[4][0], vhi[4][1], vhi[4][2], vhi[4][3]}, o[1], 0, 0, 0); \
            o[0] = __builtin_amdgcn_mfma_f32_32x32x16_bf16(__builtin_bit_cast(bf16x8, pw1), (bf16x8){vlo[1][0], vlo[1][1], vlo[1][2], vlo[1][3], vhi[1][0], vhi[1][1], vhi[1][2], vhi[1][3]}, o[0], 0, 0, 0); \
            o[1] = __builtin_amdgcn_mfma_f32_32x32x16_bf16(__builtin_bit_cast(bf16x8, pw1), (bf16x8){vlo[5][0], vlo[5][1], vlo[5][2], vlo[5][3], vhi[5][0], vhi[5][1], vhi[5][2], vhi[5][3]}, o[1], 0, 0, 0); \
            o[0] = __builtin_amdgcn_mfma_f32_32x32x16_bf16(__builtin_bit_cast(bf16x8, pw2), (bf16x8){vlo[2][0], vlo[2][1], vlo[2][2], vlo[2][3], vhi[2][0], vhi[2][1], vhi[2][2], vhi[2][3]}, o[0], 0, 0, 0); \
            o[1] = __builtin_amdgcn_mfma_f32_32x32x16_bf16(__builtin_bit_cast(bf16x8, pw2), (bf16x8){vlo[6][0], vlo[6][1], vlo[6][2], vlo[6][3], vhi[6][0], vhi[6][1], vhi[6][2], vhi[6][3]}, o[1], 0, 0, 0); \
            o[0] = __builtin_amdgcn_mfma_f32_32x32x16_bf16(__builtin_bit_cast(bf16x8, pw3), (bf16x8){vlo[3][0], vlo[3][1], vlo[3][2], vlo[3][3], vhi[3][0], vhi[3][1], vhi[3][2], vhi[3][3]}, o[0], 0, 0, 0); \
            o[1] = __builtin_amdgcn_mfma_f32_32x32x16_bf16(__builtin_bit_cast(bf16x8, pw3), (bf16x8){vlo[7][0], vlo[7][1], vlo[7][2], vlo[7][3], vhi[7][0], vhi[7][1], vhi[7][2], vhi[7][3]}, o[1], 0, 0, 0); } \
        _Pragma("unroll") for (int r_ = 0; r_ < 16; ++r_) { pA0[r_] = __builtin_amdgcn_exp2f(C0[r_]); pA1[r_] = __builtin_amdgcn_exp2f(C1[r_]); } \
        if (HASPREV) { _Pragma("unroll") for (int g_ = 0; g_ < 8; ++g_) { __builtin_amdgcn_sched_group_barrier(0x008, 1, 0); __builtin_amdgcn_sched_group_barrier(0x400, 4, 0); } } \
        if (resc_) { asm volatile("s_waitcnt lgkmcnt(0)" ::: "memory"); \
            _Pragma("unroll") for (int r_ = 0; r_ < 16; ++r_) { const float fr_ = wsf[crow(r_, hi)]; o[0][r_] *= fr_; o[1][r_] *= fr_; } } \
    } while (0)
#pragma unroll 1
    for (int S = 0; S < NS; ++S) {
        WAIT_BAR(0);
        if (S + 1 < NS) DMA2(S + 1, bo_nxt);
        if (S == 0) {
            bias31 = lut[127];
            __attribute__((address_space(3))) float* gsh = (__attribute__((address_space(3))) float*)(shm3 + 2 * M_BUF) + wid * 1024;
#pragma unroll 1
            for (int j = 0; j < qb; ++j) { float a = 0.f;
#pragma unroll
                for (int d0 = 0; d0 < 4; ++d0) { const f32x4 k0 = *(const __attribute__((address_space(3))) f32x4*)(kmean + j * 64 + d0 * 16 + hi * 8), k1 = *(const __attribute__((address_space(3))) f32x4*)(kmean + j * 64 + d0 * 16 + hi * 8 + 4);
                    const bf16x8 q = qr[d0];
                    a += __uint_as_float((unsigned)(unsigned short)q[0] << 16) * k0[0] + __uint_as_float((unsigned)(unsigned short)q[1] << 16) * k0[1] + __uint_as_float((unsigned)(unsigned short)q[2] << 16) * k0[2] + __uint_as_float((unsigned)(unsigned short)q[3] << 16) * k0[3]
                       + __uint_as_float((unsigned)(unsigned short)q[4] << 16) * k1[0] + __uint_as_float((unsigned)(unsigned short)q[5] << 16) * k1[1] + __uint_as_float((unsigned)(unsigned short)q[6] << 16) * k1[2] + __uint_as_float((unsigned)(unsigned short)q[7] << 16) * k1[3]; }
                gsh[j * 64 + lane] = a + swap32(a, hi); }
            asm volatile("s_waitcnt lgkmcnt(0)" ::: "memory");
            float g[8];
#pragma unroll
            for (int j = 0; j < 8; ++j) { g[j] = -INFINITY; if (j < qb) g[j] = gsh[j * 64 + lane]; }
#pragma unroll
            for (int j = 0; j < 8; ++j) if (j < qb) { int rank = 0;
#pragma unroll
                for (int i = 0; i < 8; ++i) if (i != j && i < qb) rank += (g[i] > g[j] || (g[i] == g[j] && i < j)) ? 1 : 0;
                if (rank < 3) selmask |= 1u << j; }
            asm volatile("s_waitcnt lgkmcnt(0)" ::: "memory");
            { const int kt0 = TILE2(0, 0), kt1 = TILE2(0, 1);
              MOBA_TILE(kt0, bo_cur, true, false, true); vprev = bo_cur;
              MOBA_TILE(kt1, bo_cur + 8192, true, true, false); vprev = bo_cur + 8192; }
        } else {
            const bool own = S < 2; const int kt0 = TILE2(S, 0), kt1 = TILE2(S, 1);
            MOBA_TILE(kt0, bo_cur, own, true, false); vprev = bo_cur;
            MOBA_TILE(kt1, bo_cur + 8192, own, true, false); vprev = bo_cur + 8192;
        }
        { const int t_ = bo_prv; bo_prv = bo_cur; bo_cur = bo_nxt; bo_nxt = t_; }
    }
    int tid_e = threadIdx.x; asm volatile("" : "+v"(tid_e));
    const int lane_e = tid_e & 63, r32_e = lane_e & 31, hi_e = lane_e >> 5; const int wid_e = __builtin_amdgcn_readfirstlane(tid_e >> 6);
    __attribute__((address_space(3))) float* wsf_e = (__attribute__((address_space(3))) float*)(shm3 + M_WS) + wid_e * 64;
    { float sa = 0.f, sb = 0.f;
#pragma unroll
      for (int r = 0; r < 16; ++r) { sa += pA0[r]; sb += pA1[r]; }
      l_reg += sa + sb;
      u32x4 pw0, pw1, pw2, pw3;
      pw0 = (u32x4){PKW(pA0, 0), PKW(pA0, 2), PKW(pA0, 4), PKW(pA0, 6)}; pw1 = (u32x4){PKW(pA0, 8), PKW(pA0, 10), PKW(pA0, 12), PKW(pA0, 14)};
      pw2 = (u32x4){PKW(pA1, 0), PKW(pA1, 2), PKW(pA1, 4), PKW(pA1, 6)}; pw3 = (u32x4){PKW(pA1, 8), PKW(pA1, 10), PKW(pA1, 12), PKW(pA1, 14)};
      SBAR();
      pv(o, (int)((unsigned)(uintptr_t)shm + 16384) + vprev + ((lane_e >> 4) & 1) * 32 + (lane_e & 3) * 8 + (4 * hi_e + ((lane_e & 15) >> 2)) * 64, __builtin_bit_cast(bf16x8, pw0), __builtin_bit_cast(bf16x8, pw1), __builtin_bit_cast(bf16x8, pw2), __builtin_bit_cast(bf16x8, pw3)); }
    l_reg += swap32(l_reg, hi_e);
    if (hi_e == 0) wsf_e[32 + r32_e] = l_reg; asm volatile("s_waitcnt lgkmcnt(0)" ::: "memory");
    float rli[16];
#pragma unroll
    for (int r = 0; r < 16; ++r) rli[r] = __builtin_amdgcn_rcpf(wsf_e[32 + crow(r, hi_e)]);
    store_o(o, rli, Y + ((long)b * SEQ + qb * 256 + wid_e * 32) * DM + 512 + h * 64, DM, shm + (M_OST - LDS_OST), wid_e, lane_e, r32_e, hi_e);
    WAIT_BAR(0);
#undef MOBA_TILE
#undef DMA2
#undef TILE2
}
#undef PKW
#undef SBAR
#undef WAIT_BAR
}

constexpr size_t MiB = 1u << 20;
constexpr size_t WS_CTL = 0, CTL_ZERO_BYTES = 1 * MiB;
constexpr size_t WS_WIN = 2 * MiB;
constexpr size_t WS_WPROJ = 12 * MiB;
constexpr size_t WS_WOUT = 14 * MiB;
constexpr size_t WS_WGU = 16 * MiB;
constexpr size_t WS_WD = 144 * MiB;
constexpr size_t WS_XN = 208 * MiB;
constexpr size_t WS_QKV = 240 * MiB;
constexpr size_t WS_GATES = 336 * MiB;
constexpr size_t WS_Y = 400 * MiB;
constexpr size_t WS_MERGED = 432 * MiB;
constexpr size_t WS_H1 = 464 * MiB;
constexpr size_t WS_HN = 528 * MiB;
constexpr size_t WS_ACT = 560 * MiB;
constexpr size_t WS_YSLOT = 704 * MiB;
constexpr size_t WS_LIST = 848 * MiB;
constexpr size_t WS_TOPW = 850 * MiB;
constexpr size_t WS_KPART = 851 * MiB;
constexpr size_t WS_TOKENT = 852 * MiB;
constexpr size_t WS_END = 853 * MiB;
constexpr int CW_TMO = 0, CW_CODE = 1;
constexpr int CW_CNT = 8192;
constexpr int CW_BAR = 4096;

constexpr int RING_OFF = 0, RING_BYTES = 131072;
constexpr int SCRATCH_BYTES = 147456;
constexpr int LDSCTL_OFF = SCRATCH_BYTES;
constexpr int L_MISC = LDSCTL_OFF;
constexpr int L_CNT = LDSCTL_OFF + 128;
constexpr int L_TOFF = LDSCTL_OFF + 256;
constexpr int L_TILEE = LDSCTL_OFF + 512;
constexpr int L_HIST = LDSCTL_OFF + 2048;
constexpr int L_BASE = LDSCTL_OFF + 2176;
constexpr int L_TMP = LDSCTL_OFF + 2304;
constexpr int LDS_BYTES = LDSCTL_OFF + 8192;
constexpr int NWAVES = 8;

#define GAS __attribute__((address_space(1)))
#define LAS __attribute__((address_space(3)))
typedef unsigned short bf16;
typedef unsigned v4u __attribute__((ext_vector_type(4)));
typedef unsigned v2u __attribute__((ext_vector_type(2)));
typedef float f32x4 __attribute__((ext_vector_type(4)));
typedef GAS unsigned gu32;
#define RLX_AGENT __ATOMIC_RELAXED, __HIP_MEMORY_SCOPE_AGENT
#define LDS_WAIT() asm volatile("s_waitcnt lgkmcnt(0)" ::: "memory")
__device__ __forceinline__ unsigned f2bf(float f) { unsigned u = __builtin_bit_cast(unsigned, f); return (u + 0x7fffu + ((u >> 16) & 1u)) >> 16; }
__device__ __forceinline__ unsigned pk2(float lo, float hi) { return f2bf(lo) | (f2bf(hi) << 16); }

#define XB_TMO      128
#define XB_XCNT(j)  (256  + 64 * (j))
#define XB_XSUB(j)  (1280 + 64 * (j))
#define XB_XGEN(j)  (2304 + 64 * (j))
#define XB_TOP      3328
#define XB_TOPGEN   3392
#define XCD_BAR_WORDS 3456
#define XB_SPIN_CAP (1u << 18)
__device__ __forceinline__ unsigned xb_ld(unsigned* p)              { return __hip_atomic_load(p, __ATOMIC_RELAXED, __HIP_MEMORY_SCOPE_AGENT); }
__device__ __forceinline__ unsigned xb_add(unsigned* p, unsigned v) { return __hip_atomic_fetch_add(p, v, __ATOMIC_RELAXED, __HIP_MEMORY_SCOPE_AGENT); }
__device__ __forceinline__ unsigned xb_xcc_id() { return (unsigned)__builtin_amdgcn_s_getreg((3 << 11) | 20) & 0xFu; }
#define XB_SPIN(cond, bar) do { unsigned _sp = 0; while (cond) { __builtin_amdgcn_s_sleep(1); \
    if ((++_sp & 255u) == 0u) { if (xb_ld(&(bar)[XB_TMO])) break; if (_sp > XB_SPIN_CAP) { atomicAdd(&(bar)[XB_TMO], 1u); break; } } } } while (0)
struct XcdBarrier { unsigned* bar; unsigned x; volatile LAS unsigned* st; };
__device__ __forceinline__ XcdBarrier xcd_barrier_post(unsigned* bar, volatile LAS unsigned* st) {
    XcdBarrier b; b.bar = bar; b.x = xb_xcc_id(); b.st = st;
    if (threadIdx.x == 0) (void)xb_add(&bar[XB_XCNT(b.x)], 1u);
    return b;
}
__device__ __forceinline__ void xcd_barrier_complete(unsigned* bar, unsigned x, unsigned& nloc, unsigned& nx) {
    const unsigned G = gridDim.x * gridDim.y * gridDim.z;
    unsigned sum, cnt, mine, sp = 0u;
    for (;;) {
        sum = 0u; cnt = 0u; mine = 0u;
#pragma unroll
        for (unsigned j = 0; j < 16; ++j) { const unsigned c = xb_ld(&bar[XB_XCNT(j)]); sum += c; cnt += (c > 0u) ? 1u : 0u; mine = (j == x) ? c : mine; }
        if (sum == G) break;
        __builtin_amdgcn_s_sleep(1);
        if ((++sp & 255u) == 0u) { if (xb_ld(&bar[XB_TMO])) break; if (sp > XB_SPIN_CAP) { atomicAdd(&bar[XB_TMO], 1u); break; } }
    }
    nloc = mine > 0u ? mine : 1u; nx = cnt > 0u ? cnt : 1u;
}
__device__ __forceinline__ void xcd_barrier(const XcdBarrier& b) {
    asm volatile("s_waitcnt vmcnt(0)" ::: "memory");
    __syncthreads();
    if (threadIdx.x == 0) {
        unsigned* bar = b.bar;
        __builtin_amdgcn_s_waitcnt(0);
        unsigned nloc = b.st[0], nx = b.st[1];
        if (nloc == 0u) { xcd_barrier_complete(bar, b.x, nloc, nx); b.st[0] = nloc; b.st[1] = nx; }
        const unsigned old = xb_add(&bar[XB_XSUB(b.x)], 1u);
        const unsigned gen = old / nloc;
        if (old + 1u == (gen + 1u) * nloc) {
            __builtin_amdgcn_fence(__ATOMIC_RELEASE, "agent");
            asm volatile("s_waitcnt vmcnt(0)" ::: "memory");
            const unsigned og = xb_add(&bar[XB_TOP], 1u);
            const unsigned tg = og / nx;
            if (og + 1u == (tg + 1u) * nx) xb_add(&bar[XB_TOPGEN], 1u);
            else XB_SPIN(xb_ld(&bar[XB_TOPGEN]) == tg, bar);
            __builtin_amdgcn_fence(__ATOMIC_ACQUIRE, "agent");
            xb_add(&bar[XB_XGEN(b.x)], 1u);
            asm volatile("s_waitcnt vmcnt(0)" ::: "memory");
        } else {
            XB_SPIN(xb_ld(&bar[XB_XGEN(b.x)]) == gen, bar);
            __builtin_amdgcn_fence(__ATOMIC_ACQUIRE, "agent");
            asm volatile("s_waitcnt vmcnt(0)" ::: "memory");
        }
    }
    __syncthreads();
}

struct Frame {
    LAS unsigned char* lds; gu32* ctl; int tid, lane, wave, vcu, G;
    const float *x, *norm_mix_g, *w_in, *w_proj_sb, *w_proj_moba, *w_out, *rel_bias, *norm_ffn_g, *w_router, *b_router, *w_gate_up, *b_gate_up, *w_down, *b_down, *norm_final_g;
    float* out; unsigned char* ws;
};
__device__ __forceinline__ float wave_sum(float v) {
#pragma unroll
    for (int o = 1; o < 64; o <<= 1) v += __shfl_xor(v, o);
    return v;
}
template <bool FP8> struct P0Item { const float* src; unsigned char* dst; int ldw, ldtB; float scale; };
template <bool FP8>
__device__ __forceinline__ P0Item<FP8> p0_mk(const float* W, int ldw, int k0, int n0, unsigned char* WT, int ldtB, int dst_row0, int kdstB, int lane, float scale) {
    constexpr int KL = FP8 ? 16 : 8; const int lk = lane >> 3, ln = lane & 7;
    P0Item<FP8> it; it.src = W + (size_t)(k0 + KL * lk) * ldw + n0 + 4 * ln; it.dst = WT + (size_t)(dst_row0 + 4 * ln) * ldtB + kdstB + (size_t)(k0 + KL * lk) * (FP8 ? 1 : 2); it.ldw = ldw; it.ldtB = ldtB; it.scale = scale; return it;
}
template <bool FP8, int KL>
__device__ __forceinline__ void p0_load(const P0Item<FP8>& it, f32x4 (&v)[KL]) {
    const GAS f32x4* src = (const GAS f32x4*)it.src;
#pragma unroll
    for (int i = 0; i < KL; ++i) v[i] = __builtin_nontemporal_load(src + (size_t)i * (it.ldw / 4));
}
template <bool FP8, int KL>
__device__ __forceinline__ void p0_store(const P0Item<FP8>& it, const f32x4 (&v)[KL]) {
    const float scale = it.scale;
#pragma unroll
    for (int j = 0; j < 4; ++j) { v4u o;
        if constexpr (FP8) { o.x = pg8::pk4_fp8(v[0][j] * scale, v[1][j] * scale, v[2][j] * scale, v[3][j] * scale); o.y = pg8::pk4_fp8(v[4][j] * scale, v[5][j] * scale, v[6][j] * scale, v[7][j] * scale);
            o.z = pg8::pk4_fp8(v[8][j] * scale, v[9][j] * scale, v[10][j] * scale, v[11][j] * scale); o.w = pg8::pk4_fp8(v[12][j] * scale, v[13][j] * scale, v[14][j] * scale, v[15][j] * scale); }
        else { o.x = pg8::cvt_pk_bf16(v[0][j], v[1][j]); o.y = pg8::cvt_pk_bf16(v[2][j], v[3][j]); o.z = pg8::cvt_pk_bf16(v[4][j], v[5][j]); o.w = pg8::cvt_pk_bf16(v[6][j], v[7][j]); }
        *(GAS v4u*)(it.dst + (size_t)j * it.ldtB) = o; }
}
template <bool FP8>
__device__ __forceinline__ void p0_item(const float* W, int ldw, int k0, int n0, unsigned char* WT, int ldtB, int dst_row0, int kdstB, int lane, float scale) {
    constexpr int KL = FP8 ? 16 : 8;
    const P0Item<FP8> it = p0_mk<FP8>(W, ldw, k0, n0, WT, ldtB, dst_row0, kdstB, lane, scale);
    f32x4 v[KL]; p0_load<FP8, KL>(it, v); p0_store<FP8, KL>(it, v);
}
constexpr int EX_KI = MOE_FP8 ? 128 : 64;
constexpr int EX_GU_PER = (1024 / EX_KI) * 64, EX_D_PER = (1024 / EX_KI) * 32, EX_I_GU = 32 * EX_GU_PER, EX_I_D = 32 * EX_D_PER, EX_ITEMS = EX_I_GU + EX_I_D;
__device__ __forceinline__ P0Item<MOE_FP8> expert_item(Frame& F, int r) {
    unsigned char* WGU = F.ws + WS_WGU; unsigned char* WD = F.ws + WS_WD;
    if (r < EX_I_GU) { const int e = r / EX_GU_PER, q = r % EX_GU_PER, kb = q >> 6, nb = q & 63, n0 = 32 * nb;
        const int cc = n0 & 1023, drow = (cc >> 7) * 256 + (n0 >= 1024 ? 128 : 0) + (cc & 127);
        return p0_mk<MOE_FP8>(F.w_gate_up + (size_t)e * 1024 * 2048, 2048, EX_KI * kb, n0, WGU + (size_t)e * 2048 * 1024 * MOE_ES, 1024 * MOE_ES, drow, 0, F.lane, MOE_WSCALE); }
    r -= EX_I_GU; const int e = r / EX_D_PER, q = r % EX_D_PER, kb = q >> 5, nb = q & 31;
    return p0_mk<MOE_FP8>(F.w_down + (size_t)e * 1024 * 1024, 1024, EX_KI * kb, 32 * nb, WD + (size_t)e * 1024 * 1024 * MOE_ES, 1024 * MOE_ES, 32 * nb, 0, F.lane, MOE_WSCALE);
}
template <int NI>
__device__ __forceinline__ void conv_chunks(Frame& F, int& conv_k, const int n) {
    constexpr int KLE = MOE_FP8 ? 16 : 8; const int gw = F.vcu * NWAVES + F.wave, NGW = F.G * NWAVES;
    for (int c = 0; c < n && conv_k + NI <= 12; ++c, conv_k += NI) {
        P0Item<MOE_FP8> it[NI]; f32x4 v[NI][KLE];
#pragma unroll
        for (int q = 0; q < NI; ++q) { const int k = conv_k + q; const int i = k < 8 ? gw + k * NGW : EX_I_GU + gw + (k - 8) * NGW; it[q] = expert_item(F, i); p0_load<MOE_FP8, KLE>(it[q], v[q]); }
#pragma unroll
        for (int q = 0; q < NI; ++q) p0_store<MOE_FP8, KLE>(it[q], v[q]); }
}
template <int NI> struct ConvHookT { Frame* F; int* conv_k; unsigned long long counts;
    __device__ __forceinline__ void operator()(int site) const { const int n = site < 16 ? (int)((counts >> (4 * site)) & 15ull) : 0; if (n) conv_chunks<NI>(*F, *conv_k, n); } };
__device__ __forceinline__ void p0_prologue(Frame& F, const int which) {
    const int gw = F.vcu * NWAVES + F.wave, NGW = F.G * NWAVES;
    unsigned char* WIN = F.ws + WS_WIN; unsigned char* WPROJ = F.ws + WS_WPROJ; unsigned char* WOUT = F.ws + WS_WOUT;
    constexpr int I_IN = 16 * 160, I_PS = 8 * 32, I_PM = 8 * 32, I_OUT = 16 * 32, I_GU = EX_I_GU, I_D = EX_I_D;
    constexpr int NITEMS = I_IN + I_PS + I_PM + I_OUT + I_GU + I_D;
    if (which & 2) {
        constexpr int KLE = MOE_FP8 ? 16 : 8; constexpr int I_E = EX_ITEMS;
        int it = gw;
#pragma unroll 1
        for (; it + NGW < I_E; it += 2 * NGW) { const P0Item<MOE_FP8> a = expert_item(F, it), b = expert_item(F, it + NGW); f32x4 va[KLE], vb[KLE];
            p0_load<MOE_FP8, KLE>(a, va); p0_load<MOE_FP8, KLE>(b, vb); p0_store<MOE_FP8, KLE>(a, va); p0_store<MOE_FP8, KLE>(b, vb); }
        if (it < I_E) { const P0Item<MOE_FP8> a = expert_item(F, it); f32x4 va[KLE]; p0_load<MOE_FP8, KLE>(a, va); p0_store<MOE_FP8, KLE>(a, va); }
    }
    if (!(which & 1)) return;
    for (int it = I_GU + I_D + gw; it < NITEMS; it += NGW) {
        int r = it - I_GU - I_D;
        if (r < I_IN) { const int kb = r / 160, nb = r % 160; p0_item<false>(F.w_in, DIN, 64 * kb, 32 * nb, WIN, 2048, 32 * nb, 0, F.lane, 1.f); continue; } r -= I_IN;
        if (r < I_PS) { const int kb = r >> 5, nb = r & 31; p0_item<false>(F.w_proj_sb, 1024, 64 * kb, 32 * nb, WPROJ, 2048, 32 * nb, 0, F.lane, 1.f); continue; } r -= I_PS;
        if (r < I_PM) { const int kb = r >> 5, nb = r & 31; p0_item<false>(F.w_proj_moba, 1024, 64 * kb, 32 * nb, WPROJ, 2048, 32 * nb, 1024, F.lane, 1.f); continue; } r -= I_PM;
        { const int kb = r >> 5, nb = r & 31; p0_item<false>(F.w_out, 1024, 64 * kb, 32 * nb, WOUT, 2048, 32 * nb, 0, F.lane, 1.f); }
    }
    f32x4 g[4];
#pragma unroll
    for (int j = 0; j < 4; ++j) g[j] = ((const f32x4*)F.norm_mix_g)[F.lane + 64 * j];
    bf16* XN = (bf16*)(F.ws + WS_XN);
#pragma unroll 1
    for (int m = gw; m < T_TOK; m += 4 * NGW) {
        f32x4 v[4][4];
#pragma unroll
        for (int r = 0; r < 4; ++r) { const GAS f32x4* xr = (const GAS f32x4*)(F.x + (size_t)(m + r * NGW) * DM) + F.lane;
#pragma unroll
            for (int j = 0; j < 4; ++j) v[r][j] = (m + r * NGW < T_TOK) ? __builtin_nontemporal_load(xr + 64 * j) : (f32x4){0.f, 0.f, 0.f, 0.f}; }
#pragma unroll
        for (int r = 0; r < 4; ++r) { if (m + r * NGW < T_TOK) { float s = 0.f;
#pragma unroll
            for (int j = 0; j < 4; ++j) s += (v[r][j].x * v[r][j].x + v[r][j].y * v[r][j].y) + (v[r][j].z * v[r][j].z + v[r][j].w * v[r][j].w);
            const float rstd = 1.0f / sqrtf(wave_sum(s) * (1.0f / DM) + RMS_EPS);
            GAS v2u* o8 = (GAS v2u*)(XN + (size_t)(m + r * NGW) * DM) + F.lane;
#pragma unroll
            for (int j = 0; j < 4; ++j) { const f32x4 y = v[r][j] * rstd * g[j]; v2u w; w.x = pg8::cvt_pk_bf16(y.x, y.y); w.y = pg8::cvt_pk_bf16(y.z, y.w); o8[64 * j] = w; } } }
    }
}

__device__ __forceinline__ f32x4 h1_frag(const bf16* h1, size_t row, int lane, int j) {
    const v2u a = *((const GAS v2u*)(h1 + row * DM) + lane + 64 * j);
    return (f32x4){__uint_as_float(a.x << 16), __uint_as_float(a.x & 0xffff0000u), __uint_as_float(a.y << 16), __uint_as_float(a.y & 0xffff0000u)};
}
__device__ __forceinline__ void p5_router_mfma(Frame& F) {
    typedef short bf16x8_t __attribute__((ext_vector_type(8)));
    typedef float f32x16_t __attribute__((ext_vector_type(16)));
    LAS unsigned short* WH = (LAS unsigned short*)(F.lds + RING_OFF);
    LAS unsigned short* WL = (LAS unsigned short*)(F.lds + RING_OFF + 65536);
    LAS float* PL = (LAS float*)(F.lds + RING_OFF);
    LAS float* SSQ = (LAS float*)(F.lds + LDSCTL_OFF + 4096);
    LAS float* RSTD = (LAS float*)(F.lds + LDSCTL_OFF + 5120);
    LAS int* hist = (LAS int*)(F.lds + L_HIST); LAS int* basel = (LAS int*)(F.lds + L_BASE); LAS int* tmp = (LAS int*)(F.lds + L_TMP);
    int tid = threadIdx.x; asm volatile("" : "+v"(tid));
    const int lane = tid & 63; const int wave = __builtin_amdgcn_readfirstlane(tid >> 6);
    const bf16* H1 = (const bf16*)(F.ws + WS_H1); unsigned char* HN8 = F.ws + WS_HN; float* topw = (float*)(F.ws + WS_TOPW); int* list = (int*)(F.ws + WS_LIST);
#pragma unroll 1
    for (int rb = F.vcu; rb < T_TOK / 64; rb += F.G) {
        for (int kk = tid; kk < DM; kk += NWAVES * 64) { const float gk = F.norm_ffn_g[kk]; const int fb = (((kk >> 4) * 2 + ((kk >> 3) & 1)) * 32) * 8 + (kk & 7);
#pragma unroll
            for (int q = 0; q < 8; ++q) { const f32x4 v = *(const f32x4*)(F.w_router + (size_t)kk * 32 + 4 * q);
#pragma unroll
                for (int c = 0; c < 4; ++c) { const float w = v[c] * gk; const unsigned hi = f2bf(w); const float lo = w - __uint_as_float(hi << 16);
                    WH[fb + (4 * q + c) * 8] = (unsigned short)hi; WL[fb + (4 * q + c) * 8] = (unsigned short)f2bf(lo); } } }
        if (tid < 32) hist[tid] = 0;
        __syncthreads();
        { const int mb = wave & 1, kq = wave >> 1, r = lane & 31, kg = lane >> 5;
          const bf16* hrow = H1 + (size_t)(rb * 64 + 32 * mb + r) * DM + kq * 256 + 8 * kg;
          bf16x8_t a[16];
#pragma unroll
          for (int st = 0; st < 16; ++st) a[st] = *(const bf16x8_t*)(hrow + st * 16);
          f32x16_t acc = f32x16_t{}; float ssq = 0.f;
#pragma unroll
          for (int st = 0; st < 16; ++st) { const int fo = (((kq * 16 + st) * 2 + kg) * 32 + r) * 8;
              const bf16x8_t bh = *(const LAS bf16x8_t*)(WH + fo), bl = *(const LAS bf16x8_t*)(WL + fo);
              acc = __builtin_amdgcn_mfma_f32_32x32x16_bf16(a[st], bh, acc, 0, 0, 0); acc = __builtin_amdgcn_mfma_f32_32x32x16_bf16(a[st], bl, acc, 0, 0, 0);
#pragma unroll
              for (int j = 0; j < 8; ++j) { const float x = __uint_as_float((unsigned)(unsigned short)a[st][j] << 16); ssq += x * x; } }
          ssq += __shfl_xor(ssq, 32);
          __syncthreads();
#pragma unroll
          for (int reg = 0; reg < 16; ++reg) { const int row = 32 * mb + (reg & 3) + 8 * (reg >> 2) + 4 * kg; PL[(kq * 64 + row) * 32 + r] = acc[reg]; }
          if (kg == 0) SSQ[kq * 64 + 32 * mb + r] = ssq; }
        __syncthreads();
        if (wave == 0) { const int row = lane; const float rstd = 1.0f / sqrtf((SSQ[row] + SSQ[64 + row] + SSQ[128 + row] + SSQ[192 + row]) * (1.0f / DM) + RMS_EPS); RSTD[row] = rstd;
            float lg[32];
#pragma unroll
            for (int e4 = 0; e4 < 8; ++e4) { const f32x4 p0 = *(const LAS f32x4*)(PL + (0 * 64 + row) * 32 + 4 * e4), p1 = *(const LAS f32x4*)(PL + (1 * 64 + row) * 32 + 4 * e4), p2 = *(const LAS f32x4*)(PL + (2 * 64 + row) * 32 + 4 * e4), p3 = *(const LAS f32x4*)(PL + (3 * 64 + row) * 32 + 4 * e4);
                const f32x4 bb = *(const f32x4*)(F.b_router + 4 * e4); const f32x4 sm = ((p0 + p1) + (p2 + p3)) * rstd + bb;
                lg[4 * e4] = sm.x; lg[4 * e4 + 1] = sm.y; lg[4 * e4 + 2] = sm.z; lg[4 * e4 + 3] = sm.w; }
            float selv[4]; int seli[4];
#pragma unroll
            for (int k = 0; k < 4; ++k) { float best = lg[0]; int bi = 0;
#pragma unroll
                for (int e = 1; e < 32; ++e) { const bool t = lg[e] > best; best = t ? lg[e] : best; bi = t ? e : bi; }
                selv[k] = best; seli[k] = bi;
#pragma unroll
                for (int e = 0; e < 32; ++e) lg[e] = (e == bi) ? -INFINITY : lg[e]; }
            const float e1 = __expf(selv[1] - selv[0]), e2 = __expf(selv[2] - selv[0]), e3 = __expf(selv[3] - selv[0]); const float inv = 1.0f / (1.0f + e1 + e2 + e3);
            const float wk[4] = {inv, e1 * inv, e2 * inv, e3 * inv};
#pragma unroll
            for (int k = 0; k < 4; ++k) { const int slot = __hip_atomic_fetch_add(hist + seli[k], 1, __ATOMIC_RELAXED, __HIP_MEMORY_SCOPE_WORKGROUP); tmp[row * 4 + k] = seli[k] | (slot << 8); }
            *(f32x4*)(topw + (size_t)(rb * 64 + row) * 4) = (f32x4){wk[0], wk[1], wk[2], wk[3]}; }
        __syncthreads();
        { f32x4 gl[4];
#pragma unroll
          for (int j = 0; j < 4; ++j) gl[j] = ((const f32x4*)F.norm_ffn_g)[lane * 4 + j];
#pragma unroll 2
          for (int i = 0; i < 8; ++i) { const int row = wave * 8 + i; const size_t grow = (size_t)(rb * 64 + row); const float rs = RSTD[row];
              const v4u h0 = *((const GAS v4u*)(H1 + grow * DM) + lane * 2), h1v = *((const GAS v4u*)(H1 + grow * DM) + lane * 2 + 1);
              float x[16];
              x[0] = __uint_as_float(h0.x << 16); x[1] = __uint_as_float(h0.x & 0xffff0000u); x[2] = __uint_as_float(h0.y << 16); x[3] = __uint_as_float(h0.y & 0xffff0000u);
              x[4] = __uint_as_float(h0.z << 16); x[5] = __uint_as_float(h0.z & 0xffff0000u); x[6] = __uint_as_float(h0.w << 16); x[7] = __uint_as_float(h0.w & 0xffff0000u);
              x[8] = __uint_as_float(h1v.x << 16); x[9] = __uint_as_float(h1v.x & 0xffff0000u); x[10] = __uint_as_float(h1v.y << 16); x[11] = __uint_as_float(h1v.y & 0xffff0000u);
              x[12] = __uint_as_float(h1v.z << 16); x[13] = __uint_as_float(h1v.z & 0xffff0000u); x[14] = __uint_as_float(h1v.w << 16); x[15] = __uint_as_float(h1v.w & 0xffff0000u);
#pragma unroll
              for (int j = 0; j < 4; ++j) { x[4 * j] *= rs * gl[j].x; x[4 * j + 1] *= rs * gl[j].y; x[4 * j + 2] *= rs * gl[j].z; x[4 * j + 3] *= rs * gl[j].w; }
              if constexpr (MOE_FP8) { v4u o; o.x = pg8::pk4_fp8(x[0], x[1], x[2], x[3]); o.y = pg8::pk4_fp8(x[4], x[5], x[6], x[7]); o.z = pg8::pk4_fp8(x[8], x[9], x[10], x[11]); o.w = pg8::pk4_fp8(x[12], x[13], x[14], x[15]);
                  *((GAS v4u*)(HN8 + grow * DM) + lane) = o; }
              else { v4u o0, o1; o0.x = pg8::cvt_pk_bf16(x[0], x[1]); o0.y = pg8::cvt_pk_bf16(x[2], x[3]); o0.z = pg8::cvt_pk_bf16(x[4], x[5]); o0.w = pg8::cvt_pk_bf16(x[6], x[7]);
                  o1.x = pg8::cvt_pk_bf16(x[8], x[9]); o1.y = pg8::cvt_pk_bf16(x[10], x[11]); o1.z = pg8::cvt_pk_bf16(x[12], x[13]); o1.w = pg8::cvt_pk_bf16(x[14], x[15]);
                  *((GAS v4u*)(HN8 + grow * DM * 2) + lane * 2) = o0; *((GAS v4u*)(HN8 + grow * DM * 2) + lane * 2 + 1) = o1; } } }
        if (tid < 32) basel[tid] = (int)__hip_atomic_fetch_add((unsigned*)(F.ctl + CW_CNT + 64 * tid), (unsigned)hist[tid], RLX_AGENT);
        __syncthreads();
        if (tid < 256) { const int t = tmp[tid]; const int ex = t & 255, slot = t >> 8; const int id = (rb * 64 + (tid >> 2)) * 4 + (tid & 3); const int idx = basel[ex] + slot;
            list[(size_t)ex * LIST_CAP + idx] = id; ((int*)(F.ws + WS_TOKENT))[id] = ex | (idx << 8); }
        __syncthreads();
    }
}
__device__ __forceinline__ int moe_tables(Frame& F) {
    LAS int* cnt = (LAS int*)(F.lds + L_CNT); LAS int* toff = (LAS int*)(F.lds + L_TOFF); LAS int* tile_e = (LAS int*)(F.lds + L_TILEE);
    __syncthreads();
    if (F.tid < 64) {
        const int lane = F.lane; int c = (lane < 32) ? (int)__hip_atomic_load((unsigned*)(F.ctl + CW_CNT + 64 * (lane & 31)), RLX_AGENT) : 0; c = c > LIST_CAP ? LIST_CAP : c;
        const int ntl = (c + 255) >> 8; int incl = ntl;
#pragma unroll
        for (int o = 1; o < 32; o <<= 1) { const int t = __shfl_up(incl, o); if (lane >= o) incl += t; }
        const int off = incl - ntl;
        if (lane < 32) { cnt[lane] = c; toff[lane] = off; if (lane == 31) toff[32] = incl;
            for (int t = 0; t < ntl; ++t) if (off + t < MAX_TILES) tile_e[off + t] = lane; } }
    __syncthreads();
    int NT = toff[32]; return NT > MAX_TILES ? MAX_TILES : NT;
}
__device__ __forceinline__ void p8_final(Frame& F) {
    int tid_ = threadIdx.x; asm volatile("" : "+v"(tid_));
    const int gw = F.vcu * NWAVES + F.wave, NGW = F.G * NWAVES, lane = tid_ & 63;
    (void)moe_tables(F);
    LAS float* bdl = (LAS float*)(F.lds + RING_OFF); const LAS int* toff = (const LAS int*)(F.lds + L_TOFF);
    for (int i = F.tid; i < NEXP * DM / 4; i += NWAVES * 64) ((LAS f32x4*)bdl)[i] = ((const f32x4*)F.b_down)[i];
    __syncthreads();
    f32x4 g[4];
#pragma unroll
    for (int j = 0; j < 4; ++j) g[j] = ((const f32x4*)F.norm_final_g)[lane + 64 * j];
    const bf16* H1 = (const bf16*)(F.ws + WS_H1); const bf16* YS = (const bf16*)(F.ws + WS_YSLOT); const int* tokent = (const int*)(F.ws + WS_TOKENT); const float* topw = (const float*)(F.ws + WS_TOPW);
#pragma unroll 1
    for (int m0 = gw; m0 < T_TOK; m0 += 2 * NGW) {
        int4 ent[2]; f32x4 wk[2]; f32x4 v[2][4]; v2u y[2][4][4];
#pragma unroll
        for (int t = 0; t < 2; ++t) { const int m = m0 + t * NGW; ent[t] = *(const int4*)(tokent + (size_t)m * 4); wk[t] = *(const f32x4*)(topw + (size_t)m * 4); }
#pragma unroll
        for (int t = 0; t < 2; ++t) { const int m = m0 + t * NGW;
#pragma unroll
            for (int j = 0; j < 4; ++j) v[t][j] = h1_frag(H1, (size_t)m, lane, j);
#pragma unroll
            for (int k = 0; k < TOPK; ++k) { const int en = k == 0 ? ent[t].x : k == 1 ? ent[t].y : k == 2 ? ent[t].z : ent[t].w; const int e = en & 255, idx = en >> 8; const size_t row = (size_t)toff[e] * 256 + idx;
                const GAS v2u* yr = (const GAS v2u*)(YS + row * DM) + lane;
#pragma unroll
                for (int j = 0; j < 4; ++j) y[t][k][j] = yr[64 * j]; } }
#pragma unroll
        for (int t = 0; t < 2; ++t) { const int m = m0 + t * NGW;
#pragma unroll
            for (int k = 0; k < TOPK; ++k) { const int en = k == 0 ? ent[t].x : k == 1 ? ent[t].y : k == 2 ? ent[t].z : ent[t].w; const int e = en & 255; const float w = k == 0 ? wk[t].x : k == 1 ? wk[t].y : k == 2 ? wk[t].z : wk[t].w;
#pragma unroll
                for (int j = 0; j < 4; ++j) { const f32x4 bb = *(const LAS f32x4*)(bdl + e * DM + 4 * (lane + 64 * j)); const v2u q = y[t][k][j];
                    v[t][j].x += w * (__uint_as_float(q.x << 16) + bb.x); v[t][j].y += w * (__uint_as_float(q.x & 0xffff0000u) + bb.y); v[t][j].z += w * (__uint_as_float(q.y << 16) + bb.z); v[t][j].w += w * (__uint_as_float(q.y & 0xffff0000u) + bb.w); } }
            float s = 0.f;
#pragma unroll
            for (int j = 0; j < 4; ++j) s += (v[t][j].x * v[t][j].x + v[t][j].y * v[t][j].y) + (v[t][j].z * v[t][j].z + v[t][j].w * v[t][j].w);
            const float rstd = 1.0f / sqrtf(wave_sum(s) * (1.0f / DM) + RMS_EPS);
            GAS f32x4* o = (GAS f32x4*)(F.out + (size_t)m * DM) + lane;
#pragma unroll
            for (int j = 0; j < 4; ++j) o[64 * j] = v[t][j] * rstd * g[j]; }
    }
}

constexpr int N_PHASES = 9;
struct Args { const float* in[15]; float* out; unsigned char* ws; int ph_lo, ph_hi; };
__global__ void __launch_bounds__(NWAVES * 64, 2) fwd_kernel(Args args) {
    extern __shared__ __attribute__((aligned(16))) unsigned char lds[];
    Frame F;
    F.lds = (LAS unsigned char*)lds;
    F.tid = threadIdx.x; F.lane = F.tid & 63; F.wave = __builtin_amdgcn_readfirstlane(F.tid >> 6);
    F.G = gridDim.x; { const int bx = blockIdx.x; F.vcu = (F.G % 8 == 0) ? (bx % 8) * (F.G / 8) + bx / 8 : bx; }
    F.ws = args.ws; F.ctl = (gu32*)(args.ws + WS_CTL); F.out = args.out;
    F.x = args.in[0]; F.norm_mix_g = args.in[1]; F.w_in = args.in[2]; F.w_proj_sb = args.in[3]; F.w_proj_moba = args.in[4]; F.w_out = args.in[5]; F.rel_bias = args.in[6]; F.norm_ffn_g = args.in[7];
    F.w_router = args.in[8]; F.b_router = args.in[9]; F.w_gate_up = args.in[10]; F.b_gate_up = args.in[11]; F.w_down = args.in[12]; F.b_down = args.in[13]; F.norm_final_g = args.in[14];
    for (int u = F.tid; u < (LDS_BYTES - LDSCTL_OFF) / 4; u += NWAVES * 64) ((LAS unsigned*)(F.lds + LDSCTL_OFF))[u] = 0u;
    __syncthreads();
    XcdBarrier bar; bar.bar = (unsigned*)(F.ctl + CW_BAR); bar.x = 0; bar.st = nullptr;
    if (MK_N_LAUNCHES == 1) bar = xcd_barrier_post((unsigned*)(F.ctl + CW_BAR), (volatile LAS unsigned*)(F.lds + L_MISC) + 8);
#define GRID_BAR() do { if (MK_N_LAUNCHES == 1) xcd_barrier(bar); } while (0)
    const int lo = args.ph_lo, hi = args.ph_hi;
#ifndef PH_MASK
#define PH_MASK 0x1ff
#endif
#define IN(k) ((((PH_MASK) >> (k)) & 1) && lo <= (k) && (k) < hi)
#define BOTH(k) (IN(k) && IN((k) + 1))
    unsigned char* ws = args.ws;
    int conv_k = 0;
    const bool conv_il = CONV_INTERLEAVE && EXPERTS_LATE && F.G == 256 && MK_N_LAUNCHES == 1; const unsigned odd = (unsigned)F.vcu & 1u;

    if (IN(0)) { _Pragma("unroll") for (int rep = 0; rep < 1 + ((PROBE_REP >> 0) & 1); ++rep) { p0_prologue(F, EXPERTS_LATE ? 1 : 3); if (BOTH(0)) GRID_BAR(); } }

    if (IN(1)) { _Pragma("unroll") for (int rep = 0; rep < 1 + ((PROBE_REP >> 1) & 1); ++rep) {
        pg8::DenseOrder S{T_TOK / 256, DIN / 256, F.G, (int)blockIdx.x, (const char*)(ws + WS_XN), (const char*)(ws + WS_WIN), (size_t)256 * DM * 2, (size_t)256 * DM * 2};
        pg8::EpiInProj E{(bf16*)(ws + WS_QKV), (bf16*)(ws + WS_GATES), (float*)(ws + WS_KPART)};
        ConvHookT<3> H{&F, &conv_k, conv_il ? (odd ? 0x00100ull : 0x00001ull) : 0ull};
        pg8::gemm_phase<pg8::EpiInProj, pg8::DenseOrder, true, false, false, ConvHookT<3> >(F.lds + RING_OFF, S, E, DM * 2, DM * 2, DM * 2, H);
        if (BOTH(1)) GRID_BAR();
    } }

    if (IN(2)) { _Pragma("unroll") for (int rep = 0; rep < 1 + ((PROBE_REP >> 2) & 1); ++rep) {
        const att::bf16* QKV = (const att::bf16*)(ws + WS_QKV); att::bf16* Y = (att::bf16*)(ws + WS_Y);
        for (int v = F.vcu; v < 256; v += F.G) {
            const int bh = v >> 2, s = v & 3, b = bh >> 3, h = bh & 7;
            _Pragma("unroll") for (int r2 = 0; r2 < 1 + ((PROBE_REP >> 9) & 1); ++r2) {
            att::moba_unit(b, h, 7 - s, QKV, Y, (const float*)(ws + WS_KPART), F.rel_bias, (char*)lds + RING_OFF);
            att::moba_unit(b, h, s, QKV, Y, (const float*)(ws + WS_KPART), F.rel_bias, (char*)lds + RING_OFF); }
            _Pragma("unroll") for (int r2 = 0; r2 < 1 + ((PROBE_REP >> 10) & 1); ++r2) {
            att::sb_unit(b, h, 7 - s, QKV, Y, (char*)lds + RING_OFF);
            att::sb_unit(b, h, s, QKV, Y, (char*)lds + RING_OFF); }
        }
        if (BOTH(2)) GRID_BAR();
    } }

    if (IN(3)) { _Pragma("unroll") for (int rep = 0; rep < 1 + ((PROBE_REP >> 3) & 1); ++rep) {
        pg8::ProjOrder S{F.G, (int)blockIdx.x, (const char*)(ws + WS_Y), (const char*)(ws + WS_WPROJ)};
        pg8::EpiProjGate E{(const bf16*)(ws + WS_GATES), (bf16*)(ws + WS_MERGED)};
        ConvHookT<3> H{&F, &conv_k, conv_il ? (odd ? 0x010ull : 0x001ull) : 0ull};
        pg8::gemm_phase<pg8::EpiProjGate, pg8::ProjOrder, true, false, false, ConvHookT<3> >(F.lds + RING_OFF, S, E, 512 * 2, DM * 2, DM * 2, H);
        if (BOTH(3)) GRID_BAR();
    } }

    if (IN(4)) { _Pragma("unroll") for (int rep = 0; rep < 1 + ((PROBE_REP >> 4) & 1); ++rep) {
        pg8::DenseOrder S{T_TOK / 256, DM / 256, F.G, (int)blockIdx.x, (const char*)(ws + WS_MERGED), (const char*)(ws + WS_WOUT), (size_t)256 * DM * 2, (size_t)256 * DM * 2};
        pg8::EpiResF32 E{F.x, (bf16*)(ws + WS_H1)};
        ConvHookT<2> H{&F, &conv_k, conv_il ? (odd ? 0x10ull : 0x01ull) : 0ull};
        pg8::gemm_phase<pg8::EpiResF32, pg8::DenseOrder, true, false, false, ConvHookT<2> >(F.lds + RING_OFF, S, E, DM * 2, DM * 2, DM * 2, H);
        if (BOTH(4)) GRID_BAR();
    } }

    if (IN(5)) { p5_router_mfma(F); if (EXPERTS_LATE) { if (conv_il) { if (conv_k < 8) conv_chunks<1>(F, conv_k, 8 - conv_k); } else p0_prologue(F, 2); } if (BOTH(5)) GRID_BAR(); }

    if (IN(6)) { _Pragma("unroll") for (int rep = 0; rep < 1 + ((PROBE_REP >> 6) & 1); ++rep) {
        const int NT = moe_tables(F);
        pg8::MoeOrder S{NT, 8, F.G, (int)blockIdx.x, (const LAS int*)(F.lds + L_TILEE), (const LAS int*)(F.lds + L_TOFF), (const LAS int*)(F.lds + L_CNT),
                        (const char*)(ws + WS_HN), (const char*)(ws + WS_WGU), (size_t)256 * DM * MOE_ES, (size_t)256 * DM * MOE_ES, (size_t)2048 * DM * MOE_ES, (const int*)(ws + WS_LIST), DM * MOE_ES, true, 1 + ((PROBE_REP >> 11) & 1)};
        pg8::EpiSwiglu E{F.b_gate_up, (unsigned char*)(ws + WS_ACT)};
        ConvHookT<1> H{&F, &conv_k, conv_il ? (odd ? 0x101010100ull : 0x010101010ull) : 0ull};
        pg8::gemm_phase<pg8::EpiSwiglu, pg8::MoeOrder, true, true, MOE_FP8, ConvHookT<1> >(F.lds + RING_OFF, S, E, DM * MOE_ES, DM * MOE_ES, DM * MOE_ES, H);
        if (conv_il) conv_chunks<1>(F, conv_k, 12);
        if (BOTH(6)) GRID_BAR();
    } }

    if (IN(7)) { _Pragma("unroll") for (int rep = 0; rep < 1 + ((PROBE_REP >> 7) & 1); ++rep) {
        const int NT = moe_tables(F);
        pg8::MoeOrder S{NT, 4, F.G, (int)blockIdx.x, (const LAS int*)(F.lds + L_TILEE), (const LAS int*)(F.lds + L_TOFF), (const LAS int*)(F.lds + L_CNT),
                        (const char*)(ws + WS_ACT), (const char*)(ws + WS_WD), (size_t)256 * DM * MOE_ES, (size_t)256 * DM * MOE_ES, (size_t)1024 * DM * MOE_ES, (const int*)(ws + WS_LIST), DM * MOE_ES, false, 1 + ((PROBE_REP >> 12) & 1)};
        pg8::EpiDown E{(bf16*)(ws + WS_YSLOT)};
        pg8::gemm_phase<pg8::EpiDown, pg8::MoeOrder, true, false, MOE_FP8>(F.lds + RING_OFF, S, E, DM * MOE_ES, DM * MOE_ES, DM * MOE_ES);
        if (BOTH(7)) GRID_BAR();
    } }

    if (IN(8)) { for (int rep = 0; rep < 1 + ((PROBE_REP >> 8) & 1); ++rep) p8_final(F); }
#undef IN
#undef BOTH
#undef GRID_BAR
}

extern "C" void kernel_launch(void* const* d_in, const int* in_sizes, int n_in, void* d_out, int out_size, void* d_ws, size_t ws_size, hipStream_t stream) {
    static int grid = 0;
    if (grid == 0) {
        if (n_in != 15 || in_sizes[0] != T_TOK * DM || out_size != T_TOK * DM || ws_size < WS_END) { fprintf(stderr, "kernel_launch: unexpected shapes (n_in %d, in0 %d, out %d, ws %zu); nothing launched\n", n_in, n_in > 0 ? in_sizes[0] : -1, out_size, ws_size); grid = -1; return; }
        int dev = 0, cus = 0, per_cu = 0;
        if (hipGetDevice(&dev) != hipSuccess || hipDeviceGetAttribute(&cus, hipDeviceAttributeMultiprocessorCount, dev) != hipSuccess) { grid = -1; return; }
        if (hipFuncSetAttribute((const void*)fwd_kernel, hipFuncAttributeMaxDynamicSharedMemorySize, LDS_BYTES) != hipSuccess) { fprintf(stderr, "kernel_launch: hipFuncSetAttribute failed\n"); grid = -1; return; }
        if (hipOccupancyMaxActiveBlocksPerMultiprocessor(&per_cu, (const void*)fwd_kernel, NWAVES * 64, LDS_BYTES) != hipSuccess || per_cu < 1) { fprintf(stderr, "kernel_launch: occupancy query reports %d workgroups per CU\n", per_cu); }
        (void)hipGetLastError();
        grid = cus;
    }
    if (grid < 0) return;
    if (hipMemsetAsync((char*)d_ws + WS_CTL, 0, CTL_ZERO_BYTES, stream) != hipSuccess) return;
    Args a{};
    for (int i = 0; i < 15; ++i) a.in[i] = (const float*)d_in[i];
    a.out = (float*)d_out; a.ws = (unsigned char*)d_ws;
    if (MK_N_LAUNCHES == 1) { a.ph_lo = 0; a.ph_hi = N_PHASES; hipLaunchKernelGGL(fwd_kernel, dim3(grid), dim3(NWAVES * 64), LDS_BYTES, stream, a); }
    else { for (int p = 0; p < N_PHASES; ++p) { a.ph_lo = p; a.ph_hi = p + 1; hipLaunchKernelGGL(fwd_kernel, dim3(grid), dim3(NWAVES * 64), LDS_BYTES, stream, a); } }
}
```
